# Optimizing an MI355X kernel written in HIP

```python
import math
import jax, jax.numpy as jnp
from jax import lax
import numpy as np

D_MODEL = 1024
BATCH = 8
SEQ = 2048
DEPTH = 1

RET_HEADS = 4
RET_DK = 128
RET_DV = 128
RET_CHUNK = 128
RET_FWD_DECAY_OFFSET = 5.0
RET_BWD_DECAY_OFFSET = 5.5
RET_THETA_BASE = 10000.0
DIFF_HEADS = 4
DIFF_DH = 64
DIFF_DV = 2 * DIFF_DH
Q_BLOCK = 128
N_BUCKETS = 32
MAX_DISTANCE = 128
N_EXPERTS = 16
EXPERT_FF = 1024
CAPACITY_FACTOR = 2
NORM_EPS = 1e-6

RET_QK_W = RET_HEADS * RET_DK
RET_V_W = RET_HEADS * RET_DV
DIFF_QK_W = DIFF_HEADS * DIFF_DH
DIFF_V_W = DIFF_HEADS * DIFF_DV
N_BRANCHES = 2
IN_SIZES = (RET_QK_W, RET_QK_W, RET_V_W, RET_V_W,
            DIFF_QK_W, DIFF_QK_W, DIFF_QK_W, DIFF_QK_W, DIFF_V_W,
            D_MODEL, D_MODEL)
IN_COLS = sum(IN_SIZES)

kernel_name = 'hybrid_retention_diffattn_ec_moe'


def _rmsnorm(x, g):
    xf = x.astype(jnp.float32)
    y = xf * lax.rsqrt(jnp.mean(xf * xf, axis=-1, keepdims=True) + NORM_EPS)
    return (y * g.astype(jnp.float32)).astype(x.dtype)


def _rotate(x, pos):
    d = x.shape[-1]
    inv = 1.0 / (RET_THETA_BASE ** jnp.linspace(0.0, 1.0, d // 2, dtype=jnp.float32))
    ang = pos.astype(jnp.float32)[:, None] * inv[None, :]
    cos = jnp.cos(ang)[None, :, None, :].astype(x.dtype)
    sin = jnp.sin(ang)[None, :, None, :].astype(x.dtype)
    x1 = x[..., 0::2]
    x2 = x[..., 1::2]
    return jnp.stack([x1 * cos - x2 * sin, x1 * sin + x2 * cos], axis=-1).reshape(x.shape)


def _retention_one_dir(q, k, v, log_g, include_diag):
    B, H, S, dk = q.shape
    dv = v.shape[-1]
    C = RET_CHUNK
    N = S // C
    qc = q.reshape(B, H, N, C, dk)
    kc = k.reshape(B, H, N, C, dk)
    vc = v.reshape(B, H, N, C, dv)
    idx = jnp.arange(C, dtype=jnp.float32)
    diff = idx[:, None] - idx[None, :]
    mask = (diff >= 0) if include_diag else (diff > 0)
    decay_in = jnp.where(mask[None], jnp.exp(jnp.maximum(diff, 0.0)[None] * log_g[:, None, None]), 0.0)
    decay_in = decay_in.astype(q.dtype)
    scores = jnp.einsum('bhncd,bhnmd->bhncm', qc, kc) * decay_in[None, :, None]
    inner = jnp.einsum('bhncm,bhnme->bhnce', scores, vc)
    k_dec = jnp.exp((C - 1 - idx)[None, :] * log_g[:, None]).astype(q.dtype)
    q_dec = jnp.exp((idx + 1)[None, :] * log_g[:, None]).astype(q.dtype)
    chunk_dec = jnp.exp(C * log_g)
    kv = jnp.einsum('bhncd,hc,bhnce->nbhde', kc, k_dec, vc).astype(jnp.float32)

    def step(state, kv_n):
        return chunk_dec[None, :, None, None] * state + kv_n, state

    _, prev = lax.scan(step, jnp.zeros((B, H, dk, dv), jnp.float32), kv)
    cross = jnp.einsum('bhncd,hc,nbhde->bhnce', qc, q_dec, prev.astype(q.dtype))
    return (inner + cross).reshape(B, H, S, dv)


def _t5_bucket(rel):
    nb = N_BUCKETS // 2
    max_exact = nb // 2
    ret = (rel > 0).astype(jnp.int32) * nb
    n = jnp.abs(rel)
    large = max_exact + (jnp.log(jnp.maximum(n, 1).astype(jnp.float32) / max_exact)
                         / math.log(MAX_DISTANCE / max_exact) * (nb - max_exact)).astype(jnp.int32)
    large = jnp.minimum(large, nb - 1)
    return ret + jnp.where(n < max_exact, n, large)


def _diff_attention(q1, q2, k1, k2, v, rel_bias, lam):
    B, H, S, dh = q1.shape
    dv = v.shape[-1]
    NB = S // Q_BLOCK
    scale = dh ** -0.5
    kpos = jnp.arange(S, dtype=jnp.int32)

    def to_blocks(t):
        return jnp.moveaxis(t.reshape(B, H, NB, Q_BLOCK, dh), 2, 0)

    def block(args):
        q1b, q2b, start = args
        qpos = start + jnp.arange(Q_BLOCK, dtype=jnp.int32)
        bias = jnp.transpose(rel_bias[_t5_bucket(kpos[None, :] - qpos[:, None])], (2, 0, 1))
        bias = bias.astype(jnp.float32)
        s1 = jnp.einsum('bhqd,bhkd->bhqk', q1b, k1).astype(jnp.float32) * scale + bias
        s2 = jnp.einsum('bhqd,bhkd->bhqk', q2b, k2).astype(jnp.float32) * scale + bias
        attn = jax.nn.softmax(s1, axis=-1) - lam * jax.nn.softmax(s2, axis=-1)
        return jnp.einsum('bhqk,bhke->bhqe', attn.astype(v.dtype), v)

    starts = jnp.arange(NB, dtype=jnp.int32) * Q_BLOCK
    out = lax.map(block, (to_blocks(q1), to_blocks(q2), starts))
    return jnp.transpose(out, (1, 0, 3, 2, 4)).reshape(B, S, H, dv)


def _expert_choice(h, w_router, w_gate, w_up, w_down):
    B, S, D = h.shape
    cap = CAPACITY_FACTOR * S // N_EXPERTS
    aff = jax.nn.softmax((h @ w_router).astype(jnp.float32), axis=-1)
    g, idx = lax.top_k(jnp.swapaxes(aff, 1, 2), cap)
    bidx = jnp.arange(B)[:, None, None]
    xin = h[bidx, idx]
    a = jnp.einsum('becd,edf->becf', xin, w_gate)
    u = jnp.einsum('becd,edf->becf', xin, w_up)
    y = jnp.einsum('becf,efd->becd', jax.nn.silu(a) * u, w_down) * g[..., None].astype(h.dtype)
    return jnp.zeros_like(h).at[bidx, idx].add(y)


def setup_inputs(seed: int = 0) -> dict:
    key = jax.random.key(seed)
    ks = jax.random.split(key, 24)
    f32 = jnp.float32
    nrm = lambda k, shape, s: jax.random.normal(k, shape, f32) * s
    gain = lambda k, shape: 1.0 + 0.02 * jax.random.normal(k, shape, f32)
    L, D = DEPTH, D_MODEL
    return {
        'x': nrm(ks[0], (BATCH, SEQ, D), 1.0),
        'c': nrm(ks[1], (BATCH, D), 1.0),
        'w_ada': nrm(ks[2], (L, D, 6 * D), D ** -0.5),
        'b_ada': nrm(ks[3], (L, 6 * D), 0.01),
        'norm_mix_g': gain(ks[4], (L, D)),
        'w_in': nrm(ks[5], (L, D, IN_COLS), D ** -0.5),
        'ret_gn_g': gain(ks[6], (L, RET_V_W)),
        'diff_subln_g': gain(ks[7], (L, DIFF_DV)),
        'lambda_q1': nrm(ks[8], (L, DIFF_DH), 0.1),
        'lambda_k1': nrm(ks[9], (L, DIFF_DH), 0.1),
        'lambda_q2': nrm(ks[10], (L, DIFF_DH), 0.1),
        'lambda_k2': nrm(ks[11], (L, DIFF_DH), 0.1),
        'w_ret_out': nrm(ks[12], (L, RET_V_W, D), RET_V_W ** -0.5),
        'w_diff_out': nrm(ks[13], (L, DIFF_V_W, D), DIFF_V_W ** -0.5),
        'w_o': nrm(ks[14], (L, D, D), D ** -0.5),
        'rel_bias': nrm(ks[15], (N_BUCKETS, DIFF_HEADS), 0.5),
        'norm_ffn_g': gain(ks[16], (L, D)),
        'w_router': nrm(ks[17], (L, D, N_EXPERTS), D ** -0.5),
        'w_exp_gate': nrm(ks[18], (L, N_EXPERTS, D, EXPERT_FF), D ** -0.5),
        'w_exp_up': nrm(ks[19], (L, N_EXPERTS, D, EXPERT_FF), D ** -0.5),
        'w_exp_down': nrm(ks[20], (L, N_EXPERTS, EXPERT_FF, D), EXPERT_FF ** -0.5),
        'final_g': gain(ks[21], (D,)),
    }


def reference(x, c, w_ada, b_ada, norm_mix_g, w_in, ret_gn_g, diff_subln_g,
              lambda_q1, lambda_k1, lambda_q2, lambda_k2, w_ret_out, w_diff_out,
              w_o, rel_bias, norm_ffn_g, w_router, w_exp_gate, w_exp_up,
              w_exp_down, final_g):
    B, S, D = x.shape
    f32 = jnp.float32
    pos = jnp.arange(S, dtype=jnp.int32)
    heads = jnp.arange(RET_HEADS, dtype=f32)
    log_g_fwd = jnp.log1p(-jnp.exp2(-RET_FWD_DECAY_OFFSET - heads))
    log_g_bwd = jnp.log1p(-jnp.exp2(-RET_BWD_DECAY_OFFSET - heads))
    split_points = np.cumsum(IN_SIZES)[:-1].tolist()
    to_bhsd = lambda t: jnp.transpose(t, (0, 2, 1, 3))

    for l in range(DEPTH):
        mod = jax.nn.silu(c) @ w_ada[l] + b_ada[l]
        sh1, sc1, ga1, sh2, sc2, ga2 = [m[:, None, :] for m in jnp.split(mod, 6, axis=-1)]

        h = _rmsnorm(x, norm_mix_g[l]) * (1.0 + sc1) + sh1
        proj = h @ w_in[l]
        rq, rk, rv, rg, dq1, dq2, dk1, dk2, dvv, gr, gd = jnp.split(proj, split_points, axis=-1)

        rq = _rotate(rq.reshape(B, S, RET_HEADS, RET_DK), pos)
        rk = _rotate(rk.reshape(B, S, RET_HEADS, RET_DK), pos) * (RET_DK ** -0.5)
        rq, rk = to_bhsd(rq), to_bhsd(rk)
        rv = to_bhsd(rv.reshape(B, S, RET_HEADS, RET_DV))
        fwd = _retention_one_dir(rq, rk, rv, log_g_fwd, True)
        bwd = jnp.flip(_retention_one_dir(jnp.flip(rq, 2), jnp.flip(rk, 2), jnp.flip(rv, 2),
                                          log_g_bwd, False), 2)
        yr = to_bhsd(fwd + bwd).astype(f32)
        mu = jnp.mean(yr, axis=-1, keepdims=True)
        var = jnp.mean(jnp.square(yr - mu), axis=-1, keepdims=True)
        yr = ((yr - mu) * lax.rsqrt(var + NORM_EPS)).reshape(B, S, RET_V_W)
        yr = (yr * ret_gn_g[l].astype(f32)).astype(x.dtype)
        y_ret = jax.nn.silu(rg) * yr

        lam_init = 0.8 - 0.6 * math.exp(-0.3 * l)
        lam = (jnp.exp(jnp.sum(lambda_q1[l].astype(f32) * lambda_k1[l].astype(f32)))
               - jnp.exp(jnp.sum(lambda_q2[l].astype(f32) * lambda_k2[l].astype(f32))) + lam_init)
        hd = lambda t, d: to_bhsd(t.reshape(B, S, DIFF_HEADS, d))
        yd = _diff_attention(hd(dq1, DIFF_DH), hd(dq2, DIFF_DH), hd(dk1, DIFF_DH),
                             hd(dk2, DIFF_DH), hd(dvv, DIFF_DV), rel_bias, lam)
        y_diff = (_rmsnorm(yd, diff_subln_g[l]) * (1.0 - lam_init)).reshape(B, S, DIFF_V_W)

        merged = (jax.nn.sigmoid(gr) * (y_ret @ w_ret_out[l])
                  + jax.nn.sigmoid(gd) * (y_diff @ w_diff_out[l]))
        x = x + ga1 * (merged @ w_o[l])

        h = _rmsnorm(x, norm_ffn_g[l]) * (1.0 + sc2) + sh2
        x = x + ga2 * _expert_choice(h, w_router[l], w_exp_gate[l], w_exp_up[l], w_exp_down[l])

    return _rmsnorm(x, final_g)
```

```cpp
#include <hip/hip_runtime.h>
#include <cstdio>
#include <cstdint>
namespace pg8 {
#define PG8_LAS __attribute__((address_space(3)))
typedef unsigned short bf16_t;
typedef short bf16x8 __attribute__((ext_vector_type(8)));
typedef float f32x4 __attribute__((ext_vector_type(4)));
typedef unsigned u32x4 __attribute__((ext_vector_type(4)));
constexpr int BM = 256, BK = 64, HALF = 128, HTB = HALF * BK * 2  , STAGE_BYTES = 8 * HTB, NXCD = 8, WGM = 8;

__host__ __device__ __forceinline__ int lds_byte(int r, int c) { const int st = (r >> 4) * 2 + (c >> 5), rr = r & 15, cc = c & 31, ob = rr * 64 + cc * 2; return st * 1024 + (ob ^ (((ob >> 9) & 1) << 5)); }
__host__ __device__ __forceinline__ void stage_rc(int b, int& R, int& C) { const int st = b / 1024, sb = b % 1024, swz = sb ^ (((sb >> 9) & 1) << 5); R = (st >> 1) * 16 + swz / 64; C = (st & 1) * 32 + (swz % 64) / 2; }
__host__ __device__ __forceinline__ int perm32(int rho) { const int n = rho >> 4, i = rho & 15; return 8 * (i >> 2) + 4 * n + (i & 3); }

struct Unit { int pm, pn; };
struct Gemm { const bf16_t* A; const bf16_t* Bt; int M, N, K, lda, ldb, gdiv; size_t gstride; };
typedef unsigned u32x2 __attribute__((ext_vector_type(2)));
__device__ __forceinline__ unsigned cvt_pk_bf16(float lo, float hi) { unsigned r; asm volatile("v_cvt_pk_bf16_f32 %0, %1, %2" : "=v"(r) : "v"(lo), "v"(hi)); return r; }
__device__ __forceinline__ float bflo(unsigned w) { return __builtin_bit_cast(float, w << 16); }
__device__ __forceinline__ float bfhi(unsigned w) { return __builtin_bit_cast(float, w & 0xffff0000u); }
__device__ __forceinline__ float sigmoidf_(float v) { return __builtin_amdgcn_rcpf(1.0f + __builtin_amdgcn_exp2f(-1.4426950408889634f * v)); }
__device__ __forceinline__ u32x4 pack8(const f32x4& v0, const f32x4& v1) { u32x4 w; w.x = cvt_pk_bf16(v0[0], v0[1]); w.y = cvt_pk_bf16(v0[2], v0[3]); w.z = cvt_pk_bf16(v1[0], v1[1]); w.w = cvt_pk_bf16(v1[2], v1[3]); return w; }
__device__ __forceinline__ void unpack8(const u32x4& w, f32x4& v0, f32x4& v1) { v0 = (f32x4){bflo(w.x), bfhi(w.x), bflo(w.y), bfhi(w.y)}; v1 = (f32x4){bflo(w.z), bfhi(w.z), bflo(w.w), bfhi(w.w)}; }

struct EpiProj {
    static constexpr bool PERM = true, AFTER_DRAIN = false;
    bf16_t* base; const float* cs;
    size_t oRQ, oRK, oRV, oRG, oDQ1, oDV, oGR, oGD;
    __device__ __forceinline__ void operator()(const f32x4 (&acc)[2][2][4][2], const Unit& u, int wr, int wc, int fr, int fq) const {
        const int pn = u.pn; size_t off; int ldc, colt, mode; float sc = 1.f;
        if (pn < 2)       { off = oRQ; ldc = 512; colt = pn * 256; mode = 1; }
        else if (pn < 4)  { off = oRK; ldc = 512; colt = (pn - 2) * 256; mode = 1; sc = 0.08838834764831845f; }
        else if (pn < 6)  { off = oRV; ldc = 512; colt = (pn - 4) * 256; mode = 0; }
        else if (pn < 8)  { off = oRG; ldc = 512; colt = (pn - 6) * 256; mode = 2; }
        else if (pn < 12) { off = oDQ1 + (size_t)(pn - 8) * ((size_t)16384 * 256); ldc = 256; colt = 0; mode = 0; sc = (pn < 10) ? 0.18033688011112042f : 1.f; }
        else if (pn < 14) { off = oDV; ldc = 512; colt = (pn - 12) * 256; mode = 0; }
        else if (pn < 18) { off = oGR; ldc = 1024; colt = (pn - 14) * 256; mode = 3; }
        else              { off = oGD; ldc = 1024; colt = (pn - 18) * 256; mode = 3; }
        const int row0 = u.pm * BM + wr * 64 + fr, col0 = colt + wc * 32 + 8 * fq;
        const int i0 = wc * 16 + 4 * fq;
#pragma unroll
        for (int ai = 0; ai < 2; ++ai)
#pragma unroll
            for (int m = 0; m < 4; ++m) { const int row = row0 + ai * HALF + m * 16; bf16_t* rowp = base + off + (size_t)row * ldc + col0;
                f32x4 c01 = (f32x4){1.f, 0.f, 1.f, 0.f}, c23 = c01;
                if (mode == 1) { const f32x4* cp = (const f32x4*)(cs + ((size_t)(row & 2047) * 64 + i0) * 2); c01 = cp[0]; c23 = cp[1]; }
#pragma unroll
                for (int bj = 0; bj < 2; ++bj) { f32x4 v0 = acc[ai][bj][m][0], v1 = acc[ai][bj][m][1];
                    if (mode == 1) {
                        const f32x4 a = v0, b = v1;
                        v0 = (f32x4){a[0] * c01[0] - a[1] * c01[1], a[0] * c01[1] + a[1] * c01[0], a[2] * c01[2] - a[3] * c01[3], a[2] * c01[3] + a[3] * c01[2]};
                        v1 = (f32x4){b[0] * c23[0] - b[1] * c23[1], b[0] * c23[1] + b[1] * c23[0], b[2] * c23[2] - b[3] * c23[3], b[2] * c23[3] + b[3] * c23[2]};
                    } else if (mode == 2) {
#pragma unroll
                        for (int j = 0; j < 4; ++j) { v0[j] = v0[j] * sigmoidf_(v0[j]); v1[j] = v1[j] * sigmoidf_(v1[j]); }
                    } else if (mode == 3) {
#pragma unroll
                        for (int j = 0; j < 4; ++j) { v0[j] = sigmoidf_(v0[j]); v1[j] = sigmoidf_(v1[j]); }
                    }
                    v0 = v0 * sc; v1 = v1 * sc;
                    *(u32x4*)(rowp + bj * HALF) = pack8(v0, v1); } }
    }
};
struct EpiGate {
    static constexpr bool PERM = true, AFTER_DRAIN = false;
    bf16_t* O; const bf16_t* G; const bf16_t* T; int ldc;
    __device__ __forceinline__ void operator()(const f32x4 (&acc)[2][2][4][2], const Unit& u, int wr, int wc, int fr, int fq) const {
        const int row0 = u.pm * BM + wr * 64 + fr, col0 = u.pn * BM + wc * 32 + 8 * fq;
#pragma unroll
        for (int ai = 0; ai < 2; ++ai)
#pragma unroll
            for (int m = 0; m < 4; ++m) { const size_t ro = (size_t)(row0 + ai * HALF + m * 16) * ldc + col0;
#pragma unroll
                for (int bj = 0; bj < 2; ++bj) { f32x4 g0, g1; unpack8(*(const u32x4*)(G + ro + bj * HALF), g0, g1);
                    f32x4 v0 = acc[ai][bj][m][0] * g0, v1 = acc[ai][bj][m][1] * g1;
                    if (T) { f32x4 t0, t1; unpack8(*(const u32x4*)(T + ro + bj * HALF), t0, t1); v0 = v0 + t0; v1 = v1 + t1; }
                    *(u32x4*)(O + ro + bj * HALF) = pack8(v0, v1); } }
    }
};
struct EpiResid {
    static constexpr bool PERM = false, AFTER_DRAIN = false;
    float* C; const float* base; const float* gate; int ldc, gpitch;
    __device__ __forceinline__ void operator()(const f32x4 (&acc)[2][2][4][2], const Unit& u, int wr, int wc, int fr, int fq) const {
        const int row0 = u.pm * BM + wr * 64 + fr, col0 = u.pn * BM + wc * 32 + 4 * fq;
        const float* gp = gate + (size_t)((u.pm * BM) >> 11) * gpitch + col0;
        f32x4 gv[2][2];
#pragma unroll
        for (int bj = 0; bj < 2; ++bj)
#pragma unroll
            for (int n = 0; n < 2; ++n) gv[bj][n] = *(const f32x4*)(gp + bj * HALF + n * 16);
#pragma unroll
        for (int ai = 0; ai < 2; ++ai)
#pragma unroll
            for (int m = 0; m < 4; ++m) { const size_t ro = (size_t)(row0 + ai * HALF + m * 16) * ldc + col0;
#pragma unroll
                for (int bj = 0; bj < 2; ++bj)
#pragma unroll
                    for (int n = 0; n < 2; ++n) *(f32x4*)(C + ro + bj * HALF + n * 16) = *(const f32x4*)(base + ro + bj * HALF + n * 16) + gv[bj][n] * acc[ai][bj][m][n]; }
    }
};
struct EpiSwiGLU {
    static constexpr bool PERM = false, AFTER_DRAIN = false;
    bf16_t* O; int ldc;
    __device__ __forceinline__ void operator()(const f32x4 (&acc)[2][2][4][2], const Unit& u, int wr, int wc, int fr, int fq) const {
        const int row0 = u.pm * BM + wr * 64 + fr, col0 = u.pn * 128 + wc * 32 + 8 * fq;
#pragma unroll
        for (int ai = 0; ai < 2; ++ai)
#pragma unroll
            for (int m = 0; m < 4; ++m) { f32x4 o[2];
#pragma unroll
                for (int bj = 0; bj < 2; ++bj) { const f32x4 gt = acc[ai][bj][m][0], up = acc[ai][bj][m][1];
#pragma unroll
                    for (int j = 0; j < 4; ++j) o[bj][j] = gt[j] * sigmoidf_(gt[j]) * up[j]; }
                *(u32x4*)(O + (size_t)(row0 + ai * HALF + m * 16) * ldc + col0) = pack8(o[0], o[1]); }
    }
};
struct EpiRowScale {
    static constexpr bool PERM = true, AFTER_DRAIN = false;
    bf16_t* O; const float* rs; int ldc;
    __device__ __forceinline__ void operator()(const f32x4 (&acc)[2][2][4][2], const Unit& u, int wr, int wc, int fr, int fq) const {
        const int row0 = u.pm * BM + wr * 64 + fr, col0 = u.pn * BM + wc * 32 + 8 * fq;
#pragma unroll
        for (int ai = 0; ai < 2; ++ai)
#pragma unroll
            for (int m = 0; m < 4; ++m) { const int row = row0 + ai * HALF + m * 16; const float s = rs[row];
#pragma unroll
                for (int bj = 0; bj < 2; ++bj) *(u32x4*)(O + (size_t)row * ldc + col0 + bj * HALF) = pack8(acc[ai][bj][m][0] * s, acc[ai][bj][m][1] * s); }
    }
};


struct StaticOrder {
    int nM, nN, nwg, G, c;
    __host__ __device__ void init(int M, int N, int G_, int c_) { nM = M / BM; nN = N / BM; nwg = nM * nN; G = G_; c = c_; }
    __host__ __device__ bool next(int i, Unit& u) const {
        const long L = (long)i * G + c; if (L >= nwg) return false;
        int wgid = (int)L; { const int q = nwg / NXCD, r = nwg % NXCD, xcd = wgid % NXCD, off = wgid / NXCD; wgid = (xcd < r ? xcd * (q + 1) : r * (q + 1) + (xcd - r) * q) + off; }
        const int nig = WGM * nN, gid = wgid / nig, fm = gid * WGM, gsz = (nM - fm) < WGM ? (nM - fm) : WGM;
        u.pm = fm + ((wgid % nig) % gsz); u.pn = (wgid % nig) / gsz; return true;
    }
    __device__ __forceinline__ void a_ready(const Unit&) const {}
    __device__ __forceinline__ void done(const Unit&) const {}
};

template <class Epi, class Sched, bool ALIGN_EPI = false, bool SP2 = false>
__device__ __forceinline__ void gemm_phase(PG8_LAS unsigned char* lds, const Gemm g, const Sched& S, const Epi& E) {
    const int tid = threadIdx.x, wid = __builtin_amdgcn_readfirstlane(tid >> 6), lane = tid & 63, wr = wid >> 2, wc = wid & 3, fr = lane & 15, fq = lane >> 4;
    const int K = g.K, nt = K / BK;
    unsigned voffA[2], voffB[2];
#pragma unroll
    for (int i = 0; i < 2; ++i) { int R, C; stage_rc(tid * 16 + i * 8192, R, C); const int Rb = Epi::PERM ? ((R & ~31) + perm32(R & 31)) : R;
        voffA[i] = (unsigned)(R * g.lda + C) * 2u; voffB[i] = (unsigned)(Rb * g.ldb + C) * 2u; }
    const size_t kstep = (size_t)(BK * 2);
    const size_t hstepA = (size_t)HALF * g.lda * 2, hstepB = (size_t)HALF * g.ldb * 2;
    const size_t tstepA = 2 * hstepA, tstepB = 2 * hstepB;
    const unsigned ldsw = (unsigned)wid * 1024u;
    const int aoff = lds_byte(wr * 64 + fr, fq * 8), boff = lds_byte(wc * 32 + fr, fq * 8);
#define PG8_SA(b, h) (((b) * 2 + (h)) * HTB)
#define PG8_SB(b, h) ((4 + (b) * 2 + (h)) * HTB)
#define PG8_STAGE(bufoff, gbase, voff) do { _Pragma("unroll") for (int _i = 0; _i < 2; ++_i) \
        __builtin_amdgcn_global_load_lds((const unsigned*)((const char*)(gbase) + (voff)[_i]), (PG8_LAS unsigned*)(lds + (bufoff) + ldsw + _i * 8192), 16, 0, 0); } while (0)
#define PG8_LDA(dst, b, h) do { _Pragma("unroll") for (int m = 0; m < 4; ++m) _Pragma("unroll") for (int k = 0; k < 2; ++k) dst[m][k] = *(const PG8_LAS bf16x8*)(lds + PG8_SA(b, h) + aoff + m * 2048 + k * 1024); } while (0)
#define PG8_LDB(dst, b, h) do { _Pragma("unroll") for (int n = 0; n < 2; ++n) _Pragma("unroll") for (int k = 0; k < 2; ++k) dst[n][k] = *(const PG8_LAS bf16x8*)(lds + PG8_SB(b, h) + boff + n * 2048 + k * 1024); } while (0)
#define PG8_MMA(ai, bj, At, Bt) do { __builtin_amdgcn_s_setprio(1); _Pragma("unroll") for (int m = 0; m < 4; ++m) _Pragma("unroll") for (int n = 0; n < 2; ++n) _Pragma("unroll") for (int k = 0; k < 2; ++k) \
        acc[ai][bj][m][n] = __builtin_amdgcn_mfma_f32_16x16x32_bf16(Bt[n][k], At[m][k], acc[ai][bj][m][n], 0, 0, 0); __builtin_amdgcn_s_setprio(0); } while (0)
#define PG8_WAIT_V(n) asm volatile("s_waitcnt vmcnt(" #n ")" ::: "memory")
#define PG8_WAIT_L(n) asm volatile("s_waitcnt lgkmcnt(" #n ")" ::: "memory")
#define PG8_BAR __builtin_amdgcn_s_barrier()
#define PG8_SCHED __builtin_amdgcn_sched_barrier(0)
    Unit cur, nxt; int ui = 0;
    if (!S.next(0, cur)) return;
    f32x4 acc[2][2][4][2];
#pragma unroll
    for (int a = 0; a < 2; ++a)
#pragma unroll
        for (int b = 0; b < 2; ++b)
#pragma unroll
            for (int m = 0; m < 4; ++m)
#pragma unroll
                for (int n = 0; n < 2; ++n) acc[a][b][m][n] = (f32x4){0.f, 0.f, 0.f, 0.f};
    bf16x8 At[4][2], B0[2][2], B1[2][2];
    const char* cA = (const char*)g.A + (size_t)cur.pm * tstepA; const char* cB = (const char*)g.Bt + (size_t)(cur.pm / g.gdiv) * g.gstride + (size_t)cur.pn * tstepB;
    S.a_ready(cur);
    if constexpr (SP2) {
        PG8_STAGE(PG8_SB(0, 0), cB, voffB); PG8_STAGE(PG8_SB(0, 1), cB + hstepB, voffB); PG8_STAGE(PG8_SA(0, 0), cA, voffA); PG8_STAGE(PG8_SA(0, 1), cA + hstepA, voffA);
        if (wr == 1) PG8_BAR;
        PG8_WAIT_V(2); PG8_BAR;
        PG8_STAGE(PG8_SB(1, 0), cB + kstep, voffB); PG8_STAGE(PG8_SA(1, 0), cA + kstep, voffA); PG8_STAGE(PG8_SB(1, 1), cB + hstepB + kstep, voffB);
        PG8_WAIT_V(6); PG8_BAR;
    } else {
        PG8_STAGE(PG8_SB(0, 0), cB, voffB); PG8_STAGE(PG8_SA(0, 0), cA, voffA); PG8_STAGE(PG8_SB(0, 1), cB + hstepB, voffB); PG8_STAGE(PG8_SA(0, 1), cA + hstepA, voffA);
        if (wr == 1) PG8_BAR;
        PG8_WAIT_V(4); PG8_BAR;
        PG8_STAGE(PG8_SB(1, 0), cB + kstep, voffB); PG8_STAGE(PG8_SA(1, 0), cA + kstep, voffA); PG8_STAGE(PG8_SB(1, 1), cB + hstepB + kstep, voffB);
        PG8_WAIT_V(6); PG8_BAR;
    }
    for (;;) {
        const bool has_next = S.next(ui + 1, nxt);
        const char* nA = has_next ? (const char*)g.A + (size_t)nxt.pm * tstepA : cA; const char* nB = has_next ? (const char*)g.Bt + (size_t)(nxt.pm / g.gdiv) * g.gstride + (size_t)nxt.pn * tstepB : cB;
        for (int t = 0; t < nt; t += 2) {
            const bool last = (t == nt - 2);
            const char* a1 = cA + (size_t)(t + 1) * kstep;
            const char* a2 = last ? nA : cA + (size_t)(t + 2) * kstep; const char* b2 = last ? nB : cB + (size_t)(t + 2) * kstep;
            const char* a3 = a2 + kstep; const char* b3 = b2 + kstep;
            if (last && has_next) S.a_ready(nxt);
            if constexpr (SP2) {
            PG8_LDB(B0, 0, 0); PG8_LDB(B1, 0, 1); PG8_SCHED; PG8_LDA(At, 0, 0); PG8_STAGE(PG8_SA(1, 1), a1 + hstepA, voffA);
            PG8_WAIT_V(8); PG8_WAIT_L(0); PG8_BAR; PG8_MMA(0, 0, At, B0); PG8_MMA(0, 1, At, B1); PG8_BAR; PG8_SCHED;
            PG8_LDA(At, 0, 1); PG8_STAGE(PG8_SB(0, 0), b2, voffB); PG8_STAGE(PG8_SB(0, 1), b2 + hstepB, voffB); PG8_STAGE(PG8_SA(0, 0), a2, voffA);
            PG8_WAIT_V(8); PG8_WAIT_L(0); PG8_BAR; PG8_MMA(1, 0, At, B0); PG8_MMA(1, 1, At, B1); PG8_BAR; PG8_SCHED;
            PG8_LDB(B0, 1, 0); PG8_LDB(B1, 1, 1); PG8_SCHED; PG8_LDA(At, 1, 0); PG8_STAGE(PG8_SA(0, 1), a2 + hstepA, voffA);
            PG8_WAIT_V(8); PG8_WAIT_L(0); PG8_BAR; PG8_MMA(0, 0, At, B0); PG8_MMA(0, 1, At, B1); PG8_BAR; PG8_SCHED;
            PG8_LDA(At, 1, 1); PG8_STAGE(PG8_SB(1, 0), b3, voffB); PG8_STAGE(PG8_SB(1, 1), b3 + hstepB, voffB); PG8_STAGE(PG8_SA(1, 0), a3, voffA);
            PG8_WAIT_V(8); PG8_WAIT_L(0); PG8_BAR; PG8_MMA(1, 0, At, B0); PG8_MMA(1, 1, At, B1); PG8_BAR; PG8_SCHED;
            } else {
            PG8_LDB(B0, 0, 0); PG8_SCHED; PG8_LDA(At, 0, 0); PG8_STAGE(PG8_SA(1, 1), a1 + hstepA, voffA);
            PG8_WAIT_L(8); PG8_BAR; PG8_WAIT_L(0); PG8_MMA(0, 0, At, B0); PG8_BAR; PG8_SCHED;
            PG8_LDB(B1, 0, 1); PG8_STAGE(PG8_SB(0, 0), b2, voffB);
            PG8_BAR; PG8_WAIT_L(0); PG8_MMA(0, 1, At, B1); PG8_BAR;
            PG8_LDA(At, 0, 1); PG8_STAGE(PG8_SA(0, 0), a2, voffA);
            PG8_BAR; PG8_WAIT_L(0); PG8_MMA(1, 0, At, B0); PG8_BAR; PG8_SCHED;
            PG8_STAGE(PG8_SB(0, 1), b2 + hstepB, voffB);
            PG8_WAIT_V(6); PG8_BAR; PG8_MMA(1, 1, At, B1); PG8_BAR;
            PG8_LDB(B0, 1, 0); PG8_SCHED; PG8_LDA(At, 1, 0); PG8_STAGE(PG8_SA(0, 1), a2 + hstepA, voffA);
            PG8_WAIT_L(8); PG8_BAR; PG8_WAIT_L(0); PG8_MMA(0, 0, At, B0); PG8_BAR; PG8_SCHED;
            PG8_LDB(B1, 1, 1); PG8_STAGE(PG8_SB(1, 0), b3, voffB);
            PG8_BAR; PG8_WAIT_L(0); PG8_MMA(0, 1, At, B1); PG8_BAR;
            PG8_LDA(At, 1, 1); PG8_STAGE(PG8_SA(1, 0), a3, voffA);
            PG8_BAR; PG8_WAIT_L(0); PG8_MMA(1, 0, At, B0); PG8_BAR; PG8_SCHED;
            PG8_STAGE(PG8_SB(1, 1), b3 + hstepB, voffB);
            PG8_WAIT_V(6); PG8_BAR; PG8_MMA(1, 1, At, B1); PG8_BAR;
            }
        }
        if constexpr (ALIGN_EPI) { if (wr == 0) PG8_BAR; }
        if constexpr (!Epi::AFTER_DRAIN) { E(acc, cur, wr, wc, fr, fq); S.done(cur); }
        if (!has_next) break;
#pragma unroll
        for (int a = 0; a < 2; ++a)
#pragma unroll
            for (int b = 0; b < 2; ++b)
#pragma unroll
                for (int m = 0; m < 4; ++m)
#pragma unroll
                    for (int n = 0; n < 2; ++n) acc[a][b][m][n] = (f32x4){0.f, 0.f, 0.f, 0.f};
        cur = nxt; cA = nA; cB = nB; ++ui;
        if constexpr (ALIGN_EPI) { if (wr == 1) PG8_BAR; }
    }
    PG8_WAIT_V(0);
    if constexpr (!ALIGN_EPI) { if (wr == 0) PG8_BAR; }
    PG8_BAR;
    if constexpr (Epi::AFTER_DRAIN) { E.fused(acc, cur, wr, wc, fr, fq, lds, wid, lane); S.done(cur); }
#undef PG8_SA
#undef PG8_SB
#undef PG8_STAGE
#undef PG8_LDA
#undef PG8_LDB
#undef PG8_MMA
#undef PG8_WAIT_V
#undef PG8_WAIT_L
#undef PG8_BAR
#undef PG8_SCHED
}
}

#define GAS __attribute__((address_space(1)))
#define LAS __attribute__((address_space(3)))
typedef unsigned short bf16;
typedef unsigned v4u __attribute__((ext_vector_type(4)));
typedef float f32x4 __attribute__((ext_vector_type(4)));
typedef short bf16x8 __attribute__((ext_vector_type(8)));
typedef GAS unsigned gu32;
typedef GAS unsigned long long gu64;
#define RLX_AGENT __ATOMIC_RELAXED, __HIP_MEMORY_SCOPE_AGENT
#define LDS_WAIT() asm volatile("s_waitcnt lgkmcnt(0)" ::: "memory")
#define VM_WAIT() asm volatile("s_waitcnt vmcnt(0)" ::: "memory")
__device__ __forceinline__ unsigned long long rt() { return __builtin_amdgcn_s_memrealtime(); }
__device__ __forceinline__ unsigned f2bf(float f) { unsigned u = __builtin_bit_cast(unsigned, f); return (u + 0x7fffu + ((u >> 16) & 1u)) >> 16; }
__device__ __forceinline__ unsigned pk2(float lo, float hi) { return f2bf(lo) | (f2bf(hi) << 16); }

#define XB_TMO      128
#define XB_XCNT(j)  (256  + 64 * (j))
#define XB_XSUB(j)  (1280 + 64 * (j))
#define XB_XGEN(j)  (2304 + 64 * (j))
#define XB_TOP      3328
#define XB_TOPGEN   3392
#define XCD_BAR_WORDS 3456
#define XB_SPIN_CAP (1u << 18)

__device__ __forceinline__ unsigned xb_ld(unsigned* p)              { return __hip_atomic_load(p, __ATOMIC_RELAXED, __HIP_MEMORY_SCOPE_AGENT); }
__device__ __forceinline__ unsigned xb_add(unsigned* p, unsigned v) { return __hip_atomic_fetch_add(p, v, __ATOMIC_RELAXED, __HIP_MEMORY_SCOPE_AGENT); }
__device__ __forceinline__ unsigned xb_xcc_id() { return (unsigned)__builtin_amdgcn_s_getreg((3 << 11) | 20) & 0xFu; }
#define XB_SPIN(cond, bar) do { unsigned _sp = 0; while (cond) { __builtin_amdgcn_s_sleep(1); \
    if ((++_sp & 255u) == 0u) { if (xb_ld(&(bar)[XB_TMO])) break; if (_sp > XB_SPIN_CAP) { atomicAdd(&(bar)[XB_TMO], 1u); break; } } } } while (0)

struct XcdBarrier {
    unsigned* bar; unsigned x;
    volatile LAS unsigned* st;
};

__device__ __forceinline__ XcdBarrier xcd_barrier_post(unsigned* bar, volatile LAS unsigned* st) {
    XcdBarrier b; b.bar = bar; b.x = xb_xcc_id(); b.st = st;
    if (threadIdx.x == 0) (void)xb_add(&bar[XB_XCNT(b.x)], 1u);
    return b;
}
__device__ __forceinline__ void xcd_barrier_complete(unsigned* bar, unsigned x, unsigned& nloc, unsigned& nx) {
    const unsigned G = gridDim.x * gridDim.y * gridDim.z;
    unsigned sum, cnt, mine, sp = 0u;
    for (;;) {
        sum = 0u; cnt = 0u; mine = 0u;
#pragma unroll
        for (unsigned j = 0; j < 16; ++j) { const unsigned c = xb_ld(&bar[XB_XCNT(j)]); sum += c; cnt += (c > 0u) ? 1u : 0u; mine = (j == x) ? c : mine; }
        if (sum == G) break;
        __builtin_amdgcn_s_sleep(1);
        if ((++sp & 255u) == 0u) { if (xb_ld(&bar[XB_TMO])) break; if (sp > XB_SPIN_CAP) { atomicAdd(&bar[XB_TMO], 1u); break; } }
    }
    nloc = mine > 0u ? mine : 1u; nx = cnt > 0u ? cnt : 1u;
}

__device__ __forceinline__ void xcd_barrier(const XcdBarrier& b) {
    asm volatile("s_waitcnt vmcnt(0)" ::: "memory");
    __syncthreads();
    if (threadIdx.x == 0) {
        unsigned* bar = b.bar;
        __builtin_amdgcn_s_waitcnt(0);
        unsigned nloc = b.st[0], nx = b.st[1];
        if (nloc == 0u) { xcd_barrier_complete(bar, b.x, nloc, nx); b.st[0] = nloc; b.st[1] = nx; }
        const unsigned old = xb_add(&bar[XB_XSUB(b.x)], 1u);
        const unsigned gen = old / nloc;
        if (old + 1u == (gen + 1u) * nloc) {
            __builtin_amdgcn_fence(__ATOMIC_RELEASE, "agent");
            asm volatile("s_waitcnt vmcnt(0)" ::: "memory");
            const unsigned og = xb_add(&bar[XB_TOP], 1u);
            const unsigned tg = og / nx;
            if (og + 1u == (tg + 1u) * nx) xb_add(&bar[XB_TOPGEN], 1u);
            else XB_SPIN(xb_ld(&bar[XB_TOPGEN]) == tg, bar);
            __builtin_amdgcn_fence(__ATOMIC_ACQUIRE, "agent");
            xb_add(&bar[XB_XGEN(b.x)], 1u);
            asm volatile("s_waitcnt vmcnt(0)" ::: "memory");
        } else {
            XB_SPIN(xb_ld(&bar[XB_XGEN(b.x)]) == gen, bar);
            __builtin_amdgcn_fence(__ATOMIC_ACQUIRE, "agent");
            asm volatile("s_waitcnt vmcnt(0)" ::: "memory");
        }
    }
    __syncthreads();
}

constexpr int NWAVES = 8;
constexpr int NB = 8, SEQ = 2048, D = 1024, M = NB * SEQ;
constexpr int NIN = 5632, NE = 16, CAP = 256, MS = NE * NB * CAP;
constexpr float EPS = 1e-6f;
constexpr float LOG2E = 1.4426950408889634f;
constexpr size_t MiB = 1u << 20;
constexpr size_t WS_CTL = 0, CTL_ZERO_BYTES = 1 * MiB;
constexpr size_t WS_MOD = 1 * MiB;
constexpr size_t WS_CS = 1 * MiB + 256 * 1024;
constexpr size_t WS_AFF = 3 * MiB;
constexpr size_t WS_INV = 4 * MiB;
constexpr size_t WS_SELG = 5 * MiB;
constexpr size_t WS_WIN = 6 * MiB;
constexpr size_t WS_WCAT = 17 * MiB;
constexpr size_t WS_WO = 19 * MiB;
constexpr size_t WS_WGU = 21 * MiB;
constexpr size_t WS_WD = 85 * MiB;
constexpr size_t WS_ACT0 = 117 * MiB;
constexpr size_t WS_RQ = 117 * MiB, WS_RK = 133 * MiB, WS_RV = 149 * MiB, WS_RG = 165 * MiB;
constexpr size_t WS_DQ1 = 181 * MiB;
constexpr size_t WS_DV = 213 * MiB;
constexpr size_t WS_GR = 229 * MiB, WS_GD = 261 * MiB;
constexpr size_t WS_END = 293 * MiB;
constexpr size_t WS_T1 = 117 * MiB;
constexpr size_t WS_MERGED = 149 * MiB;
constexpr size_t WS_H2 = 181 * MiB;
constexpr size_t WS_XG = 117 * MiB;
constexpr size_t WS_ACT = 213 * MiB;
constexpr size_t WS_YS = 117 * MiB;
constexpr int CW_TMO = 0, CW_CODE = 1, CW_BAR = 4096;
constexpr int RING_OFF = 0, RING_BYTES = 131072;
constexpr int LDSCTL_OFF = RING_BYTES, MISC_OFF = LDSCTL_OFF + 320;
constexpr int QS_OFF = RING_BYTES + 1024;
constexpr int LDS_BYTES = 147456;

typedef unsigned v2u __attribute__((ext_vector_type(2)));
typedef float f32x2 __attribute__((ext_vector_type(2)));
struct Frame {
    LAS unsigned char* lds;
    volatile LAS unsigned* MISC;
    gu32* ctl;
    int tid, lane, wave;
    int vcu, G;
    const float* in[22]; float* out; unsigned char* ws;
};
__device__ __forceinline__ float wave_sum(float v) {
#pragma unroll
    for (int o = 1; o < 64; o <<= 1) v += __shfl_xor(v, o);
    return v;
}
__device__ __forceinline__ float wave_max(float v) {
#pragma unroll
    for (int o = 1; o < 64; o <<= 1) v = fmaxf(v, __shfl_xor(v, o));
    return v;
}
__device__ __forceinline__ float bf2f_lo(unsigned w) { return __builtin_bit_cast(float, w << 16); }
__device__ __forceinline__ float bf2f_hi(unsigned w) { return __builtin_bit_cast(float, w & 0xffff0000u); }
__device__ __forceinline__ float bf2f(bf16 h) { return __builtin_bit_cast(float, ((unsigned)h) << 16); }
__device__ __forceinline__ float sigm(float v) { return __builtin_amdgcn_rcpf(1.0f + __builtin_amdgcn_exp2f(-LOG2E * v)); }
__device__ __forceinline__ float silu_exact(float v) { return v / (1.0f + __expf(-v)); }

__device__ __forceinline__ int gu_base(int o) { return (o >> 7) * 256 + ((o >> 2) & 1) * 128 + ((o >> 5) & 3) * 32 + ((o >> 3) & 3) * 4 + (o & 3); }
__device__ __forceinline__ void p0_transpose_item(const float* W, int N, bf16* WT, int dpitch, int kcol_off, int k0, int n0, int mode, int row_off, LAS float* scr, int lane) {
#pragma unroll 8
    for (int i = 0; i < 32; ++i) { const int kk = 2 * i + (lane >> 5); scr[kk * 33 + (lane & 31)] = W[(size_t)(k0 + kk) * N + n0 + (lane & 31)]; }
    LDS_WAIT(); asm volatile("" ::: "memory");
    const int c = lane & 7;
#pragma unroll
    for (int j = 0; j < 4; ++j) { const int n = (lane >> 3) + 8 * j; const LAS float* s = scr + (8 * c) * 33 + n;
        v4u o; o.x = pk2(s[0 * 33], s[1 * 33]); o.y = pk2(s[2 * 33], s[3 * 33]); o.z = pk2(s[4 * 33], s[5 * 33]); o.w = pk2(s[6 * 33], s[7 * 33]);
        const int drow = row_off + (mode ? gu_base(n0 + n) : (n0 + n));
        *(GAS v4u*)(WT + (size_t)drow * dpitch + kcol_off + k0 + 8 * c) = o; }
    LDS_WAIT(); asm volatile("" ::: "memory");
}
__device__ __forceinline__ void p0_prologue(Frame& F) {
    if (blockIdx.x < 96) {
        LAS float* sc = (LAS float*)(F.lds);
        LAS float* red = (LAS float*)(F.lds + 32768);
        const float* cin = F.in[1];
        for (int idx = F.tid; idx < 8192; idx += 512) { const int b = idx >> 10, k = idx & 1023; sc[k * 8 + b] = silu_exact(cin[idx]); }
        __syncthreads();
        const int j0 = blockIdx.x * 64; const float* wa = F.in[2] + j0 + F.lane;
        float a[8];
#pragma unroll
        for (int b = 0; b < 8; ++b) a[b] = 0.f;
        const int kb = F.wave * 128;
#pragma unroll 8
        for (int k = 0; k < 128; ++k) { const float wv = wa[(size_t)(kb + k) * 6144]; const f32x4 s0 = *(const LAS f32x4*)(sc + (kb + k) * 8), s1 = *(const LAS f32x4*)(sc + (kb + k) * 8 + 4);
            a[0] += s0[0] * wv; a[1] += s0[1] * wv; a[2] += s0[2] * wv; a[3] += s0[3] * wv; a[4] += s1[0] * wv; a[5] += s1[1] * wv; a[6] += s1[2] * wv; a[7] += s1[3] * wv; }
#pragma unroll
        for (int b = 0; b < 8; ++b) red[(F.wave * 8 + b) * 64 + F.lane] = a[b];
        __syncthreads();
        { const int b = F.wave; float s = F.in[3][j0 + F.lane];
#pragma unroll
          for (int w = 0; w < 8; ++w) s += red[(w * 8 + b) * 64 + F.lane];
          ((float*)(F.ws + WS_MOD))[b * 6144 + j0 + F.lane] = s; }
        __syncthreads();
    }
    { float* cs = (float*)(F.ws + WS_CS);
      for (int idx = blockIdx.x * 512 + F.tid; idx < 2048 * 64; idx += F.G * 512) { const int pos = idx >> 6, i = idx & 63;
          double inv = 1.0, r = 0.8639884494839686; int e = i;
          for (int t = 0; t < 6; ++t) { if (e & 1) inv *= r; r *= r; e >>= 1; }
          const float ang = (float)pos * (float)inv;
          const double rev = (double)ang * 0.15915494309189535; const float fr = (float)(rev - __builtin_rint(rev));
          cs[2 * idx] = __builtin_amdgcn_cosf(fr); cs[2 * idx + 1] = __builtin_amdgcn_sinf(fr); } }
    LAS float* scr = (LAS float*)(F.lds + RING_OFF + F.wave * 16384);
    const int gw = F.vcu * NWAVES + F.wave, NGW = F.G * NWAVES;
    constexpr int I_IN = 16 * 176, I_RO = 8 * 32, I_WO = 16 * 32, I_EX = 16 * 32;
    constexpr int NITEMS = I_IN + 2 * I_RO + I_WO + 48 * I_EX;
    for (int it = gw; it < NITEMS; it += NGW) {
        int r = it;
        if (r < I_IN) { p0_transpose_item(F.in[5], NIN, (bf16*)(F.ws + WS_WIN), 1024, 0, 64 * (r / 176), 32 * (r % 176), 0, 0, scr, F.lane); continue; } r -= I_IN;
        if (r < I_RO) { p0_transpose_item(F.in[12], 1024, (bf16*)(F.ws + WS_WCAT), 1024, 0, 64 * (r / 32), 32 * (r % 32), 0, 0, scr, F.lane); continue; } r -= I_RO;
        if (r < I_RO) { p0_transpose_item(F.in[13], 1024, (bf16*)(F.ws + WS_WCAT), 1024, 512, 64 * (r / 32), 32 * (r % 32), 0, 0, scr, F.lane); continue; } r -= I_RO;
        if (r < I_WO) { p0_transpose_item(F.in[14], 1024, (bf16*)(F.ws + WS_WO), 1024, 0, 64 * (r / 32), 32 * (r % 32), 0, 0, scr, F.lane); continue; } r -= I_WO;
        const int mat = r / I_EX, q = r % I_EX, ty = mat >> 4, e = mat & 15; const int k0 = 64 * (q / 32), n0 = 32 * (q % 32);
        if (ty == 0)      p0_transpose_item(F.in[18] + (size_t)e * 1048576, 1024, (bf16*)(F.ws + WS_WGU), 1024, 0, k0, n0, 1, e * 2048, scr, F.lane);
        else if (ty == 1) p0_transpose_item(F.in[19] + (size_t)e * 1048576, 1024, (bf16*)(F.ws + WS_WGU), 1024, 0, k0, n0, 1, e * 2048 + 16, scr, F.lane);
        else              p0_transpose_item(F.in[20] + (size_t)e * 1048576, 1024, (bf16*)(F.ws + WS_WD), 1024, 0, k0, n0, 0, e * 1024, scr, F.lane);
    }
}
__device__ __forceinline__ void p1_norm(Frame& F, bf16* XN) {
    const int gw = F.vcu * NWAVES + F.wave, NGW = F.G * NWAVES;
    const float* mod = (const float*)(F.ws + WS_MOD);
    for (int m = gw; m < M; m += NGW) {
        const int b = m >> 11;
        const f32x4* xr = (const f32x4*)(F.in[0] + (size_t)m * D) + F.lane;
        const f32x4* gp = (const f32x4*)(F.in[4]) + F.lane;
        const f32x4* shp = (const f32x4*)(mod + b * 6144) + F.lane;
        const f32x4* scp = (const f32x4*)(mod + b * 6144 + 1024) + F.lane;
        f32x4 v[4]; float s = 0.f;
#pragma unroll
        for (int j = 0; j < 4; ++j) { v[j] = xr[64 * j]; s += (v[j].x * v[j].x + v[j].y * v[j].y) + (v[j].z * v[j].z + v[j].w * v[j].w); }
        const float rstd = 1.0f / sqrtf(wave_sum(s) * (1.f / D) + EPS);
        unsigned long long* o8 = (unsigned long long*)(XN + (size_t)m * D) + F.lane;
#pragma unroll
        for (int j = 0; j < 4; ++j) { const f32x4 g = gp[64 * j], sh = shp[64 * j], sc = scp[64 * j]; const f32x4 h = (v[j] * rstd) * g * (sc + 1.0f) + sh;
            o8[64 * j] = (unsigned long long)pk2(h.x, h.y) | ((unsigned long long)pk2(h.z, h.w) << 32); }
    }
}
__device__ __forceinline__ int t5_bucket(int rel) {
    const int n = rel < 0 ? -rel : rel; int bk;
    if (n < 8) bk = n; else if (n < 12) bk = 8; else if (n < 16) bk = 9; else if (n < 23) bk = 10; else if (n < 32) bk = 11; else if (n < 46) bk = 12; else if (n < 64) bk = 13; else if (n < 91) bk = 14; else bk = 15;
    return bk + (rel > 0 ? 16 : 0);
}
__device__ __forceinline__ float ln1m(float x) { return -x * (1.f + x * (0.5f + x * (0.33333334f + x * (0.25f + x * (0.2f + x * (0.16666667f + x * 0.14285715f)))))); }
template <int MODE>
__device__ __forceinline__ void naive_unit(Frame& F, int unit, float lam, bf16* YCAT) {
    const int b = unit >> 10, h = (unit >> 8) & 3, q0 = (unit & 255) * 8;
    LAS float* S = (LAS float*)(F.lds);
    unsigned qs_off = QS_OFF; asm volatile("" : "+v"(qs_off));
    LAS float* Qs = (LAS float*)(F.lds + qs_off);
    LAS float* BT = Qs + 1024;
    const bf16* RQ = (const bf16*)(F.ws + WS_RQ); const bf16* RK = (const bf16*)(F.ws + WS_RK); const bf16* RV = (const bf16*)(F.ws + WS_RV); const bf16* RG = (const bf16*)(F.ws + WS_RG);
    const bf16* DQ1 = (const bf16*)(F.ws + WS_DQ1); const bf16* DQ2 = DQ1 + (size_t)M * 256; const bf16* DK1 = DQ2 + (size_t)M * 256; const bf16* DK2 = DK1 + (size_t)M * 256;
    const bf16* DV = (const bf16*)(F.ws + WS_DV);
    const size_t rb = (size_t)b * SEQ;
    for (int idx = F.tid; idx < 1024; idx += 512) { const int qi = idx >> 7, d = idx & 127; const size_t row = rb + q0 + qi;
        float v;
        if (MODE == 0) v = bf2f(RQ[row * 512 + h * 128 + d]);
        else v = d < 64 ? bf2f(DQ1[row * 256 + h * 64 + d]) : bf2f(DQ2[row * 256 + h * 64 + d - 64]);
        Qs[idx] = v; }
    if (MODE == 1 && F.tid < 32) BT[F.tid] = F.in[15][F.tid * 4 + h] * LOG2E;
    __syncthreads();
    float l2f, l2b;
    { const float xf = __builtin_amdgcn_exp2f(-5.0f - (float)h); l2f = ln1m(xf) * LOG2E; l2b = ln1m(xf * 0.70710678118654752f) * LOG2E; }
    for (int j = F.tid; j < SEQ; j += 512) {
        asm volatile("" ::: "memory");
        float s1[8], s2[8];
#pragma unroll
        for (int qi = 0; qi < 8; ++qi) { s1[qi] = 0.f; s2[qi] = 0.f; }
#pragma unroll 1
        for (int c = 0; c < 16; ++c) {
            const bf16* kp;
            if (MODE == 0) kp = RK + (rb + j) * 512 + h * 128 + c * 8;
            else kp = (c < 8) ? (DK1 + (rb + j) * 256 + h * 64 + c * 8) : (DK2 + (rb + j) * 256 + h * 64 + (c - 8) * 8);
            const v4u kw = *(const v4u*)kp;
            const float kf[8] = {bf2f_lo(kw.x), bf2f_hi(kw.x), bf2f_lo(kw.y), bf2f_hi(kw.y), bf2f_lo(kw.z), bf2f_hi(kw.z), bf2f_lo(kw.w), bf2f_hi(kw.w)};
            float t[8];
#pragma unroll
            for (int qi = 0; qi < 8; ++qi) { const f32x4 qa = *(const LAS f32x4*)(Qs + qi * 128 + c * 8), qb = *(const LAS f32x4*)(Qs + qi * 128 + c * 8 + 4);
                t[qi] = (qa[0] * kf[0] + qa[1] * kf[1]) + (qa[2] * kf[2] + qa[3] * kf[3]) + (qb[0] * kf[4] + qb[1] * kf[5]) + (qb[2] * kf[6] + qb[3] * kf[7]); }
            if (MODE == 1 && c >= 8) {
#pragma unroll
                for (int qi = 0; qi < 8; ++qi) s2[qi] += t[qi];
            } else {
#pragma unroll
                for (int qi = 0; qi < 8; ++qi) s1[qi] += t[qi];
            }
        }
#pragma unroll
        for (int qi = 0; qi < 8; ++qi) { const int i = q0 + qi;
            if (MODE == 0) { const float w = (j <= i) ? __builtin_amdgcn_exp2f((float)(i - j) * l2f) : __builtin_amdgcn_exp2f((float)(j - i) * l2b); S[qi * SEQ + j] = s1[qi] * w; }
            else { const float bias = BT[t5_bucket(j - i)]; S[qi * SEQ + j] = s1[qi] + bias; S[(8 + qi) * SEQ + j] = s2[qi] + bias; } }
    }
    __syncthreads();
    const int qi = F.wave; LAS float* S1 = S + qi * SEQ; LAS float* S2 = S + (8 + qi) * SEQ;
    if (MODE == 1) {
        float m1 = -3.0e38f, m2 = -3.0e38f;
        for (int j = F.lane; j < SEQ; j += 64) { m1 = fmaxf(m1, S1[j]); m2 = fmaxf(m2, S2[j]); }
        m1 = wave_max(m1); m2 = wave_max(m2);
        float l1 = 0.f, l2 = 0.f;
        for (int j = F.lane; j < SEQ; j += 64) { l1 += __builtin_amdgcn_exp2f(S1[j] - m1); l2 += __builtin_amdgcn_exp2f(S2[j] - m2); }
        l1 = wave_sum(l1); l2 = wave_sum(l2);
        const float r1 = 1.0f / l1, r2 = lam / l2;
        for (int j = F.lane; j < SEQ; j += 64) S1[j] = __builtin_amdgcn_exp2f(S1[j] - m1) * r1 - __builtin_amdgcn_exp2f(S2[j] - m2) * r2;
        LDS_WAIT(); asm volatile("" ::: "memory");
    }
    const bf16* V = (MODE == 0 ? RV : DV) + rb * 512 + h * 128 + 2 * F.lane;
    float o0 = 0.f, o1 = 0.f;
#pragma unroll 8
    for (int j = 0; j < SEQ; ++j) { const float p = S1[j]; const unsigned vv = *(const unsigned*)(V + (size_t)j * 512); o0 += p * bf2f_lo(vv); o1 += p * bf2f_hi(vv); }
    const size_t row = rb + q0 + qi;
    if (MODE == 0) {
        const float mean = wave_sum(o0 + o1) * (1.f / 128.f); const float d0 = o0 - mean, d1 = o1 - mean;
        const float var = wave_sum(d0 * d0 + d1 * d1) * (1.f / 128.f); const float rstd = 1.0f / sqrtf(var + EPS);
        const unsigned gw = *(const unsigned*)(RG + row * 512 + h * 128 + 2 * F.lane);
        const float y0 = d0 * rstd * F.in[6][h * 128 + 2 * F.lane] * bf2f_lo(gw), y1 = d1 * rstd * F.in[6][h * 128 + 2 * F.lane + 1] * bf2f_hi(gw);
        *(unsigned*)(YCAT + row * 1024 + h * 128 + 2 * F.lane) = pk2(y0, y1);
    } else {
        const float ms = wave_sum(o0 * o0 + o1 * o1) * (1.f / 128.f); const float rstd = 1.0f / sqrtf(ms + EPS);
        const float y0 = o0 * rstd * F.in[7][2 * F.lane] * 0.8f, y1 = o1 * rstd * F.in[7][2 * F.lane + 1] * 0.8f;
        *(unsigned*)(YCAT + row * 1024 + 512 + h * 128 + 2 * F.lane) = pk2(y0, y1);
    }
    __syncthreads();
}
__device__ __forceinline__ void p7_router(Frame& F, const float* X1, bf16* H2, float* AFF) {
    LAS float* wr = (LAS float*)(F.lds);
    for (int idx = F.tid; idx < 16384; idx += 512) { const int k = idx >> 4, e = idx & 15; wr[e * 1024 + k] = F.in[17][idx]; }
    __syncthreads();
    const int gw = F.vcu * NWAVES + F.wave, NGW = F.G * NWAVES;
    const float* mod = (const float*)(F.ws + WS_MOD);
    for (int m = gw; m < M; m += NGW) {
        const int b = m >> 11;
        const f32x4* xr = (const f32x4*)(X1 + (size_t)m * D) + F.lane;
        const f32x4* gp = (const f32x4*)(F.in[16]) + F.lane;
        const f32x4* shp = (const f32x4*)(mod + b * 6144 + 3072) + F.lane;
        const f32x4* scp = (const f32x4*)(mod + b * 6144 + 4096) + F.lane;
        f32x4 v[4]; float s = 0.f;
#pragma unroll
        for (int j = 0; j < 4; ++j) { v[j] = xr[64 * j]; s += (v[j].x * v[j].x + v[j].y * v[j].y) + (v[j].z * v[j].z + v[j].w * v[j].w); }
        const float rstd = 1.0f / sqrtf(wave_sum(s) * (1.f / D) + EPS);
        unsigned long long* o8 = (unsigned long long*)(H2 + (size_t)m * D) + F.lane;
#pragma unroll
        for (int j = 0; j < 4; ++j) { const f32x4 g = gp[64 * j], sh = shp[64 * j], sc = scp[64 * j]; v[j] = (v[j] * rstd) * g * (sc + 1.0f) + sh;
            o8[64 * j] = (unsigned long long)pk2(v[j].x, v[j].y) | ((unsigned long long)pk2(v[j].z, v[j].w) << 32); }
        float lg[16];
#pragma unroll
        for (int e = 0; e < 16; ++e) { float a = 0.f;
#pragma unroll
            for (int j = 0; j < 4; ++j) { const f32x4 w = *(const LAS f32x4*)(wr + e * 1024 + 4 * F.lane + 256 * j); a += (v[j].x * w.x + v[j].y * w.y) + (v[j].z * w.z + v[j].w * w.w); }
            lg[e] = wave_sum(a); asm volatile("" ::: "memory"); }
        float mx = lg[0];
#pragma unroll
        for (int e = 1; e < 16; ++e) mx = fmaxf(mx, lg[e]);
        float den = 0.f;
#pragma unroll
        for (int e = 0; e < 16; ++e) { lg[e] = __expf(lg[e] - mx); den += lg[e]; }
        float mine = 0.f;
#pragma unroll
        for (int e = 0; e < 16; ++e) mine = (F.lane == e) ? lg[e] : mine;
        if (F.lane < 16) AFF[(size_t)m * 16 + F.lane] = mine / den;
    }
    __syncthreads();
}
__device__ __forceinline__ void p8_topk(Frame& F, const float* AFF, const bf16* H2, bf16* XG, float* SELG, int* INV) {
    LAS float* av = (LAS float*)(F.lds);
    LAS int* sel = (LAS int*)(F.lds + 8192);
    for (int item = blockIdx.x; item < NB * NE; item += F.G) {
        const int b = item >> 4, e = item & 15;
        for (int s = F.tid; s < SEQ; s += 512) av[s] = AFF[((size_t)b * SEQ + s) * 16 + e];
        __syncthreads();
        float a[4]; int rk[4];
#pragma unroll
        for (int c = 0; c < 4; ++c) { a[c] = av[F.tid + 512 * c]; rk[c] = 0; }
        for (int j = 0; j < SEQ; j += 4) { const f32x4 aj = *(const LAS f32x4*)(av + j);
#pragma unroll
            for (int t = 0; t < 4; ++t)
#pragma unroll
                for (int c = 0; c < 4; ++c) rk[c] += (aj[t] > a[c] || (aj[t] == a[c] && (j + t) < (F.tid + 512 * c))) ? 1 : 0; }
        const int slot0 = (e * NB + b) * CAP;
#pragma unroll
        for (int c = 0; c < 4; ++c) { const int s = F.tid + 512 * c;
            if (rk[c] < CAP) { SELG[slot0 + rk[c]] = a[c]; sel[rk[c]] = s; INV[((size_t)b * SEQ + s) * 16 + e] = rk[c]; }
            else INV[((size_t)b * SEQ + s) * 16 + e] = -1; }
        __syncthreads();
        for (int r = F.wave; r < CAP; r += NWAVES) { const int s = sel[r];
            const v4u* src = (const v4u*)(H2 + ((size_t)b * SEQ + s) * D) + F.lane; v4u* dst = (v4u*)(XG + (size_t)(slot0 + r) * D) + F.lane;
            const v4u x0 = src[0], x1 = src[64]; dst[0] = x0; dst[64] = x1; }
        __syncthreads();
    }
}
__device__ __forceinline__ void p11_final(Frame& F, const bf16* YS, const int* INV) {
    const int gw = F.vcu * NWAVES + F.wave, NGW = F.G * NWAVES;
    const float* mod = (const float*)(F.ws + WS_MOD);
    for (int m = gw; m < M; m += NGW) {
        const int b = m >> 11;
        f32x4* xr = (f32x4*)(F.out + (size_t)m * D) + F.lane;
        f32x4 v[4], y[4];
#pragma unroll
        for (int j = 0; j < 4; ++j) { v[j] = xr[64 * j]; y[j] = (f32x4){0.f, 0.f, 0.f, 0.f}; }
        const int myinv = INV[(size_t)m * 16 + (F.lane & 15)];
        for (int e = 0; e < NE; ++e) { const int r = __builtin_amdgcn_readlane(myinv, e);
            if (r >= 0) { const unsigned long long* yp = (const unsigned long long*)(YS + (size_t)((e * NB + b) * CAP + r) * D) + F.lane;
#pragma unroll
                for (int j = 0; j < 4; ++j) { const unsigned long long w = yp[64 * j]; const unsigned lo = (unsigned)w, hi = (unsigned)(w >> 32);
                    y[j] = y[j] + (f32x4){bf2f_lo(lo), bf2f_hi(lo), bf2f_lo(hi), bf2f_hi(hi)}; } } }
        const f32x4* gap = (const f32x4*)(mod + b * 6144 + 5120) + F.lane;
        float s = 0.f;
#pragma unroll
        for (int j = 0; j < 4; ++j) { v[j] = v[j] + gap[64 * j] * y[j]; s += (v[j].x * v[j].x + v[j].y * v[j].y) + (v[j].z * v[j].z + v[j].w * v[j].w); }
        const float rstd = 1.0f / sqrtf(wave_sum(s) * (1.f / D) + EPS);
        const f32x4* gp = (const f32x4*)(F.in[21]) + F.lane;
#pragma unroll
        for (int j = 0; j < 4; ++j) xr[64 * j] = (v[j] * rstd) * gp[64 * j];
    }
}

#ifndef MK_PER_PHASE
#define MK_PER_PHASE 0
#endif
constexpr int N_PHASES = 12;
struct Args { const float* in[22]; float* out; unsigned char* ws; int ph_lo, ph_hi; };
__global__ void __launch_bounds__(NWAVES * 64, 2) fwd_kernel(Args args) {
    extern __shared__ __attribute__((aligned(16))) unsigned char lds[];
    Frame F;
    F.lds = (LAS unsigned char*)lds;
    F.MISC = (volatile LAS unsigned*)(F.lds + MISC_OFF);
    F.tid = threadIdx.x; F.lane = F.tid & 63; F.wave = __builtin_amdgcn_readfirstlane(F.tid >> 6);
    F.G = gridDim.x; { const int bx = blockIdx.x; F.vcu = (F.G % 8 == 0) ? (bx % 8) * (F.G / 8) + bx / 8 : bx; }
    F.ws = args.ws; F.out = args.out; F.ctl = (gu32*)(args.ws + WS_CTL);
#pragma unroll
    for (int i = 0; i < 22; ++i) F.in[i] = args.in[i];
    for (int u = F.tid; u < (LDS_BYTES - LDSCTL_OFF) / 4; u += NWAVES * 64) ((LAS unsigned*)(F.lds + LDSCTL_OFF))[u] = 0u;
    __syncthreads();
    XcdBarrier bar; bar.bar = (unsigned*)(F.ctl + CW_BAR); bar.x = 0; bar.st = nullptr;
    if (!MK_PER_PHASE) bar = xcd_barrier_post((unsigned*)(F.ctl + CW_BAR), F.MISC + 8);
    const int lo = args.ph_lo, hi = args.ph_hi;
#ifndef PHASE_MASK
#define PHASE_MASK 0xfff
#endif
#define IN(k) (((PHASE_MASK >> (k)) & 1) && lo <= (k) && (k) < hi)
#define GRID_BAR(k) do { if (IN(k) && IN((k) + 1)) xcd_barrier(bar); } while (0)
    unsigned char* ws = args.ws;
    bf16* XN = (bf16*)args.out;
    bf16* YCAT = (bf16*)args.out;
    float* X1 = args.out;
    const float* MOD = (const float*)(ws + WS_MOD);

    if (IN(0)) { p0_prologue(F); }
    GRID_BAR(0);
    if (IN(1)) { p1_norm(F, XN); }
    GRID_BAR(1);
    if (IN(2)) {
        pg8::Gemm g{XN, (const bf16*)(ws + WS_WIN), M, NIN, D, D, D, 1 << 30, 0};
        pg8::StaticOrder S; S.init(M, NIN, F.G, (int)blockIdx.x);
        pg8::EpiProj E{(bf16*)ws, (const float*)(ws + WS_CS), WS_RQ / 2, WS_RK / 2, WS_RV / 2, WS_RG / 2, WS_DQ1 / 2, WS_DV / 2, WS_GR / 2, WS_GD / 2};
        pg8::gemm_phase<pg8::EpiProj, pg8::StaticOrder, true, true>(F.lds + RING_OFF, g, S, E);
    }
    GRID_BAR(2);
    if (IN(3)) {
        float lam;
        { float a = F.lane < 64 ? F.in[8][F.lane] * F.in[9][F.lane] : 0.f, c = F.in[10][F.lane] * F.in[11][F.lane];
          lam = __expf(wave_sum(a)) - __expf(wave_sum(c)) + 0.2f; }
        for (int u = F.vcu; u < 16384; u += F.G) { if (u < 8192) naive_unit<0>(F, u, lam, YCAT); else naive_unit<1>(F, u - 8192, lam, YCAT); }
    }
    GRID_BAR(3);
    if (IN(4)) {
        pg8::Gemm g{YCAT, (const bf16*)(ws + WS_WCAT), M, D, 512, D, D, 1 << 30, 0};
        pg8::StaticOrder S; S.init(M, D, F.G, (int)blockIdx.x);
        pg8::EpiGate E{(bf16*)(ws + WS_T1), (const bf16*)(ws + WS_GR), nullptr, D};
        pg8::gemm_phase<pg8::EpiGate, pg8::StaticOrder, true, true>(F.lds + RING_OFF, g, S, E);
    }
    GRID_BAR(4);
    if (IN(5)) {
        pg8::Gemm g{YCAT + 512, (const bf16*)(ws + WS_WCAT) + 512, M, D, 512, D, D, 1 << 30, 0};
        pg8::StaticOrder S; S.init(M, D, F.G, (int)blockIdx.x);
        pg8::EpiGate E{(bf16*)(ws + WS_MERGED), (const bf16*)(ws + WS_GD), (const bf16*)(ws + WS_T1), D};
        pg8::gemm_phase<pg8::EpiGate, pg8::StaticOrder, true, true>(F.lds + RING_OFF, g, S, E);
    }
    GRID_BAR(5);
    if (IN(6)) {
        pg8::Gemm g{(const bf16*)(ws + WS_MERGED), (const bf16*)(ws + WS_WO), M, D, D, D, D, 1 << 30, 0};
        pg8::StaticOrder S; S.init(M, D, F.G, (int)blockIdx.x);
        pg8::EpiResid E{X1, F.in[0], MOD + 2048, D, 6144};
        pg8::gemm_phase<pg8::EpiResid, pg8::StaticOrder, true, true>(F.lds + RING_OFF, g, S, E);
    }
    GRID_BAR(6);
    if (IN(7)) { p7_router(F, X1, (bf16*)(ws + WS_H2), (float*)(ws + WS_AFF)); }
    GRID_BAR(7);
    if (IN(8)) { p8_topk(F, (const float*)(ws + WS_AFF), (const bf16*)(ws + WS_H2), (bf16*)(ws + WS_XG), (float*)(ws + WS_SELG), (int*)(ws + WS_INV)); }
    GRID_BAR(8);
    if (IN(9)) {
        pg8::Gemm g{(const bf16*)(ws + WS_XG), (const bf16*)(ws + WS_WGU), MS, 2048, D, D, D, 8, (size_t)2048 * 1024 * 2};
        pg8::StaticOrder S; S.init(MS, 2048, F.G, (int)blockIdx.x);
        pg8::EpiSwiGLU E{(bf16*)(ws + WS_ACT), D};
        pg8::gemm_phase<pg8::EpiSwiGLU, pg8::StaticOrder, true, true>(F.lds + RING_OFF, g, S, E);
    }
    GRID_BAR(9);
    if (IN(10)) {
        pg8::Gemm g{(const bf16*)(ws + WS_ACT), (const bf16*)(ws + WS_WD), MS, D, D, D, D, 8, (size_t)1024 * 1024 * 2};
        pg8::StaticOrder S; S.init(MS, D, F.G, (int)blockIdx.x);
        pg8::EpiRowScale E{(bf16*)(ws + WS_YS), (const float*)(ws + WS_SELG), D};
        pg8::gemm_phase<pg8::EpiRowScale, pg8::StaticOrder, true, true>(F.lds + RING_OFF, g, S, E);
    }
    GRID_BAR(10);
    if (IN(11)) { p11_final(F, (const bf16*)(ws + WS_YS), (const int*)(ws + WS_INV)); }
#undef IN
#undef GRID_BAR
}

extern "C" void kernel_launch(void* const* d_in, const int* in_sizes, int n_in, void* d_out, int out_size, void* d_ws, size_t ws_size, hipStream_t stream) {
    static int grid = 0;
    if (grid == 0) {
        if (n_in != 22 || in_sizes[0] != M * D || out_size != M * D || ws_size < WS_END) { fprintf(stderr, "kernel_launch: unexpected problem (n_in %d, out %d, ws %zu); nothing launched\n", n_in, out_size, ws_size); grid = -1; return; }
        int dev = 0, cus = 0, per_cu = 0;
        if (hipGetDevice(&dev) != hipSuccess || hipDeviceGetAttribute(&cus, hipDeviceAttributeMultiprocessorCount, dev) != hipSuccess) { grid = -1; return; }
        if (hipFuncSetAttribute((const void*)fwd_kernel, hipFuncAttributeMaxDynamicSharedMemorySize, LDS_BYTES) != hipSuccess) { fprintf(stderr, "kernel_launch: hipFuncSetAttribute failed\n"); grid = -1; return; }
        if (hipOccupancyMaxActiveBlocksPerMultiprocessor(&per_cu, (const void*)fwd_kernel, NWAVES * 64, LDS_BYTES) != hipSuccess || per_cu < 1) { fprintf(stderr, "kernel_launch: occupancy query reports %d\n", per_cu); }
        (void)hipGetLastError();
        grid = cus;
    }
    if (grid < 0) return;
    if (hipMemsetAsync((char*)d_ws + WS_CTL, 0, CTL_ZERO_BYTES, stream) != hipSuccess) return;
    Args a{};
    for (int i = 0; i < 22; ++i) a.in[i] = (const float*)d_in[i];
    a.out = (float*)d_out; a.ws = (unsigned char*)d_ws;
#if MK_PER_PHASE
    for (int p = 0; p < N_PHASES; ++p) { a.ph_lo = p; a.ph_hi = p + 1; hipLaunchKernelGGL(fwd_kernel, dim3(grid), dim3(NWAVES * 64), LDS_BYTES, stream, a); }
#else
    a.ph_lo = 0; a.ph_hi = N_PHASES;
    hipLaunchKernelGGL(fwd_kernel, dim3(grid), dim3(NWAVES * 64), LDS_BYTES, stream, a);
#endif
}
```

```cpp
#include <hip/hip_runtime.h>
#include <cstdio>
#include <cstdint>
namespace pg8 {
#define PG8_LAS __attribute__((address_space(3)))
typedef unsigned short bf16_t;
typedef short bf16x8 __attribute__((ext_vector_type(8)));
typedef float f32x4 __attribute__((ext_vector_type(4)));
typedef unsigned u32x4 __attribute__((ext_vector_type(4)));
typedef int v4i_t __attribute__((ext_vector_type(4)));
typedef int v8i_t __attribute__((ext_vector_type(8)));
constexpr int BM = 256, BK = 64, HALF = 128, HTB = HALF * BK * 2  , STAGE_BYTES = 8 * HTB, NXCD = 8, WGM = 8;

__host__ __device__ __forceinline__ int lds_byte(int r, int c) { const int st = (r >> 4) * 2 + (c >> 5), rr = r & 15, cc = c & 31, ob = rr * 64 + cc * 2; return st * 1024 + (ob ^ (((ob >> 9) & 1) << 5)); }
__host__ __device__ __forceinline__ void stage_rc(int b, int& R, int& C) { const int st = b / 1024, sb = b % 1024, swz = sb ^ (((sb >> 9) & 1) << 5); R = (st >> 1) * 16 + swz / 64; C = (st & 1) * 32 + (swz % 64) / 2; }
__host__ __device__ __forceinline__ int perm32(int rho) { const int n = rho >> 4, i = rho & 15; return 8 * (i >> 2) + 4 * n + (i & 3); }

struct Unit { int pm, pn; };
struct Gemm { const bf16_t* A; const bf16_t* Bt; int M, N, K, lda, ldb, gdiv; size_t gstride; const int* gidx; };
typedef unsigned u32x2 __attribute__((ext_vector_type(2)));
__device__ __forceinline__ unsigned cvt_pk_bf16(float lo, float hi) { unsigned r; asm volatile("v_cvt_pk_bf16_f32 %0, %1, %2" : "=v"(r) : "v"(lo), "v"(hi)); return r; }
__device__ __forceinline__ float bflo(unsigned w) { return __builtin_bit_cast(float, w << 16); }
__device__ __forceinline__ float bfhi(unsigned w) { return __builtin_bit_cast(float, w & 0xffff0000u); }
__device__ __forceinline__ float sigmoidf_(float v) { return __builtin_amdgcn_rcpf(1.0f + __builtin_amdgcn_exp2f(-1.4426950408889634f * v)); }
__device__ __forceinline__ u32x4 pack8(const f32x4& v0, const f32x4& v1) { u32x4 w; w.x = cvt_pk_bf16(v0[0], v0[1]); w.y = cvt_pk_bf16(v0[2], v0[3]); w.z = cvt_pk_bf16(v1[0], v1[1]); w.w = cvt_pk_bf16(v1[2], v1[3]); return w; }
__device__ __forceinline__ void unpack8(const u32x4& w, f32x4& v0, f32x4& v1) { v0 = (f32x4){bflo(w.x), bfhi(w.x), bflo(w.y), bfhi(w.y)}; v1 = (f32x4){bflo(w.z), bfhi(w.z), bflo(w.w), bfhi(w.w)}; }

__device__ __forceinline__ float clamp448(float v) { return __builtin_fminf(__builtin_fmaxf(v, -448.f), 448.f); }
__device__ __forceinline__ unsigned pk_fp8x4(float a, float b, float c, float d) { int w = 0; w = __builtin_amdgcn_cvt_pk_fp8_f32(clamp448(a), clamp448(b), w, false); w = __builtin_amdgcn_cvt_pk_fp8_f32(clamp448(c), clamp448(d), w, true); return (unsigned)w; }

template <bool F8> struct EpiProjT {
    static constexpr bool PERM = true, AFTER_DRAIN = false, MID = false, FP8 = F8, GATHER = false;
    bf16_t* base; const float* cs;
    size_t oRQ, oRK, oRV, oRG, oDQ1, oDV, oGR, oGD;
    __device__ __forceinline__ void operator()(const f32x4 (&acc)[2][2][4][2], const Unit& u, int wr, int wc, int fr, int fq) const {
        const int pn = u.pn; size_t off; int ldc, colt, mode; float sc = 1.f;
        if (pn < 2)       { off = oRQ; ldc = 512; colt = pn * 256; mode = 1; }
        else if (pn < 4)  { off = oRK; ldc = 512; colt = (pn - 2) * 256; mode = 1; sc = 0.08838834764831845f; }
        else if (pn < 6)  { off = oRV; ldc = 512; colt = (pn - 4) * 256; mode = 0; }
        else if (pn < 8)  { off = oRG; ldc = 512; colt = (pn - 6) * 256; mode = 2; }
        else if (pn < 12) { off = oDQ1 + (size_t)(pn - 8) * ((size_t)16384 * 256); ldc = 256; colt = 0; mode = 0; sc = (pn < 10) ? 0.18033688011112042f : 1.f; }
        else if (pn < 14) { off = oDV; ldc = 512; colt = (pn - 12) * 256; mode = 0; }
        else if (pn < 18) { off = oGR; ldc = 1024; colt = (pn - 14) * 256; mode = 3; }
        else              { off = oGD; ldc = 1024; colt = (pn - 18) * 256; mode = 3; }
        const int row0 = u.pm * BM + wr * 64 + fr, col0 = colt + wc * 32 + 8 * fq;
        const int i0 = wc * 16 + 4 * fq;
#pragma unroll
        for (int ai = 0; ai < 2; ++ai)
#pragma unroll
            for (int m = 0; m < 4; ++m) { const int row = row0 + ai * HALF + m * 16; bf16_t* rowp = base + off + (size_t)row * ldc + col0;
                f32x4 c01 = (f32x4){1.f, 0.f, 1.f, 0.f}, c23 = c01;
                if (mode == 1) { const f32x4* cp = (const f32x4*)(cs + ((size_t)(row & 2047) * 64 + i0) * 2); c01 = cp[0]; c23 = cp[1]; }
#pragma unroll
                for (int bj = 0; bj < 2; ++bj) { f32x4 v0 = acc[ai][bj][m][0], v1 = acc[ai][bj][m][1];
                    if (F8) { v0 = v0 * (1.f / 64.f); v1 = v1 * (1.f / 64.f); }
                    if (mode == 1) {
                        const f32x4 a = v0, b = v1;
                        v0 = (f32x4){a[0] * c01[0] - a[1] * c01[1], a[0] * c01[1] + a[1] * c01[0], a[2] * c01[2] - a[3] * c01[3], a[2] * c01[3] + a[3] * c01[2]};
                        v1 = (f32x4){b[0] * c23[0] - b[1] * c23[1], b[0] * c23[1] + b[1] * c23[0], b[2] * c23[2] - b[3] * c23[3], b[2] * c23[3] + b[3] * c23[2]};
                    } else if (mode == 2) {
#pragma unroll
                        for (int j = 0; j < 4; ++j) { v0[j] = v0[j] * sigmoidf_(v0[j]); v1[j] = v1[j] * sigmoidf_(v1[j]); }
                    } else if (mode == 3) {
#pragma unroll
                        for (int j = 0; j < 4; ++j) { v0[j] = sigmoidf_(v0[j]); v1[j] = sigmoidf_(v1[j]); }
                    }
                    v0 = v0 * sc; v1 = v1 * sc;
                    *(u32x4*)(rowp + bj * HALF) = pack8(v0, v1); } }
    }
};
typedef EpiProjT<false> EpiProj; typedef EpiProjT<true> EpiProj8;
struct EpiGate {
    static constexpr bool PERM = true, AFTER_DRAIN = false, MID = false, FP8 = false, GATHER = false;
    bf16_t* O; const bf16_t* G; const bf16_t* T; int ldc;
    __device__ __forceinline__ void operator()(const f32x4 (&acc)[2][2][4][2], const Unit& u, int wr, int wc, int fr, int fq) const {
        const int row0 = u.pm * BM + wr * 64 + fr, col0 = u.pn * BM + wc * 32 + 8 * fq;
#pragma unroll
        for (int ai = 0; ai < 2; ++ai)
#pragma unroll
            for (int m = 0; m < 4; ++m) { const size_t ro = (size_t)(row0 + ai * HALF + m * 16) * ldc + col0;
#pragma unroll
                for (int bj = 0; bj < 2; ++bj) { f32x4 g0, g1; unpack8(*(const u32x4*)(G + ro + bj * HALF), g0, g1);
                    f32x4 v0 = acc[ai][bj][m][0] * g0, v1 = acc[ai][bj][m][1] * g1;
                    if (T) { f32x4 t0, t1; unpack8(*(const u32x4*)(T + ro + bj * HALF), t0, t1); v0 = v0 + t0; v1 = v1 + t1; }
                    *(u32x4*)(O + ro + bj * HALF) = pack8(v0, v1); } }
    }
};
struct EpiGate2 {
    static constexpr bool PERM = true, AFTER_DRAIN = false, MID = true, FP8 = false, GATHER = false;
    bf16_t* O; const bf16_t* GR; const bf16_t* GD; int ldc;
    __device__ __forceinline__ void mid(f32x4 (&acc)[2][2][4][2], const Unit& u, int wr, int wc, int fr, int fq) const {
        int row0 = u.pm * BM + wr * 64 + fr; const int col0 = u.pn * BM + wc * 32 + 8 * fq; asm volatile("" : "+v"(row0));
#pragma unroll
        for (int ai = 0; ai < 2; ++ai)
#pragma unroll
            for (int m = 0; m < 4; ++m) { const size_t ro = (size_t)(row0 + ai * HALF + m * 16) * ldc + col0;
#pragma unroll
                for (int bj = 0; bj < 2; ++bj) { f32x4 r0, r1, d0, d1; unpack8(*(const u32x4*)(GR + ro + bj * HALF), r0, r1); unpack8(*(const u32x4*)(GD + ro + bj * HALF), d0, d1);
#pragma unroll
                    for (int j = 0; j < 4; ++j) { acc[ai][bj][m][0][j] *= r0[j] * __builtin_amdgcn_rcpf(d0[j]); acc[ai][bj][m][1][j] *= r1[j] * __builtin_amdgcn_rcpf(d1[j]); }
                    asm volatile("" : "+v"(acc[ai][bj][m][0]), "+v"(acc[ai][bj][m][1]) :: "memory"); } }
    }
    __device__ __forceinline__ void operator()(const f32x4 (&acc)[2][2][4][2], const Unit& u, int wr, int wc, int fr, int fq) const {
        int row0 = u.pm * BM + wr * 64 + fr; const int col0 = u.pn * BM + wc * 32 + 8 * fq; asm volatile("" : "+v"(row0));
#pragma unroll
        for (int ai = 0; ai < 2; ++ai)
#pragma unroll
            for (int m = 0; m < 4; ++m) { const size_t ro = (size_t)(row0 + ai * HALF + m * 16) * ldc + col0;
#pragma unroll
                for (int bj = 0; bj < 2; ++bj) { f32x4 d0, d1; unpack8(*(const u32x4*)(GD + ro + bj * HALF), d0, d1);
                    *(u32x4*)(O + ro + bj * HALF) = pack8(acc[ai][bj][m][0] * d0, acc[ai][bj][m][1] * d1); } }
    }
};
struct EpiResid {
    static constexpr bool PERM = false, AFTER_DRAIN = false, MID = false, FP8 = false, GATHER = false;
    float* C; const float* base; const float* gate; int ldc, gpitch;
    __device__ __forceinline__ void operator()(const f32x4 (&acc)[2][2][4][2], const Unit& u, int wr, int wc, int fr, int fq) const {
        const int row0 = u.pm * BM + wr * 64 + fr, col0 = u.pn * BM + wc * 32 + 4 * fq;
        const float* gp = gate + (size_t)((u.pm * BM) >> 11) * gpitch + col0;
        f32x4 gv[2][2];
#pragma unroll
        for (int bj = 0; bj < 2; ++bj)
#pragma unroll
            for (int n = 0; n < 2; ++n) gv[bj][n] = *(const f32x4*)(gp + bj * HALF + n * 16);
#pragma unroll
        for (int ai = 0; ai < 2; ++ai)
#pragma unroll
            for (int m = 0; m < 4; ++m) { const size_t ro = (size_t)(row0 + ai * HALF + m * 16) * ldc + col0;
#pragma unroll
                for (int bj = 0; bj < 2; ++bj)
#pragma unroll
                    for (int n = 0; n < 2; ++n) *(f32x4*)(C + ro + bj * HALF + n * 16) = *(const f32x4*)(base + ro + bj * HALF + n * 16) + gv[bj][n] * acc[ai][bj][m][n]; }
    }
};
struct EpiSwiGLU {
    static constexpr bool PERM = false, AFTER_DRAIN = false, MID = false, FP8 = false, GATHER = false;
    bf16_t* O; int ldc;
    __device__ __forceinline__ void operator()(const f32x4 (&acc)[2][2][4][2], const Unit& u, int wr, int wc, int fr, int fq) const {
        const int row0 = u.pm * BM + wr * 64 + fr, col0 = u.pn * 128 + wc * 32 + 8 * fq;
#pragma unroll
        for (int ai = 0; ai < 2; ++ai)
#pragma unroll
            for (int m = 0; m < 4; ++m) { f32x4 o[2];
#pragma unroll
                for (int bj = 0; bj < 2; ++bj) { const f32x4 gt = acc[ai][bj][m][0], up = acc[ai][bj][m][1];
#pragma unroll
                    for (int j = 0; j < 4; ++j) o[bj][j] = gt[j] * sigmoidf_(gt[j]) * up[j]; }
                *(u32x4*)(O + (size_t)(row0 + ai * HALF + m * 16) * ldc + col0) = pack8(o[0], o[1]); }
    }
};
struct EpiRowScale {
    static constexpr bool PERM = true, AFTER_DRAIN = false, MID = false, FP8 = false, GATHER = false;
    bf16_t* O; const float* rs; int ldc;
    __device__ __forceinline__ void operator()(const f32x4 (&acc)[2][2][4][2], const Unit& u, int wr, int wc, int fr, int fq) const {
        const int row0 = u.pm * BM + wr * 64 + fr, col0 = u.pn * BM + wc * 32 + 8 * fq;
#pragma unroll
        for (int ai = 0; ai < 2; ++ai)
#pragma unroll
            for (int m = 0; m < 4; ++m) { const int row = row0 + ai * HALF + m * 16; const float s = rs[row];
#pragma unroll
                for (int bj = 0; bj < 2; ++bj) *(u32x4*)(O + (size_t)row * ldc + col0 + bj * HALF) = pack8(acc[ai][bj][m][0] * s, acc[ai][bj][m][1] * s); }
    }
};

constexpr float W8_SCALE = 64.f, ACT_SCALE = 16.f;
struct EpiSwiGLU8 {
    static constexpr bool PERM = false, AFTER_DRAIN = false, MID = false, FP8 = true, GATHER = true;
    unsigned char* O; int ldc;
    __device__ __forceinline__ void operator()(const f32x4 (&acc)[2][2][4][2], const Unit& u, int wr, int wc, int fr, int fq) const {
        const int row0 = u.pm * BM + wr * 64 + fr, col0 = u.pn * 128 + wc * 32 + 8 * fq;
#pragma unroll
        for (int ai = 0; ai < 2; ++ai)
#pragma unroll
            for (int m = 0; m < 4; ++m) { f32x4 o[2];
#pragma unroll
                for (int bj = 0; bj < 2; ++bj) { const f32x4 gt = acc[ai][bj][m][0] * (1.f / W8_SCALE), up = acc[ai][bj][m][1] * (ACT_SCALE / W8_SCALE);
#pragma unroll
                    for (int j = 0; j < 4; ++j) o[bj][j] = gt[j] * sigmoidf_(gt[j]) * up[j]; }
                u32x2 w; w.x = pk_fp8x4(o[0][0], o[0][1], o[0][2], o[0][3]); w.y = pk_fp8x4(o[1][0], o[1][1], o[1][2], o[1][3]);
                *(u32x2*)(O + (size_t)(row0 + ai * HALF + m * 16) * ldc + col0) = w; }
    }
};
constexpr float YS_SCALE = 64.f;
struct EpiRowScale8 {
    static constexpr bool PERM = true, AFTER_DRAIN = false, MID = false, FP8 = true, GATHER = false;
    unsigned char* O; const float* rs; int ldc;
    __device__ __forceinline__ void operator()(const f32x4 (&acc)[2][2][4][2], const Unit& u, int wr, int wc, int fr, int fq) const {
        const int row0 = u.pm * BM + wr * 64 + fr, col0 = u.pn * BM + wc * 32 + 8 * fq;
#pragma unroll
        for (int ai = 0; ai < 2; ++ai)
#pragma unroll
            for (int m = 0; m < 4; ++m) { const int row = row0 + ai * HALF + m * 16; const float s = rs[row] * (YS_SCALE / (ACT_SCALE * W8_SCALE));
#pragma unroll
                for (int bj = 0; bj < 2; ++bj) { const f32x4 v0 = acc[ai][bj][m][0] * s, v1 = acc[ai][bj][m][1] * s; u32x2 w; w.x = pk_fp8x4(v0[0], v0[1], v0[2], v0[3]); w.y = pk_fp8x4(v1[0], v1[1], v1[2], v1[3]);
                    *(u32x2*)(O + (size_t)row * ldc + col0 + bj * HALF) = w; } }
    }
};
struct EpiResidB {
    static constexpr bool PERM = true, AFTER_DRAIN = false, MID = false, FP8 = false, GATHER = false;
    bf16_t* C; const float* base; const float* gate; int ldc, gpitch;
    __device__ __forceinline__ void operator()(const f32x4 (&acc)[2][2][4][2], const Unit& u, int wr, int wc, int fr, int fq) const {
        const int row0 = u.pm * BM + wr * 64 + fr, col0 = u.pn * BM + wc * 32 + 8 * fq;
        const float* gp = gate + (size_t)((u.pm * BM) >> 11) * gpitch + col0;
        f32x4 gv[2][2];
#pragma unroll
        for (int bj = 0; bj < 2; ++bj)
#pragma unroll
            for (int n = 0; n < 2; ++n) gv[bj][n] = *(const f32x4*)(gp + bj * HALF + 4 * n);
#pragma unroll
        for (int ai = 0; ai < 2; ++ai)
#pragma unroll
            for (int m = 0; m < 4; ++m) { const size_t ro = (size_t)(row0 + ai * HALF + m * 16) * ldc + col0;
#pragma unroll
                for (int bj = 0; bj < 2; ++bj) { const f32x4 b0 = *(const f32x4*)(base + ro + bj * HALF), b1 = *(const f32x4*)(base + ro + bj * HALF + 4);
                    *(u32x4*)(C + ro + bj * HALF) = pack8(b0 + gv[bj][0] * acc[ai][bj][m][0], b1 + gv[bj][1] * acc[ai][bj][m][1]); } }
    }
};


struct StaticOrder {
    int nM, nN, nwg, G, c;
    __host__ __device__ void init(int M, int N, int G_, int c_) { nM = M / BM; nN = N / BM; nwg = nM * nN; G = G_; c = c_; }
    __host__ __device__ bool next(int i, Unit& u) const {
        const long L = (long)i * G + c; if (L >= nwg) return false;
        int wgid = (int)L; { const int q = nwg / NXCD, r = nwg % NXCD, xcd = wgid % NXCD, off = wgid / NXCD; wgid = (xcd < r ? xcd * (q + 1) : r * (q + 1) + (xcd - r) * q) + off; }
        const int nig = WGM * nN, gid = wgid / nig, fm = gid * WGM, gsz = (nM - fm) < WGM ? (nM - fm) : WGM;
        u.pm = fm + ((wgid % nig) % gsz); u.pn = (wgid % nig) / gsz; return true;
    }
    __device__ __forceinline__ void a_ready(const Unit&) const {}
    __device__ __forceinline__ void done(const Unit&) const {}
};

template <class Epi, class Sched, bool ALIGN_EPI = false, bool SP2 = false>
__device__ __forceinline__ void gemm_phase(PG8_LAS unsigned char* lds, const Gemm g, const Sched& S, const Epi& E) {
    const int tid = threadIdx.x, wid = __builtin_amdgcn_readfirstlane(tid >> 6), lane = tid & 63, wr = wid >> 2, wc = wid & 3, fr = lane & 15, fq = lane >> 4;
    const int K = g.K, nt = K / BK;
    unsigned voffA[2], voffB[2];
#pragma unroll
    for (int i = 0; i < 2; ++i) { int R, C; stage_rc(tid * 16 + i * 8192, R, C); const int Rb = Epi::PERM ? ((R & ~31) + perm32(R & 31)) : R;
        voffA[i] = (unsigned)(R * g.lda + C) * 2u; voffB[i] = (unsigned)(Rb * g.ldb + C) * 2u; }
    unsigned vgc[2][2] = {{0u, 0u}, {0u, 0u}}, vgn[2][2] = {{0u, 0u}, {0u, 0u}};
#define PG8_LOADVG(vg, pm_) do { _Pragma("unroll") for (int h_ = 0; h_ < 2; ++h_) _Pragma("unroll") for (int i_ = 0; i_ < 2; ++i_) { int R_, C_; stage_rc(tid * 16 + i_ * 8192, R_, C_); \
        vg[h_][i_] = (unsigned)(g.gidx[(pm_) * BM + h_ * HALF + R_] * g.lda + C_) * 2u; } } while (0)
    const size_t kstep = (size_t)(BK * 2);
    const size_t hstepA = (size_t)HALF * g.lda * 2, hstepB = (size_t)HALF * g.ldb * 2;
    const size_t tstepA = 2 * hstepA, tstepB = 2 * hstepB;
    const unsigned ldsw = (unsigned)wid * 1024u;
    const int aoff = lds_byte(wr * 64 + fr, fq * 8), boff = lds_byte(wc * 32 + fr, fq * 8);
#define PG8_SA(b, h) (((b) * 2 + (h)) * HTB)
#define PG8_SB(b, h) ((4 + (b) * 2 + (h)) * HTB)
#define PG8_STAGE(bufoff, gbase, voff) do { _Pragma("unroll") for (int _i = 0; _i < 2; ++_i) \
        __builtin_amdgcn_global_load_lds((const unsigned*)((const char*)(gbase) + (voff)[_i]), (PG8_LAS unsigned*)(lds + (bufoff) + ldsw + _i * 8192), 16, 0, 0); } while (0)
#define PG8_STAGE_A(bufoff, X, half, nx) do { if constexpr (Epi::GATHER) { unsigned vs_[2]; vs_[0] = (nx) ? vgn[half][0] : vgc[half][0]; vs_[1] = (nx) ? vgn[half][1] : vgc[half][1]; PG8_STAGE(bufoff, X, vs_); } \
        else PG8_STAGE(bufoff, (half) ? (X) + hstepA : (X), voffA); } while (0)
#define PG8_LDA(dst, b, h) do { _Pragma("unroll") for (int m = 0; m < 4; ++m) { const v4i_t l_ = *(const PG8_LAS v4i_t*)(lds + PG8_SA(b, h) + aoff + m * 2048), h_ = *(const PG8_LAS v4i_t*)(lds + PG8_SA(b, h) + aoff + m * 2048 + 1024); dst[m] = __builtin_shufflevector(l_, h_, 0, 1, 2, 3, 4, 5, 6, 7); } } while (0)
#define PG8_LDB(dst, b, h) do { _Pragma("unroll") for (int n = 0; n < 2; ++n) { const v4i_t l_ = *(const PG8_LAS v4i_t*)(lds + PG8_SB(b, h) + boff + n * 2048), h_ = *(const PG8_LAS v4i_t*)(lds + PG8_SB(b, h) + boff + n * 2048 + 1024); dst[n] = __builtin_shufflevector(l_, h_, 0, 1, 2, 3, 4, 5, 6, 7); } } while (0)
#define PG8_HALF(x, k) __builtin_bit_cast(bf16x8, __builtin_shufflevector(x, x, 4 * (k), 4 * (k) + 1, 4 * (k) + 2, 4 * (k) + 3))
#define PG8_MMA(ai, bj, At, Bt) do { if constexpr (Epi::FP8) __builtin_amdgcn_sched_barrier(0); __builtin_amdgcn_s_setprio(1); _Pragma("unroll") for (int m = 0; m < 4; ++m) _Pragma("unroll") for (int n = 0; n < 2; ++n) { \
        if constexpr (Epi::FP8) acc[ai][bj][m][n] = __builtin_amdgcn_mfma_scale_f32_16x16x128_f8f6f4(Bt[n], At[m], acc[ai][bj][m][n], 0, 0, 0, 0x7f7f7f7f, 0, 0x7f7f7f7f); \
        else { acc[ai][bj][m][n] = __builtin_amdgcn_mfma_f32_16x16x32_bf16(PG8_HALF(Bt[n], 0), PG8_HALF(At[m], 0), acc[ai][bj][m][n], 0, 0, 0); \
               acc[ai][bj][m][n] = __builtin_amdgcn_mfma_f32_16x16x32_bf16(PG8_HALF(Bt[n], 1), PG8_HALF(At[m], 1), acc[ai][bj][m][n], 0, 0, 0); } } \
        __builtin_amdgcn_s_setprio(0); if constexpr (Epi::FP8) { _Pragma("unroll") for (int m = 0; m < 4; ++m) _Pragma("unroll") for (int n = 0; n < 2; ++n) asm volatile("" : "+v"(acc[ai][bj][m][n])); __builtin_amdgcn_sched_barrier(0); } } while (0)
#define PG8_WAIT_V(n) asm volatile("s_waitcnt vmcnt(" #n ")" ::: "memory")
#define PG8_WAIT_L(n) asm volatile("s_waitcnt lgkmcnt(" #n ")" ::: "memory")
#define PG8_BAR __builtin_amdgcn_s_barrier()
#define PG8_SCHED __builtin_amdgcn_sched_barrier(0)
    Unit cur, nxt; int ui = 0;
    if (!S.next(0, cur)) return;
    f32x4 acc[2][2][4][2];
#pragma unroll
    for (int a = 0; a < 2; ++a)
#pragma unroll
        for (int b = 0; b < 2; ++b)
#pragma unroll
            for (int m = 0; m < 4; ++m)
#pragma unroll
                for (int n = 0; n < 2; ++n) acc[a][b][m][n] = (f32x4){0.f, 0.f, 0.f, 0.f};
    v8i_t At[4], B0[2], B1[2];
    const char* cA = (const char*)g.A + (Epi::GATHER ? (size_t)0 : (size_t)cur.pm * tstepA); const char* cB = (const char*)g.Bt + (size_t)(cur.pm / g.gdiv) * g.gstride + (size_t)cur.pn * tstepB;
    S.a_ready(cur);
    if constexpr (Epi::GATHER) { static_assert(SP2 || !Epi::GATHER, "gather: SP2 loop only"); PG8_LOADVG(vgc, cur.pm); }
    if constexpr (SP2) {
        PG8_STAGE(PG8_SB(0, 0), cB, voffB); PG8_STAGE(PG8_SB(0, 1), cB + hstepB, voffB); PG8_STAGE_A(PG8_SA(0, 0), cA, 0, false); PG8_STAGE_A(PG8_SA(0, 1), cA, 1, false);
        if (wr == 1) PG8_BAR;
        PG8_WAIT_V(2); PG8_BAR;
        PG8_STAGE(PG8_SB(1, 0), cB + kstep, voffB); PG8_STAGE_A(PG8_SA(1, 0), cA + kstep, 0, false); PG8_STAGE(PG8_SB(1, 1), cB + hstepB + kstep, voffB);
        PG8_WAIT_V(6); PG8_BAR;
    } else {
        PG8_STAGE(PG8_SB(0, 0), cB, voffB); PG8_STAGE(PG8_SA(0, 0), cA, voffA); PG8_STAGE(PG8_SB(0, 1), cB + hstepB, voffB); PG8_STAGE(PG8_SA(0, 1), cA + hstepA, voffA);
        if (wr == 1) PG8_BAR;
        PG8_WAIT_V(4); PG8_BAR;
        PG8_STAGE(PG8_SB(1, 0), cB + kstep, voffB); PG8_STAGE(PG8_SA(1, 0), cA + kstep, voffA); PG8_STAGE(PG8_SB(1, 1), cB + hstepB + kstep, voffB);
        PG8_WAIT_V(6); PG8_BAR;
    }
    for (;;) {
        const bool has_next = S.next(ui + 1, nxt);
        const char* nA = (has_next && !Epi::GATHER) ? (const char*)g.A + (size_t)nxt.pm * tstepA : cA; const char* nB = has_next ? (const char*)g.Bt + (size_t)(nxt.pm / g.gdiv) * g.gstride + (size_t)nxt.pn * tstepB : cB;
        for (int t = 0; t < nt; t += 2) {
            const bool last = (t == nt - 2);
            const char* a1 = cA + (size_t)(t + 1) * kstep;
            const char* a2 = last ? nA : cA + (size_t)(t + 2) * kstep; const char* b2 = last ? nB : cB + (size_t)(t + 2) * kstep;
            const char* a3 = a2 + kstep; const char* b3 = b2 + kstep;
            if (last && has_next) S.a_ready(nxt);
            const bool nx_ = last;
            if constexpr (Epi::GATHER) { if (last) { if (has_next) PG8_LOADVG(vgn, nxt.pm); else { vgn[0][0] = vgc[0][0]; vgn[0][1] = vgc[0][1]; vgn[1][0] = vgc[1][0]; vgn[1][1] = vgc[1][1]; } } }
            if constexpr (Epi::MID) { PG8_SCHED; if (t == nt / 2) E.mid(acc, cur, wr, wc, fr, fq); PG8_SCHED; }
            if constexpr (SP2) {
            PG8_LDB(B0, 0, 0); PG8_LDB(B1, 0, 1); PG8_SCHED; PG8_LDA(At, 0, 0); PG8_STAGE_A(PG8_SA(1, 1), a1, 1, false);
            PG8_WAIT_V(8); PG8_WAIT_L(0); PG8_BAR; PG8_MMA(0, 0, At, B0); PG8_MMA(0, 1, At, B1); PG8_BAR; PG8_SCHED;
            PG8_LDA(At, 0, 1); PG8_STAGE(PG8_SB(0, 0), b2, voffB); PG8_STAGE(PG8_SB(0, 1), b2 + hstepB, voffB); PG8_STAGE_A(PG8_SA(0, 0), a2, 0, nx_);
            PG8_WAIT_V(8); PG8_WAIT_L(0); PG8_BAR; PG8_MMA(1, 0, At, B0); PG8_MMA(1, 1, At, B1); PG8_BAR; PG8_SCHED;
            PG8_LDB(B0, 1, 0); PG8_LDB(B1, 1, 1); PG8_SCHED; PG8_LDA(At, 1, 0); PG8_STAGE_A(PG8_SA(0, 1), a2, 1, nx_);
            PG8_WAIT_V(8); PG8_WAIT_L(0); PG8_BAR; PG8_MMA(0, 0, At, B0); PG8_MMA(0, 1, At, B1); PG8_BAR; PG8_SCHED;
            PG8_LDA(At, 1, 1); PG8_STAGE(PG8_SB(1, 0), b3, voffB); PG8_STAGE(PG8_SB(1, 1), b3 + hstepB, voffB); PG8_STAGE_A(PG8_SA(1, 0), a3, 0, nx_);
            PG8_WAIT_V(8); PG8_WAIT_L(0); PG8_BAR; PG8_MMA(1, 0, At, B0); PG8_MMA(1, 1, At, B1); PG8_BAR; PG8_SCHED;
            } else {
            PG8_LDB(B0, 0, 0); PG8_SCHED; PG8_LDA(At, 0, 0); PG8_STAGE(PG8_SA(1, 1), a1 + hstepA, voffA);
            PG8_WAIT_L(8); PG8_BAR; PG8_WAIT_L(0); PG8_MMA(0, 0, At, B0); PG8_BAR; PG8_SCHED;
            PG8_LDB(B1, 0, 1); PG8_STAGE(PG8_SB(0, 0), b2, voffB);
            PG8_BAR; PG8_WAIT_L(0); PG8_MMA(0, 1, At, B1); PG8_BAR;
            PG8_LDA(At, 0, 1); PG8_STAGE(PG8_SA(0, 0), a2, voffA);
            PG8_BAR; PG8_WAIT_L(0); PG8_MMA(1, 0, At, B0); PG8_BAR; PG8_SCHED;
            PG8_STAGE(PG8_SB(0, 1), b2 + hstepB, voffB);
            PG8_WAIT_V(6); PG8_BAR; PG8_MMA(1, 1, At, B1); PG8_BAR;
            PG8_LDB(B0, 1, 0); PG8_SCHED; PG8_LDA(At, 1, 0); PG8_STAGE(PG8_SA(0, 1), a2 + hstepA, voffA);
            PG8_WAIT_L(8); PG8_BAR; PG8_WAIT_L(0); PG8_MMA(0, 0, At, B0); PG8_BAR; PG8_SCHED;
            PG8_LDB(B1, 1, 1); PG8_STAGE(PG8_SB(1, 0), b3, voffB);
            PG8_BAR; PG8_WAIT_L(0); PG8_MMA(0, 1, At, B1); PG8_BAR;
            PG8_LDA(At, 1, 1); PG8_STAGE(PG8_SA(1, 0), a3, voffA);
            PG8_BAR; PG8_WAIT_L(0); PG8_MMA(1, 0, At, B0); PG8_BAR; PG8_SCHED;
            PG8_STAGE(PG8_SB(1, 1), b3 + hstepB, voffB);
            PG8_WAIT_V(6); PG8_BAR; PG8_MMA(1, 1, At, B1); PG8_BAR;
            }
        }
        if constexpr (ALIGN_EPI) { if (wr == 0) PG8_BAR; }
        if constexpr (!Epi::AFTER_DRAIN) { E(acc, cur, wr, wc, fr, fq); S.done(cur); }
        if (!has_next) break;
#pragma unroll
        for (int a = 0; a < 2; ++a)
#pragma unroll
            for (int b = 0; b < 2; ++b)
#pragma unroll
                for (int m = 0; m < 4; ++m)
#pragma unroll
                    for (int n = 0; n < 2; ++n) acc[a][b][m][n] = (f32x4){0.f, 0.f, 0.f, 0.f};
        cur = nxt; cA = nA; cB = nB; ++ui;
        if constexpr (Epi::GATHER) { vgc[0][0] = vgn[0][0]; vgc[0][1] = vgn[0][1]; vgc[1][0] = vgn[1][0]; vgc[1][1] = vgn[1][1]; }
        if constexpr (ALIGN_EPI) { if (wr == 1) PG8_BAR; }
    }
    PG8_WAIT_V(0);
    if constexpr (!ALIGN_EPI) { if (wr == 0) PG8_BAR; }
    PG8_BAR;
    if constexpr (Epi::AFTER_DRAIN) { E.fused(acc, cur, wr, wc, fr, fq, lds, wid, lane); S.done(cur); }
#undef PG8_SA
#undef PG8_SB
#undef PG8_STAGE
#undef PG8_STAGE_A
#undef PG8_LOADVG
#undef PG8_LDA
#undef PG8_LDB
#undef PG8_MMA
#undef PG8_HALF
#undef PG8_WAIT_V
#undef PG8_WAIT_L
#undef PG8_BAR
#undef PG8_SCHED
}
}

#define GAS __attribute__((address_space(1)))
#define LAS __attribute__((address_space(3)))
typedef unsigned short bf16;
typedef unsigned v4u __attribute__((ext_vector_type(4)));
typedef float f32x4 __attribute__((ext_vector_type(4)));
typedef short bf16x8 __attribute__((ext_vector_type(8)));
typedef GAS unsigned gu32;
typedef GAS unsigned long long gu64;
#define RLX_AGENT __ATOMIC_RELAXED, __HIP_MEMORY_SCOPE_AGENT
#define LDS_WAIT() asm volatile("s_waitcnt lgkmcnt(0)" ::: "memory")
#define VM_WAIT() asm volatile("s_waitcnt vmcnt(0)" ::: "memory")
__device__ __forceinline__ unsigned long long rt() { return __builtin_amdgcn_s_memrealtime(); }
__device__ __forceinline__ unsigned f2bf(float f) { unsigned u = __builtin_bit_cast(unsigned, f); return (u + 0x7fffu + ((u >> 16) & 1u)) >> 16; }
__device__ __forceinline__ unsigned pk2(float lo, float hi) { return f2bf(lo) | (f2bf(hi) << 16); }

#define XB_TMO      128
#define XB_XCNT(j)  (256  + 64 * (j))
#define XB_XSUB(j)  (1280 + 64 * (j))
#define XB_XGEN(j)  (2304 + 64 * (j))
#define XB_TOP      3328
#define XB_TOPGEN   3392
#define XCD_BAR_WORDS 3456
#define XB_SPIN_CAP (1u << 18)

__device__ __forceinline__ unsigned xb_ld(unsigned* p)              { return __hip_atomic_load(p, __ATOMIC_RELAXED, __HIP_MEMORY_SCOPE_AGENT); }
__device__ __forceinline__ unsigned xb_add(unsigned* p, unsigned v) { return __hip_atomic_fetch_add(p, v, __ATOMIC_RELAXED, __HIP_MEMORY_SCOPE_AGENT); }
__device__ __forceinline__ unsigned xb_xcc_id() { return (unsigned)__builtin_amdgcn_s_getreg((3 << 11) | 20) & 0xFu; }
#define XB_SPIN(cond, bar) do { unsigned _sp = 0; while (cond) { __builtin_amdgcn_s_sleep(1); \
    if ((++_sp & 255u) == 0u) { if (xb_ld(&(bar)[XB_TMO])) break; if (_sp > XB_SPIN_CAP) { atomicAdd(&(bar)[XB_TMO], 1u); break; } } } } while (0)

struct XcdBarrier {
    unsigned* bar; unsigned x;
    volatile LAS unsigned* st;
};

__device__ __forceinline__ XcdBarrier xcd_barrier_post(unsigned* bar, volatile LAS unsigned* st) {
    XcdBarrier b; b.bar = bar; b.x = xb_xcc_id(); b.st = st;
    if (threadIdx.x == 0) (void)xb_add(&bar[XB_XCNT(b.x)], 1u);
    return b;
}
__device__ __forceinline__ void xcd_barrier_complete(unsigned* bar, unsigned x, unsigned& nloc, unsigned& nx) {
    const unsigned G = gridDim.x * gridDim.y * gridDim.z;
    unsigned sum, cnt, mine, sp = 0u;
    for (;;) {
        sum = 0u; cnt = 0u; mine = 0u;
#pragma unroll
        for (unsigned j = 0; j < 16; ++j) { const unsigned c = xb_ld(&bar[XB_XCNT(j)]); sum += c; cnt += (c > 0u) ? 1u : 0u; mine = (j == x) ? c : mine; }
        if (sum == G) break;
        __builtin_amdgcn_s_sleep(1);
        if ((++sp & 255u) == 0u) { if (xb_ld(&bar[XB_TMO])) break; if (sp > XB_SPIN_CAP) { atomicAdd(&bar[XB_TMO], 1u); break; } }
    }
    nloc = mine > 0u ? mine : 1u; nx = cnt > 0u ? cnt : 1u;
}

__device__ __forceinline__ void xcd_barrier(const XcdBarrier& b) {
    asm volatile("s_waitcnt vmcnt(0)" ::: "memory");
    __syncthreads();
    if (threadIdx.x == 0) {
        unsigned* bar = b.bar;
        __builtin_amdgcn_s_waitcnt(0);
        unsigned nloc = b.st[0], nx = b.st[1];
        if (nloc == 0u) { xcd_barrier_complete(bar, b.x, nloc, nx); b.st[0] = nloc; b.st[1] = nx; }
        const unsigned old = xb_add(&bar[XB_XSUB(b.x)], 1u);
        const unsigned gen = old / nloc;
        if (old + 1u == (gen + 1u) * nloc) {
            __builtin_amdgcn_fence(__ATOMIC_RELEASE, "agent");
            asm volatile("s_waitcnt vmcnt(0)" ::: "memory");
            const unsigned og = xb_add(&bar[XB_TOP], 1u);
            const unsigned tg = og / nx;
            if (og + 1u == (tg + 1u) * nx) xb_add(&bar[XB_TOPGEN], 1u);
            else XB_SPIN(xb_ld(&bar[XB_TOPGEN]) == tg, bar);
            __builtin_amdgcn_fence(__ATOMIC_ACQUIRE, "agent");
            xb_add(&bar[XB_XGEN(b.x)], 1u);
            asm volatile("s_waitcnt vmcnt(0)" ::: "memory");
        } else {
            XB_SPIN(xb_ld(&bar[XB_XGEN(b.x)]) == gen, bar);
            __builtin_amdgcn_fence(__ATOMIC_ACQUIRE, "agent");
            asm volatile("s_waitcnt vmcnt(0)" ::: "memory");
        }
    }
    __syncthreads();
}

constexpr int NWAVES = 8;
constexpr int NB = 8, SEQ = 2048, D = 1024, M = NB * SEQ;
constexpr int NIN = 5632, NE = 16, CAP = 256, MS = NE * NB * CAP;
constexpr float EPS = 1e-6f;
constexpr float LOG2E = 1.4426950408889634f;
constexpr size_t MiB = 1u << 20;
constexpr size_t WS_CTL = 0, CTL_ZERO_BYTES = 1 * MiB;
constexpr size_t WS_MOD = 1 * MiB;
constexpr size_t WS_CS = 1 * MiB + 256 * 1024;
constexpr size_t WS_AFF = 3 * MiB;
constexpr size_t WS_INV = 4 * MiB;
constexpr size_t WS_SELG = 5 * MiB;
constexpr size_t WS_WIN = 6 * MiB;
constexpr size_t WS_WIN8 = 12 * MiB + 512 * 1024;
constexpr size_t WS_WCAT = 17 * MiB;
constexpr size_t WS_WO = 19 * MiB;
constexpr size_t WS_WGU = 21 * MiB;
constexpr size_t WS_WD = 85 * MiB;
constexpr size_t WS_ACT0 = 117 * MiB;
constexpr size_t WS_RQ = 117 * MiB, WS_RK = 133 * MiB, WS_RV = 149 * MiB, WS_RG = 165 * MiB;
constexpr size_t WS_DQ1 = 181 * MiB;
constexpr size_t WS_DV = 213 * MiB;
constexpr size_t WS_GR = 229 * MiB, WS_GD = 261 * MiB;
constexpr size_t WS_END = 293 * MiB;
constexpr size_t WS_T1 = 117 * MiB;
constexpr size_t WS_MERGED = 149 * MiB;
constexpr size_t WS_H2 = 181 * MiB;
constexpr size_t WS_XG = 117 * MiB;
constexpr size_t WS_ACT = 213 * MiB;
constexpr size_t WS_X1 = 261 * MiB;
constexpr size_t WS_YS = 117 * MiB;
constexpr int CW_TMO = 0, CW_CODE = 1, CW_RET = 64, CW_MOD = 128, CW_BAR = 4096;
constexpr int RING_OFF = 0, RING_BYTES = 131072;
constexpr int LDSCTL_OFF = RING_BYTES, MISC_OFF = LDSCTL_OFF + 320;
constexpr int QS_OFF = RING_BYTES + 1024;
constexpr int LDS_BYTES = 147456;

typedef unsigned v2u __attribute__((ext_vector_type(2)));
typedef float f32x2 __attribute__((ext_vector_type(2)));
struct Frame {
    LAS unsigned char* lds;
    volatile LAS unsigned* MISC;
    gu32* ctl;
    int tid, lane, wave;
    int vcu, G;
    const float* in[22]; float* out; unsigned char* ws;
};
__device__ __forceinline__ float wave_sum(float v) {
#pragma unroll
    for (int o = 1; o < 64; o <<= 1) v += __shfl_xor(v, o);
    return v;
}
__device__ __forceinline__ float wave_max(float v) {
#pragma unroll
    for (int o = 1; o < 64; o <<= 1) v = fmaxf(v, __shfl_xor(v, o));
    return v;
}
__device__ __forceinline__ float bf2f_lo(unsigned w) { return __builtin_bit_cast(float, w << 16); }
__device__ __forceinline__ float bf2f_hi(unsigned w) { return __builtin_bit_cast(float, w & 0xffff0000u); }
__device__ __forceinline__ float bf2f(bf16 h) { return __builtin_bit_cast(float, ((unsigned)h) << 16); }
__device__ __forceinline__ float sigm(float v) { return __builtin_amdgcn_rcpf(1.0f + __builtin_amdgcn_exp2f(-LOG2E * v)); }
__device__ __forceinline__ float silu_exact(float v) { return v / (1.0f + __expf(-v)); }

__device__ __forceinline__ int gu_base(int o) { return (o >> 7) * 256 + ((o >> 2) & 1) * 128 + ((o >> 5) & 3) * 32 + ((o >> 3) & 3) * 4 + (o & 3); }
__device__ __forceinline__ void p0_transpose_item(const float* W, int N, bf16* WT, int dpitch, int kcol_off, int k0, int n0, int mode, int row_off, LAS float* scr, int lane) {
    float wv[32];
#pragma unroll
    for (int i = 0; i < 32; ++i) wv[i] = W[(size_t)(k0 + 2 * i + (lane >> 5)) * N + n0 + (lane & 31)];
#pragma unroll
    for (int i = 0; i < 32; ++i) scr[(2 * i + (lane >> 5)) * 33 + (lane & 31)] = wv[i];
    LDS_WAIT(); asm volatile("" ::: "memory");
    const int c = lane & 7;
#pragma unroll
    for (int j = 0; j < 4; ++j) { const int n = (lane >> 3) + 8 * j; const LAS float* s = scr + (8 * c) * 33 + n;
        v4u o; o.x = pk2(s[0 * 33], s[1 * 33]); o.y = pk2(s[2 * 33], s[3 * 33]); o.z = pk2(s[4 * 33], s[5 * 33]); o.w = pk2(s[6 * 33], s[7 * 33]);
        const int drow = row_off + (mode ? gu_base(n0 + n) : (n0 + n));
        *(GAS v4u*)(WT + (size_t)drow * dpitch + kcol_off + k0 + 8 * c) = o; }
    LDS_WAIT(); asm volatile("" ::: "memory");
}
__device__ __forceinline__ void p0_transpose_item8(const float* W, int N, unsigned char* WT, int dpitch, int k0, int n0, int mode, int row_off, LAS float* scr, int lane) {
    float wv[32];
#pragma unroll
    for (int i = 0; i < 32; ++i) wv[i] = W[(size_t)(k0 + 2 * i + (lane >> 5)) * N + n0 + (lane & 31)];
#pragma unroll
    for (int i = 0; i < 32; ++i) scr[(2 * i + (lane >> 5)) * 33 + (lane & 31)] = wv[i] * pg8::W8_SCALE;
    LDS_WAIT(); asm volatile("" ::: "memory");
    const int c = lane & 7;
#pragma unroll
    for (int j = 0; j < 4; ++j) { const int n = (lane >> 3) + 8 * j; const LAS float* s = scr + (8 * c) * 33 + n;
        v2u o; o.x = pg8::pk_fp8x4(s[0 * 33], s[1 * 33], s[2 * 33], s[3 * 33]); o.y = pg8::pk_fp8x4(s[4 * 33], s[5 * 33], s[6 * 33], s[7 * 33]);
        const int drow = row_off + (mode ? gu_base(n0 + n) : (n0 + n));
        *(GAS v2u*)(WT + (size_t)drow * dpitch + k0 + 8 * c) = o; }
    LDS_WAIT(); asm volatile("" ::: "memory");
}
constexpr int I_IN = 16 * 176, I_RO = 8 * 32, I_WO = 16 * 32, I_EX = 16 * 32;
constexpr int P0_NITEMS = I_IN + 2 * I_RO + I_WO + 48 * I_EX, P0_ITEMS = P0_NITEMS - 24 * I_EX;
__device__ __forceinline__ void p0_item(Frame& F, int it, LAS float* scr) {
    int r = it;
    if (r < I_IN) { p0_transpose_item(F.in[5], NIN, (bf16*)(F.ws + WS_WIN), 1024, 0, 64 * (r / 176), 32 * (r % 176), 0, 0, scr, F.lane); return; } r -= I_IN;
    if (r < I_RO) { p0_transpose_item(F.in[12], 1024, (bf16*)(F.ws + WS_WCAT), 1024, 0, 64 * (r / 32), 32 * (r % 32), 0, 0, scr, F.lane); return; } r -= I_RO;
    if (r < I_RO) { p0_transpose_item(F.in[13], 1024, (bf16*)(F.ws + WS_WCAT), 1024, 512, 64 * (r / 32), 32 * (r % 32), 0, 0, scr, F.lane); return; } r -= I_RO;
    if (r < I_WO) { p0_transpose_item(F.in[14], 1024, (bf16*)(F.ws + WS_WO), 1024, 0, 64 * (r / 32), 32 * (r % 32), 0, 0, scr, F.lane); return; } r -= I_WO;
    const int mat = r / I_EX, q = r % I_EX, ty = mat >> 4, e = mat & 15; const int k0 = 64 * (q / 32), n0 = 32 * (q % 32);
    if (ty == 0)      p0_transpose_item8(F.in[18] + (size_t)e * 1048576, 1024, F.ws + WS_WGU, 1024, k0, n0, 1, e * 2048, scr, F.lane);
    else if (ty == 1) p0_transpose_item8(F.in[19] + (size_t)e * 1048576, 1024, F.ws + WS_WGU, 1024, k0, n0, 1, e * 2048 + 16, scr, F.lane);
    else              p0_transpose_item8(F.in[20] + (size_t)e * 1048576, 1024, F.ws + WS_WD, 1024, k0, n0, 0, e * 1024, scr, F.lane);
}
__device__ __forceinline__ void p0_prologue(Frame& F) {
    if (blockIdx.x < 96) {
        LAS float* sc = (LAS float*)(F.lds);
        LAS float* red = (LAS float*)(F.lds + 32768);
        const float* cin = F.in[1];
        { float t_[16];
#pragma unroll
          for (int i = 0; i < 16; ++i) t_[i] = cin[F.tid + 512 * i];
#pragma unroll
          for (int i = 0; i < 16; ++i) { const int idx = F.tid + 512 * i, b = idx >> 10, k = idx & 1023; sc[k * 8 + b] = silu_exact(t_[i]); } }
        __syncthreads();
        const int j0 = blockIdx.x * 64; const float* wa = F.in[2] + j0 + F.lane;
        float a[8];
#pragma unroll
        for (int b = 0; b < 8; ++b) a[b] = 0.f;
        const int kb = F.wave * 128;
#pragma unroll 16
        for (int k = 0; k < 128; ++k) { const float wv = wa[(size_t)(kb + k) * 6144]; const f32x4 s0 = *(const LAS f32x4*)(sc + (kb + k) * 8), s1 = *(const LAS f32x4*)(sc + (kb + k) * 8 + 4);
            a[0] += s0[0] * wv; a[1] += s0[1] * wv; a[2] += s0[2] * wv; a[3] += s0[3] * wv; a[4] += s1[0] * wv; a[5] += s1[1] * wv; a[6] += s1[2] * wv; a[7] += s1[3] * wv; }
#pragma unroll
        for (int b = 0; b < 8; ++b) red[(F.wave * 8 + b) * 64 + F.lane] = a[b];
        __syncthreads();
        { const int b = F.wave; float s = F.in[3][j0 + F.lane];
#pragma unroll
          for (int w = 0; w < 8; ++w) s += red[(w * 8 + b) * 64 + F.lane];
          ((float*)(F.ws + WS_MOD))[b * 6144 + j0 + F.lane] = s; }
        __syncthreads();
    }
    { float* cs = (float*)(F.ws + WS_CS);
      for (int idx = blockIdx.x * 512 + F.tid; idx < 2048 * 64; idx += F.G * 512) { const int pos = idx >> 6, i = idx & 63;
          double inv = 1.0, r = 0.8639884494839686; int e = i;
          for (int t = 0; t < 6; ++t) { if (e & 1) inv *= r; r *= r; e >>= 1; }
          const float ang = (float)pos * (float)inv;
          const double rev = (double)ang * 0.15915494309189535; const float fr = (float)(rev - __builtin_rint(rev));
          cs[2 * idx] = __builtin_amdgcn_cosf(fr); cs[2 * idx + 1] = __builtin_amdgcn_sinf(fr); } }
    LAS float* scr = (LAS float*)(F.lds + RING_OFF + F.wave * 16384);
    const int gw = F.vcu * NWAVES + F.wave, NGW = F.G * NWAVES;
    constexpr int P0_A = 11904;
    if (F.G == 256) {
        for (int it = gw; it < P0_A; it += NGW) p0_item(F, it, scr);
        if (blockIdx.x >= 96) for (int it = P0_A + ((int)blockIdx.x - 96) * NWAVES + F.wave; it < P0_ITEMS; it += 160 * NWAVES) p0_item(F, it, scr);
    } else for (int it = gw; it < P0_ITEMS; it += NGW) p0_item(F, it, scr);
    __syncthreads();
}
__device__ __forceinline__ void p0_tail_items(Frame& F) {
    if (F.G != 256 || blockIdx.x < 128) { if (F.G != 256) { LAS float* scr = (LAS float*)(F.lds + RING_OFF + F.wave * 16384); for (int it = P0_ITEMS + F.vcu * NWAVES + F.wave; it < P0_NITEMS; it += F.G * NWAVES) p0_item(F, it, scr); } return; }
    LAS float* scr = (LAS float*)(F.lds + RING_OFF + F.wave * 16384);
    for (int it = P0_ITEMS + ((int)blockIdx.x - 128) * NWAVES + F.wave; it < P0_NITEMS; it += 128 * NWAVES) p0_item(F, it, scr);
}
__device__ __forceinline__ void p1_norm(Frame& F, bf16* XN) {
    const int gw = F.vcu * NWAVES + F.wave, NGW = F.G * NWAVES;
    const float* mod = (const float*)(F.ws + WS_MOD);
    for (int i = 0; i < M / NGW; ++i) { const int m = (F.G == 256) ? (F.vcu * 64 + F.wave * 8 + i) : (gw + i * NGW);
        const int b = m >> 11;
        const f32x4* xr = (const f32x4*)(F.in[0] + (size_t)m * D) + F.lane;
        const f32x4* gp = (const f32x4*)(F.in[4]) + F.lane;
        const f32x4* shp = (const f32x4*)(mod + b * 6144) + F.lane;
        const f32x4* scp = (const f32x4*)(mod + b * 6144 + 1024) + F.lane;
        f32x4 v[4]; float s = 0.f;
#pragma unroll
        for (int j = 0; j < 4; ++j) { v[j] = xr[64 * j]; s += (v[j].x * v[j].x + v[j].y * v[j].y) + (v[j].z * v[j].z + v[j].w * v[j].w); }
        const float rstd = 1.0f / sqrtf(wave_sum(s) * (1.f / D) + EPS);
        unsigned long long* o8 = (unsigned long long*)(XN + (size_t)m * D) + F.lane;
#pragma unroll
        for (int j = 0; j < 4; ++j) { const f32x4 g = gp[64 * j], sh = shp[64 * j], sc = scp[64 * j]; const f32x4 h = (v[j] * rstd) * g * (sc + 1.0f) + sh;
            o8[64 * j] = (unsigned long long)pk2(h.x, h.y) | ((unsigned long long)pk2(h.z, h.w) << 32); }
    }
}
__device__ __forceinline__ int t5_bucket(int rel) {
    const int n = rel < 0 ? -rel : rel; int bk;
    if (n < 8) bk = n; else if (n < 12) bk = 8; else if (n < 16) bk = 9; else if (n < 23) bk = 10; else if (n < 32) bk = 11; else if (n < 46) bk = 12; else if (n < 64) bk = 13; else if (n < 91) bk = 14; else bk = 15;
    return bk + (rel > 0 ? 16 : 0);
}
__device__ __forceinline__ float ln1m(float x) { return -x * (1.f + x * (0.5f + x * (0.33333334f + x * (0.25f + x * (0.2f + x * (0.16666667f + x * 0.14285715f)))))); }
template <int MODE>
__device__ __forceinline__ void naive_unit(Frame& F, int unit, float lam, bf16* YCAT) {
    const int b = unit >> 10, h = (unit >> 8) & 3, q0 = (unit & 255) * 8;
    LAS float* S = (LAS float*)(F.lds);
    unsigned qs_off = QS_OFF; asm volatile("" : "+v"(qs_off));
    LAS float* Qs = (LAS float*)(F.lds + qs_off);
    LAS float* BT = Qs + 1024;
    const bf16* RQ = (const bf16*)(F.ws + WS_RQ); const bf16* RK = (const bf16*)(F.ws + WS_RK); const bf16* RV = (const bf16*)(F.ws + WS_RV); const bf16* RG = (const bf16*)(F.ws + WS_RG);
    const bf16* DQ1 = (const bf16*)(F.ws + WS_DQ1); const bf16* DQ2 = DQ1 + (size_t)M * 256; const bf16* DK1 = DQ2 + (size_t)M * 256; const bf16* DK2 = DK1 + (size_t)M * 256;
    const bf16* DV = (const bf16*)(F.ws + WS_DV);
    const size_t rb = (size_t)b * SEQ;
    for (int idx = F.tid; idx < 1024; idx += 512) { const int qi = idx >> 7, d = idx & 127; const size_t row = rb + q0 + qi;
        float v;
        if (MODE == 0) v = bf2f(RQ[row * 512 + h * 128 + d]);
        else v = d < 64 ? bf2f(DQ1[row * 256 + h * 64 + d]) : bf2f(DQ2[row * 256 + h * 64 + d - 64]);
        Qs[idx] = v; }
    if (MODE == 1 && F.tid < 32) BT[F.tid] = F.in[15][F.tid * 4 + h] * LOG2E;
    __syncthreads();
    float l2f, l2b;
    { const float xf = __builtin_amdgcn_exp2f(-5.0f - (float)h); l2f = ln1m(xf) * LOG2E; l2b = ln1m(xf * 0.70710678118654752f) * LOG2E; }
    for (int j = F.tid; j < SEQ; j += 512) {
        asm volatile("" ::: "memory");
        float s1[8], s2[8];
#pragma unroll
        for (int qi = 0; qi < 8; ++qi) { s1[qi] = 0.f; s2[qi] = 0.f; }
#pragma unroll 1
        for (int c = 0; c < 16; ++c) {
            const bf16* kp;
            if (MODE == 0) kp = RK + (rb + j) * 512 + h * 128 + c * 8;
            else kp = (c < 8) ? (DK1 + (rb + j) * 256 + h * 64 + c * 8) : (DK2 + (rb + j) * 256 + h * 64 + (c - 8) * 8);
            const v4u kw = *(const v4u*)kp;
            const float kf[8] = {bf2f_lo(kw.x), bf2f_hi(kw.x), bf2f_lo(kw.y), bf2f_hi(kw.y), bf2f_lo(kw.z), bf2f_hi(kw.z), bf2f_lo(kw.w), bf2f_hi(kw.w)};
            float t[8];
#pragma unroll
            for (int qi = 0; qi < 8; ++qi) { const f32x4 qa = *(const LAS f32x4*)(Qs + qi * 128 + c * 8), qb = *(const LAS f32x4*)(Qs + qi * 128 + c * 8 + 4);
                t[qi] = (qa[0] * kf[0] + qa[1] * kf[1]) + (qa[2] * kf[2] + qa[3] * kf[3]) + (qb[0] * kf[4] + qb[1] * kf[5]) + (qb[2] * kf[6] + qb[3] * kf[7]); }
            if (MODE == 1 && c >= 8) {
#pragma unroll
                for (int qi = 0; qi < 8; ++qi) s2[qi] += t[qi];
            } else {
#pragma unroll
                for (int qi = 0; qi < 8; ++qi) s1[qi] += t[qi];
            }
        }
#pragma unroll
        for (int qi = 0; qi < 8; ++qi) { const int i = q0 + qi;
            if (MODE == 0) { const float w = (j <= i) ? __builtin_amdgcn_exp2f((float)(i - j) * l2f) : __builtin_amdgcn_exp2f((float)(j - i) * l2b); S[qi * SEQ + j] = s1[qi] * w; }
            else { const float bias = BT[t5_bucket(j - i)]; S[qi * SEQ + j] = s1[qi] + bias; S[(8 + qi) * SEQ + j] = s2[qi] + bias; } }
    }
    __syncthreads();
    const int qi = F.wave; LAS float* S1 = S + qi * SEQ; LAS float* S2 = S + (8 + qi) * SEQ;
    if (MODE == 1) {
        float m1 = -3.0e38f, m2 = -3.0e38f;
        for (int j = F.lane; j < SEQ; j += 64) { m1 = fmaxf(m1, S1[j]); m2 = fmaxf(m2, S2[j]); }
        m1 = wave_max(m1); m2 = wave_max(m2);
        float l1 = 0.f, l2 = 0.f;
        for (int j = F.lane; j < SEQ; j += 64) { l1 += __builtin_amdgcn_exp2f(S1[j] - m1); l2 += __builtin_amdgcn_exp2f(S2[j] - m2); }
        l1 = wave_sum(l1); l2 = wave_sum(l2);
        const float r1 = 1.0f / l1, r2 = lam / l2;
        for (int j = F.lane; j < SEQ; j += 64) S1[j] = __builtin_amdgcn_exp2f(S1[j] - m1) * r1 - __builtin_amdgcn_exp2f(S2[j] - m2) * r2;
        LDS_WAIT(); asm volatile("" ::: "memory");
    }
    const bf16* V = (MODE == 0 ? RV : DV) + rb * 512 + h * 128 + 2 * F.lane;
    float o0 = 0.f, o1 = 0.f;
#pragma unroll 8
    for (int j = 0; j < SEQ; ++j) { const float p = S1[j]; const unsigned vv = *(const unsigned*)(V + (size_t)j * 512); o0 += p * bf2f_lo(vv); o1 += p * bf2f_hi(vv); }
    const size_t row = rb + q0 + qi;
    if (MODE == 0) {
        const float mean = wave_sum(o0 + o1) * (1.f / 128.f); const float d0 = o0 - mean, d1 = o1 - mean;
        const float var = wave_sum(d0 * d0 + d1 * d1) * (1.f / 128.f); const float rstd = 1.0f / sqrtf(var + EPS);
        const unsigned gw = *(const unsigned*)(RG + row * 512 + h * 128 + 2 * F.lane);
        const float y0 = d0 * rstd * F.in[6][h * 128 + 2 * F.lane] * bf2f_lo(gw), y1 = d1 * rstd * F.in[6][h * 128 + 2 * F.lane + 1] * bf2f_hi(gw);
        *(unsigned*)(YCAT + row * 1024 + h * 128 + 2 * F.lane) = pk2(y0, y1);
    } else {
        const float ms = wave_sum(o0 * o0 + o1 * o1) * (1.f / 128.f); const float rstd = 1.0f / sqrtf(ms + EPS);
        const float y0 = o0 * rstd * F.in[7][2 * F.lane] * 0.8f, y1 = o1 * rstd * F.in[7][2 * F.lane + 1] * 0.8f;
        *(unsigned*)(YCAT + row * 1024 + 512 + h * 128 + 2 * F.lane) = pk2(y0, y1);
    }
    __syncthreads();
}
__device__ __forceinline__ void router_finish(const float (&lg)[16], int lane, float* affrow) {
    float r8[8], r4[4], r2[2], r1;
    { const bool up = (lane & 32) != 0;
#pragma unroll
      for (int e = 0; e < 8; ++e) { const float keep = up ? lg[e + 8] : lg[e], send = up ? lg[e] : lg[e + 8]; r8[e] = keep + __shfl_xor(send, 32); } }
    { const bool up = (lane & 16) != 0;
#pragma unroll
      for (int e = 0; e < 4; ++e) { const float keep = up ? r8[e + 4] : r8[e], send = up ? r8[e] : r8[e + 4]; r4[e] = keep + __shfl_xor(send, 16); } }
    { const bool up = (lane & 8) != 0;
#pragma unroll
      for (int e = 0; e < 2; ++e) { const float keep = up ? r4[e + 2] : r4[e], send = up ? r4[e] : r4[e + 2]; r2[e] = keep + __shfl_xor(send, 8); } }
    { const bool up = (lane & 4) != 0; const float keep = up ? r2[1] : r2[0], send = up ? r2[0] : r2[1]; r1 = keep + __shfl_xor(send, 4); }
    r1 += __shfl_xor(r1, 2); r1 += __shfl_xor(r1, 1);
    float mx = r1;
#pragma unroll
    for (int o = 4; o < 64; o <<= 1) mx = fmaxf(mx, __shfl_xor(mx, o));
    const float ex = __expf(r1 - mx); float den = ex;
#pragma unroll
    for (int o = 4; o < 64; o <<= 1) den += __shfl_xor(den, o);
    if ((lane & 3) == 0) { const int e = ((lane >> 5) & 1) * 8 + ((lane >> 4) & 1) * 4 + ((lane >> 3) & 1) * 2 + ((lane >> 2) & 1); affrow[e] = ex / den; }
}
__device__ __forceinline__ void p7_router(Frame& F, const bf16* X1, unsigned char* H2, float* AFF) {
    LAS float* wr = (LAS float*)(F.lds);
    { f32x4 t_[8];
#pragma unroll
      for (int i = 0; i < 8; ++i) { const int q = F.tid + 512 * i, eq = q >> 10, k = q & 1023; t_[i] = *(const f32x4*)(F.in[17] + k * 16 + 4 * eq); }
#pragma unroll
      for (int i = 0; i < 8; ++i) { const int q = F.tid + 512 * i, eq = q >> 10, k = q & 1023;
          wr[(4 * eq + 0) * 1024 + k] = t_[i].x; wr[(4 * eq + 1) * 1024 + k] = t_[i].y; wr[(4 * eq + 2) * 1024 + k] = t_[i].z; wr[(4 * eq + 3) * 1024 + k] = t_[i].w; } }
    __syncthreads();
    const int gw = F.vcu * NWAVES + F.wave, NGW = F.G * NWAVES;
    const float* mod = (const float*)(F.ws + WS_MOD);
#pragma unroll 1
    for (int i = 0; i < M / 4 / NGW; ++i) {
        const int m = (F.G == 256) ? (F.vcu * 64 + F.wave * 8 + 4 * i) : 4 * (gw + i * NGW), b = m >> 11;
        const f32x4* gp = (const f32x4*)(F.in[16]) + F.lane;
        const f32x4* shp = (const f32x4*)(mod + b * 6144 + 3072) + F.lane;
        const f32x4* scp = (const f32x4*)(mod + b * 6144 + 4096) + F.lane;
        f32x4 v[4][4]; float ss[4];
        { const v2u* x0 = (const v2u*)(X1 + (size_t)m * D) + F.lane;
#pragma unroll
          for (int r = 0; r < 4; ++r) { ss[r] = 0.f;
#pragma unroll
              for (int j = 0; j < 4; ++j) { const v2u w = x0[r * (D / 4) + 64 * j]; v[r][j] = (f32x4){bf2f_lo(w.x), bf2f_hi(w.x), bf2f_lo(w.y), bf2f_hi(w.y)};
                  ss[r] += (v[r][j].x * v[r][j].x + v[r][j].y * v[r][j].y) + (v[r][j].z * v[r][j].z + v[r][j].w * v[r][j].w); } } }
        f32x4 gs[4], sh[4];
#pragma unroll
        for (int j = 0; j < 4; ++j) { gs[j] = gp[64 * j] * (scp[64 * j] + 1.0f); sh[j] = shp[64 * j]; }
#pragma unroll
        for (int r = 0; r < 4; ++r) { const float rstd = 1.0f / sqrtf(wave_sum(ss[r]) * (1.f / D) + EPS);
            unsigned pk[4];
#pragma unroll
            for (int j = 0; j < 4; ++j) { v[r][j] = (v[r][j] * rstd) * gs[j] + sh[j]; pk[j] = pg8::pk_fp8x4(v[r][j].x, v[r][j].y, v[r][j].z, v[r][j].w); }
            const int qi = F.lane & 3; v4u st;
            { unsigned c0, c1, c2, c3;
              const unsigned mine0 = pk[0], mine1 = pk[1], mine2 = pk[2], mine3 = pk[3];
#define QSEL(s) ({ const unsigned a0_ = (unsigned)__builtin_amdgcn_mov_dpp((int)mine0, 0x55 * (s), 0xf, 0xf, true), a1_ = (unsigned)__builtin_amdgcn_mov_dpp((int)mine1, 0x55 * (s), 0xf, 0xf, true), \
                               a2_ = (unsigned)__builtin_amdgcn_mov_dpp((int)mine2, 0x55 * (s), 0xf, 0xf, true), a3_ = (unsigned)__builtin_amdgcn_mov_dpp((int)mine3, 0x55 * (s), 0xf, 0xf, true); \
                               qi == 0 ? a0_ : (qi == 1 ? a1_ : (qi == 2 ? a2_ : a3_)); })
              c0 = QSEL(0); c1 = QSEL(1); c2 = QSEL(2); c3 = QSEL(3);
#undef QSEL
              st = (v4u){c0, c1, c2, c3}; }
            *(v4u*)(H2 + (size_t)(m + r) * D + 256 * qi + 16 * (F.lane >> 2)) = st; }
        float l0[16], l1[16], l2[16], l3[16];
#pragma unroll
        for (int e = 0; e < 16; ++e) { float a0 = 0.f, a1 = 0.f, a2 = 0.f, a3 = 0.f;
#pragma unroll
            for (int j = 0; j < 4; ++j) { const f32x4 w = *(const LAS f32x4*)(wr + e * 1024 + 4 * F.lane + 256 * j);
                a0 += (v[0][j].x * w.x + v[0][j].y * w.y) + (v[0][j].z * w.z + v[0][j].w * w.w); a1 += (v[1][j].x * w.x + v[1][j].y * w.y) + (v[1][j].z * w.z + v[1][j].w * w.w);
                a2 += (v[2][j].x * w.x + v[2][j].y * w.y) + (v[2][j].z * w.z + v[2][j].w * w.w); a3 += (v[3][j].x * w.x + v[3][j].y * w.y) + (v[3][j].z * w.z + v[3][j].w * w.w); }
            asm volatile("" : "+v"(a0), "+v"(a1), "+v"(a2), "+v"(a3));
            l0[e] = a0; l1[e] = a1; l2[e] = a2; l3[e] = a3; }
        router_finish(l0, F.lane, AFF + (size_t)m * 16); router_finish(l1, F.lane, AFF + (size_t)(m + 1) * 16);
        router_finish(l2, F.lane, AFF + (size_t)(m + 2) * 16); router_finish(l3, F.lane, AFF + (size_t)(m + 3) * 16);
    }
    __syncthreads();
}
__device__ __forceinline__ void p8_topk(Frame& F, const float* AFF, int* SELI, float* SELG, int* INV) {
    LAS int* wsum = (LAS int*)(F.lds);
    LAS int* sel = (LAS int*)(F.lds + 1024);
    for (int item = blockIdx.x; item < NB * NE; item += F.G) {
        const int pe = item, half = 0, b = pe >> 4, e = pe & 15;
        unsigned key[4];
#pragma unroll
        for (int c = 0; c < 4; ++c) key[c] = __builtin_bit_cast(unsigned, AFF[((size_t)b * SEQ + 4 * F.tid + c) * 16 + e]);
        unsigned tau = 0u;
        for (int bit = 30; bit >= 0; --bit) {
            const unsigned cand = tau | (1u << bit);
            int cnt = 0;
#pragma unroll
            for (int c = 0; c < 4; ++c) cnt += __builtin_popcountll(__ballot(key[c] >= cand));
            LAS int* ws_ = wsum + (bit & 1) * 8;
            if (F.lane == 0) ws_[F.wave] = cnt;
            __syncthreads();
            int tot = 0;
#pragma unroll
            for (int w = 0; w < 8; ++w) tot += ws_[w];
            if (tot >= CAP) tau = cand;
        }
        int gt_before = 0, eq_before = 0;
        int my_gt = 0, my_eq = 0;
#pragma unroll
        for (int c = 0; c < 4; ++c) { my_gt += key[c] > tau; my_eq += key[c] == tau; }
        int pk = my_gt | (my_eq << 16), sc = pk;
#pragma unroll
        for (int o = 1; o < 64; o <<= 1) { const int v = __shfl_up(sc, o); if (F.lane >= o) sc += v; }
        LAS int* wtot = wsum + 16;
        __syncthreads();
        if (F.lane == 63) wtot[F.wave] = sc;
        __syncthreads();
        int base = 0, total = 0;
#pragma unroll
        for (int w = 0; w < 8; ++w) { const int v = wtot[w]; if (w < F.wave) base += v; total += v; }
        const int excl = base + sc - pk; gt_before = excl & 0xffff; eq_before = excl >> 16;
        const int n_gt = total & 0xffff, need = CAP - n_gt;
        const int slot0 = (e * NB + b) * CAP;
        int g = gt_before, q = eq_before;
#pragma unroll
        for (int c = 0; c < 4; ++c) { const int s = 4 * F.tid + c; int slot = -1;
            if (key[c] > tau) { slot = g; ++g; } else if (key[c] == tau) { if (q < need) slot = n_gt + q; ++q; }
            if (half == 0) INV[((size_t)b * SEQ + s) * 16 + e] = slot;
            if (slot >= 0) { SELI[slot0 + slot] = b * SEQ + s; SELG[slot0 + slot] = __builtin_bit_cast(float, key[c]); } }
        __syncthreads();
    }
}
__device__ __forceinline__ void p11_final(Frame& F, const bf16* X1, const unsigned char* YS, const int* INV) {
    const int gw = F.vcu * NWAVES + F.wave, NGW = F.G * NWAVES;
    const float* mod = (const float*)(F.ws + WS_MOD);
    for (int i = 0; i < M / 2 / NGW; ++i) {
        const int m0 = (F.G == 256) ? (F.vcu * 64 + F.wave * 8 + 2 * i) : 2 * (gw + i * NGW); const int b = m0 >> 11;
        const int inv0 = INV[(size_t)m0 * 16 + (F.lane & 15)], inv1 = INV[(size_t)(m0 + 1) * 16 + (F.lane & 15)];
        f32x4 v[2][4], y[2][4];
#pragma unroll
        for (int r = 0; r < 2; ++r) { const v2u* xr = (const v2u*)(X1 + (size_t)(m0 + r) * D) + F.lane;
#pragma unroll
            for (int j = 0; j < 4; ++j) { const v2u w = xr[64 * j]; v[r][j] = (f32x4){bf2f_lo(w.x), bf2f_hi(w.x), bf2f_lo(w.y), bf2f_hi(w.y)}; y[r][j] = (f32x4){0.f, 0.f, 0.f, 0.f}; } }
#pragma unroll
        for (int r = 0; r < 2; ++r) {
            const int myinv = r ? inv1 : inv0;
            unsigned mask = (unsigned)(__ballot(myinv >= 0) & 0xffffull);
            while (mask) {
                int w4[4][4]; int cnt = 0;
#pragma unroll
                for (int q = 0; q < 4; ++q) { if (mask) { const int e = __builtin_ctz(mask); mask &= mask - 1; const int slot = __builtin_amdgcn_readlane(myinv, e);
                        const int* yp = (const int*)(YS + (size_t)((e * NB + b) * CAP + slot) * D) + F.lane;
#pragma unroll
                        for (int j = 0; j < 4; ++j) w4[q][j] = yp[64 * j];
                        cnt = q + 1; } else {
#pragma unroll
                        for (int j = 0; j < 4; ++j) w4[q][j] = 0; } }
#pragma unroll
                for (int q = 0; q < 4; ++q)
#pragma unroll
                    for (int j = 0; j < 4; ++j) { const f32x2 lo = __builtin_amdgcn_cvt_pk_f32_fp8(w4[q][j], false), hi = __builtin_amdgcn_cvt_pk_f32_fp8(w4[q][j], true);
                        y[r][j] = y[r][j] + (f32x4){lo.x, lo.y, hi.x, hi.y}; }
                (void)cnt;
            }
        }
        const f32x4* gap = (const f32x4*)(mod + b * 6144 + 5120) + F.lane;
        const f32x4* gp = (const f32x4*)(F.in[21]) + F.lane;
#pragma unroll
        for (int r = 0; r < 2; ++r) { float s = 0.f;
#pragma unroll
            for (int j = 0; j < 4; ++j) { v[r][j] = v[r][j] + gap[64 * j] * y[r][j] * (1.f / pg8::YS_SCALE); s += (v[r][j].x * v[r][j].x + v[r][j].y * v[r][j].y) + (v[r][j].z * v[r][j].z + v[r][j].w * v[r][j].w); }
            const float rstd = 1.0f / sqrtf(wave_sum(s) * (1.f / D) + EPS);
            f32x4* orow = (f32x4*)(F.out + (size_t)(m0 + r) * D) + F.lane;
#pragma unroll
            for (int j = 0; j < 4; ++j) orow[64 * j] = (v[r][j] * rstd) * gp[64 * j]; }
    }
}

namespace mx {
typedef float f32x16 __attribute__((ext_vector_type(16)));
typedef short s16x4 __attribute__((ext_vector_type(4)));
typedef short v4i16_t __attribute__((ext_vector_type(4)));
typedef float f32x2_t __attribute__((ext_vector_type(2)));
typedef __bf16 bf16x2_t __attribute__((ext_vector_type(2)));
typedef LAS const char* lds_cptr;
constexpr int ST_K1 = 0, ST_K2 = 8192, ST_V = 16384, ST_BYTES = 32768;
constexpr int BT_OFF = QS_OFF;
__device__ __forceinline__ int crow(int r, int hi) { return (r & 3) + 8 * (r >> 2) + 4 * hi; }
__device__ __forceinline__ unsigned cvtpk(float lo, float hi) { f32x2_t v = {lo, hi}; bf16x2_t b = __builtin_convertvector(v, bf16x2_t); return __builtin_bit_cast(unsigned, b); }
__device__ __forceinline__ s16x4 vtr(lds_cptr p) { return __builtin_bit_cast(s16x4, __builtin_amdgcn_ds_read_tr16_b64_v4i16((LAS v4i16_t*)p)); }
template <int NKS>
__device__ __forceinline__ void qkt(f32x16& p0, f32x16& p1, lds_cptr kb, const bf16x8* qr) {
#pragma unroll
    for (int ks = 0; ks < NKS; ++ks) { const bf16x8 b0 = *(const LAS bf16x8*)(kb + ks * 2048), b1 = *(const LAS bf16x8*)(kb + ks * 2048 + 512);
        p0 = __builtin_amdgcn_mfma_f32_32x32x16_bf16(b0, qr[ks], p0, 0, 0, 0); p1 = __builtin_amdgcn_mfma_f32_32x32x16_bf16(b1, qr[ks], p1, 0, 0, 0); }
}
template <int NKS>
__device__ __forceinline__ void qkt1(f32x16& p, lds_cptr kb, const bf16x8* qr) {
#pragma unroll
    for (int ks = 0; ks < NKS; ++ks) { const bf16x8 b0 = *(const LAS bf16x8*)(kb + ks * 2048); p = __builtin_amdgcn_mfma_f32_32x32x16_bf16(b0, qr[ks], p, 0, 0, 0); }
}
template <int NKS>
__device__ __forceinline__ void kload(bf16x8 (&kf)[NKS], lds_cptr kb) {
#pragma unroll
    for (int ks = 0; ks < NKS; ++ks) kf[ks] = *(const LAS bf16x8*)(kb + ks * 2048);
}
template <int NKS>
__device__ __forceinline__ void kmma(f32x16& p, const f32x16& init, const bf16x8 (&kf)[NKS], const bf16x8* qr) {
    p = __builtin_amdgcn_mfma_f32_32x32x16_bf16(kf[0], qr[0], init, 0, 0, 0);
#pragma unroll
    for (int ks = 1; ks < NKS; ++ks) p = __builtin_amdgcn_mfma_f32_32x32x16_bf16(kf[ks], qr[ks], p, 0, 0, 0);
}
__device__ __forceinline__ bf16x8 packp(const f32x16& p, int s) {
    v4u w; w.x = cvtpk(p[8 * s + 0], p[8 * s + 1]); w.y = cvtpk(p[8 * s + 2], p[8 * s + 3]); w.z = cvtpk(p[8 * s + 4], p[8 * s + 5]); w.w = cvtpk(p[8 * s + 6], p[8 * s + 7]);
    return __builtin_bit_cast(bf16x8, w);
}
#define MX_SB() __builtin_amdgcn_sched_barrier(0)
__device__ __forceinline__ void vload(s16x4 (&lo)[4], s16x4 (&hh)[4], lds_cptr vp, int d0) {
#pragma unroll
    for (int kk = 0; kk < 4; ++kk) { lo[kk] = vtr(vp + d0 * 4096 + kk * 1024); hh[kk] = vtr(vp + d0 * 4096 + kk * 1024 + 512); }
}
__device__ __forceinline__ void vmma(f32x16& o, const s16x4 (&lo)[4], const s16x4 (&hh)[4], const bf16x8 (&pw)[4]) {
#pragma unroll
    for (int kk = 0; kk < 4; ++kk) { const bf16x8 vf = (bf16x8){lo[kk][0], lo[kk][1], lo[kk][2], lo[kk][3], hh[kk][0], hh[kk][1], hh[kk][2], hh[kk][3]};
        o = __builtin_amdgcn_mfma_f32_32x32x16_bf16(vf, pw[kk], o, 0, 0, 0); }
}
__device__ __forceinline__ void pv(f32x16 (&o)[4], lds_cptr vp, const bf16x8 (&pw)[4]) {
    s16x4 la[4], ha[4], lb[4], hb[4];
    vload(la, ha, vp, 0); vload(lb, hb, vp, 1); MX_SB();
    vmma(o[0], la, ha, pw); MX_SB(); vload(la, ha, vp, 2); MX_SB();
    vmma(o[1], lb, hb, pw); MX_SB(); vload(lb, hb, vp, 3); MX_SB();
    vmma(o[2], la, ha, pw); MX_SB();
    vmma(o[3], lb, hb, pw); MX_SB();
}
__device__ __forceinline__ float max32(const f32x16& a, const f32x16& b) {
    float m = fmaxf(a[0], b[0]);
#pragma unroll
    for (int r = 1; r < 16; ++r) m = fmaxf(m, fmaxf(a[r], b[r]));
    return m;
}

#define MX_WAITBAR(N) asm volatile("s_waitcnt vmcnt(" #N ") lgkmcnt(0)\n\ts_barrier" ::: "memory")
__device__ __forceinline__ void glds(const void* g, LAS unsigned char* l) { unsigned keep; const unsigned dst = (unsigned)__builtin_amdgcn_readfirstlane((int)(unsigned)(size_t)l);
    asm volatile("s_mov_b32 %0, m0\n\ts_mov_b32 m0, %2\n\ts_nop 0\n\tglobal_load_lds_dwordx4 %1, off\n\ts_mov_b32 m0, %0" : "=&s"(keep) : "v"(g), "s"(dst) : "memory"); }
__device__ __forceinline__ f32x16 splat16(float v) { f32x16 r;
#pragma unroll
    for (int i = 0; i < 16; ++i) r[i] = v;
    return r; }
template <int NKS>
__device__ __forceinline__ void qkt1i(f32x16& p, const f32x16& init, lds_cptr kb, const bf16x8* qr) {
    p = __builtin_amdgcn_mfma_f32_32x32x16_bf16(*(const LAS bf16x8*)(kb), qr[0], init, 0, 0, 0);
#pragma unroll
    for (int ks = 1; ks < NKS; ++ks) p = __builtin_amdgcn_mfma_f32_32x32x16_bf16(*(const LAS bf16x8*)(kb + ks * 2048), qr[ks], p, 0, 0, 0);
}

template <int VAR>
__device__ __forceinline__ void diff_unit(Frame& F, int b, int h, int qb, float lam, bf16* YCAT) {
    const int lane = F.lane, r32 = lane & 31, hi = lane >> 5, wave = F.wave, half = wave >> 2;
    const size_t rb = (size_t)b * SEQ; const int qw = qb * 256 + wave * 32;
    const bf16* DQ1 = (const bf16*)(F.ws + WS_DQ1); const bf16* DQ2 = DQ1 + (size_t)M * 256; const bf16* DK1 = DQ2 + (size_t)M * 256; const bf16* DK2 = DK1 + (size_t)M * 256;
    const bf16* DV = (const bf16*)(F.ws + WS_DV);
    LAS float* bt = (LAS float*)(F.lds + BT_OFF);
    __syncthreads();
    for (int i = F.tid; i < 512; i += 512) bt[i] = F.in[15][t5_bucket(i - 256) * 4 + h] * LOG2E;
    const float cneg = F.in[15][15 * 4 + h] * LOG2E, cpos = F.in[15][31 * 4 + h] * LOG2E;
    bf16x8 qr1[4], qr2[4];
#pragma unroll
    for (int ks = 0; ks < 4; ++ks) { qr1[ks] = *(const bf16x8*)(DQ1 + (rb + qw + r32) * 256 + h * 64 + ks * 16 + hi * 8); qr2[ks] = *(const bf16x8*)(DQ2 + (rb + qw + r32) * 256 + h * 64 + ks * 16 + hi * 8); }
    const bf16* k1src = DK1 + (rb + lane) * 256 + h * 64 + wave * 8; const bf16* k2src = DK2 + (rb + lane) * 256 + h * 64 + wave * 8;
    const bf16* vsrc0 = DV + (rb + ((2 * wave) & 3) * 16 + (lane >> 2)) * 512 + h * 128 + ((2 * wave) >> 2) * 32 + (lane & 3) * 8;
    const bf16* vsrc1 = DV + (rb + ((2 * wave + 1) & 3) * 16 + (lane >> 2)) * 512 + h * 128 + ((2 * wave + 1) >> 2) * 32 + (lane & 3) * 8;
    const lds_cptr L = (lds_cptr)F.lds;
    const int kfo = hi * 1024 + r32 * 16;
    const int vfo = ST_V + ((lane >> 4) & 1) * 32 + (lane & 3) * 8 + (4 * hi + ((lane & 15) >> 2)) * 64;
    const int btb = (256 - qw - r32 + 4 * hi) * 4;
#define DIFF_DMA(u, WITHV) do { const int so_ = ((u) % 3) * ST_BYTES; const size_t ko_ = (size_t)(u) * 64 * 256; \
        glds(k1src + ko_, F.lds + so_ + ST_K1 + wave * 1024); glds(k2src + ko_, F.lds + so_ + ST_K2 + wave * 1024); \
        if (WITHV) { const size_t vo_ = (size_t)(u) * 64 * 512; glds(vsrc0 + vo_, F.lds + so_ + ST_V + wave * 2048); glds(vsrc1 + vo_, F.lds + so_ + ST_V + wave * 2048 + 1024); } } while (0)
    constexpr int T = 32;
#define P1_DMA(u) do { const int so_ = ((u) % 6) * 16384; const size_t ko_ = (size_t)(u) * 64 * 256; \
        glds(k1src + ko_, F.lds + so_ + wave * 1024); glds(k2src + ko_, F.lds + so_ + 8192 + wave * 1024); } while (0)
#define P1_WAIT(t) do { const int rem_ = T - 2 - (t); if (rem_ >= 3) MX_WAITBAR(6); else if (rem_ == 2) MX_WAITBAR(4); else if (rem_ == 1) MX_WAITBAR(2); else MX_WAITBAR(0); } while (0)
#pragma unroll
    for (int ks = 0; ks < 4; ++ks) { asm volatile("" : "+v"(qr1[ks])); asm volatile("" : "+v"(qr2[ks])); }
    P1_DMA(0); P1_DMA(1); P1_DMA(2); P1_DMA(3);
    MX_WAITBAR(0);
    float mref1 = 0.f, mref2 = 0.f, l1 = 0.f, l2 = 0.f;
    f32x16 ni1 = splat16(0.f), ni2 = splat16(0.f);
    f32x16 a0, a1, c0, c1;
    const float ecneg = __builtin_amdgcn_exp2f(cneg), ecpos = __builtin_amdgcn_exp2f(cpos);
    for (int t = 0; t < ((VAR & 1) ? 0 : T); ++t) {
        const lds_cptr stg = L + (t % 6) * 16384;
        if (t + 4 < T) P1_DMA(t + 4);
        { bf16x8 ka[4], kb_[4], kc[4], kd[4];
          kload<4>(ka, stg + ST_K1 + kfo); kload<4>(kb_, stg + ST_K1 + kfo + 512); kload<4>(kc, stg + ST_K2 + kfo); kload<4>(kd, stg + ST_K2 + kfo + 512); MX_SB();
          kmma<4>(a0, ni1, ka, qr1); kmma<4>(a1, ni1, kb_, qr1); kmma<4>(c0, ni2, kc, qr2); kmma<4>(c1, ni2, kd, qr2); MX_SB(); }
        if (!(VAR & 16)) {
            const int kt = t * 64; float cc = 0.f, ecc = 1.f;
            if (kt <= qw - 191) { cc = cneg; ecc = ecneg; } else if (kt >= qw + 159) { cc = cpos; ecc = ecpos; }
            else { const LAS float* bp = (const LAS float*)((lds_cptr)bt + btb + kt * 4);
#pragma unroll
                for (int r = 0; r < 16; ++r) { const float b0 = bp[(r & 3) + 8 * (r >> 2)], b1 = bp[32 + (r & 3) + 8 * (r >> 2)]; a0[r] += b0; c0[r] += b0; a1[r] += b1; c1[r] += b1; } }
            float s1 = 0.f, s2 = 0.f;
#pragma unroll
            for (int r = 0; r < 16; ++r) { s1 += __builtin_amdgcn_exp2f(a0[r]) + __builtin_amdgcn_exp2f(a1[r]); s2 += __builtin_amdgcn_exp2f(c0[r]) + __builtin_amdgcn_exp2f(c1[r]); }
            s1 *= ecc; s2 *= ecc;
            if (__any(t == 0 || !(s1 < 1e15f) || !(s2 < 1e15f))) {
                { float d = max32(a0, a1) + cc; if (t != 0) d = fmaxf(d, 0.f); mref1 += d; l1 *= __builtin_amdgcn_exp2f(-d); const float sh = d - cc; s1 = 0.f;
#pragma unroll
                  for (int r = 0; r < 16; ++r) s1 += __builtin_amdgcn_exp2f(a0[r] - sh) + __builtin_amdgcn_exp2f(a1[r] - sh);
                  ni1 = splat16(-mref1); }
                { float d = max32(c0, c1) + cc; if (t != 0) d = fmaxf(d, 0.f); mref2 += d; l2 *= __builtin_amdgcn_exp2f(-d); const float sh = d - cc; s2 = 0.f;
#pragma unroll
                  for (int r = 0; r < 16; ++r) s2 += __builtin_amdgcn_exp2f(c0[r] - sh) + __builtin_amdgcn_exp2f(c1[r] - sh);
                  ni2 = splat16(-mref2); }
            }
            l1 += s1; l2 += s2;
        }
        P1_WAIT(t);
    }
    float ml1, ml2;
    { const float mo = __shfl_xor(mref1, 32), lo = __shfl_xor(l1, 32), mm = fmaxf(mref1, mo); const float ll = l1 * __builtin_amdgcn_exp2f(mref1 - mm) + lo * __builtin_amdgcn_exp2f(mo - mm); ml1 = mm + __builtin_amdgcn_logf(ll); }
    { const float mo = __shfl_xor(mref2, 32), lo = __shfl_xor(l2, 32), mm = fmaxf(mref2, mo); const float ll = l2 * __builtin_amdgcn_exp2f(mref2 - mm) + lo * __builtin_amdgcn_exp2f(mo - mm); ml2 = mm + __builtin_amdgcn_logf(ll); }
#define P2_DMA(u) do { const int so_ = ((u) & 3) * ST_BYTES; const size_t ko_ = (size_t)(u) * 64 * 256, vo_ = (size_t)(u) * 64 * 512; \
        glds(k1src + ko_, F.lds + so_ + ST_K1 + wave * 1024); glds(k2src + ko_, F.lds + so_ + ST_K2 + wave * 1024); \
        glds(vsrc0 + vo_, F.lds + so_ + ST_V + wave * 2048); glds(vsrc1 + vo_, F.lds + so_ + ST_V + wave * 2048 + 1024); } while (0)
    P2_DMA(0); P2_DMA(1);
    MX_WAITBAR(0);
    f32x16 o[4]; o[0] = f32x16{}; o[1] = f32x16{}; o[2] = f32x16{}; o[3] = f32x16{};
    bf16x8 pw[4];
    int cls = -1;
    for (int t = 0; t < T; ++t) {
        const lds_cptr stg = L + (t & 3) * ST_BYTES;
        if (t + 2 < T) P2_DMA(t + 2);
        if (t > 0) pv(o, L + ((t - 1) & 3) * ST_BYTES + vfo, pw);
        const int kt = t * 64; const int c3 = (kt <= qw - 191) ? 0 : ((kt >= qw + 159) ? 2 : 1);
        if (c3 != cls) { cls = c3; const float cc = (c3 == 0) ? cneg : ((c3 == 2) ? cpos : 0.f); ni1 = splat16(cc - ml1); ni2 = splat16(cc - ml2); }
        { bf16x8 ka[4], kc[4], kb_[4], kd[4];
          kload<4>(ka, stg + ST_K1 + kfo); kload<4>(kc, stg + ST_K2 + kfo); kload<4>(kb_, stg + ST_K1 + kfo + 512); kload<4>(kd, stg + ST_K2 + kfo + 512); MX_SB();
          kmma<4>(a0, ni1, ka, qr1); kmma<4>(c0, ni2, kc, qr2); kmma<4>(a1, ni1, kb_, qr1); kmma<4>(c1, ni2, kd, qr2); MX_SB(); }
        {
            if (c3 == 1) { const LAS float* bp = (const LAS float*)((lds_cptr)bt + btb + kt * 4);
#pragma unroll
                for (int r = 0; r < 16; ++r) { const float b0 = bp[(r & 3) + 8 * (r >> 2)], b1 = bp[32 + (r & 3) + 8 * (r >> 2)]; a0[r] += b0; c0[r] += b0; a1[r] += b1; c1[r] += b1; } }
#pragma unroll
            for (int r = 0; r < 16; ++r) a0[r] = __builtin_amdgcn_exp2f(a0[r]) - lam * __builtin_amdgcn_exp2f(c0[r]);
            pw[0] = packp(a0, 0); pw[1] = packp(a0, 1);
#pragma unroll
            for (int r = 0; r < 16; ++r) a1[r] = __builtin_amdgcn_exp2f(a1[r]) - lam * __builtin_amdgcn_exp2f(c1[r]);
            pw[2] = packp(a1, 0); pw[3] = packp(a1, 1);
        }
        if (t + 2 < T) MX_WAITBAR(4); else MX_WAITBAR(0);
    }
    pv(o, L + ((T - 1) & 3) * ST_BYTES + vfo, pw);
#undef P2_DMA
#undef DIFF_DMA
#undef P1_DMA
#undef P1_WAIT
    float ss = 0.f;
#pragma unroll
    for (int d0 = 0; d0 < 4; ++d0)
#pragma unroll
        for (int r = 0; r < 16; ++r) ss += o[d0][r] * o[d0][r];
    ss += __shfl_xor(ss, 32);
    const float rstd = 0.8f / sqrtf(ss * (1.f / 128.f) + EPS);
    bf16* yrow = YCAT + (rb + qw + r32) * 1024 + 512 + h * 128;
#pragma unroll
    for (int d0 = 0; d0 < 4; ++d0)
#pragma unroll
        for (int g = 0; g < 4; ++g) { const int dv = 32 * d0 + 8 * g + 4 * hi; const f32x4 gg = *(const f32x4*)(F.in[7] + dv);
            v2u w; w.x = cvtpk(o[d0][4 * g] * rstd * gg[0], o[d0][4 * g + 1] * rstd * gg[1]); w.y = cvtpk(o[d0][4 * g + 2] * rstd * gg[2], o[d0][4 * g + 3] * rstd * gg[3]);
            *(v2u*)(yrow + dv) = w; }
}

template <int VAR>
__device__ __forceinline__ void ret_unit(Frame& F, int b, int h, int qb, bf16* YCAT) {
    const int lane = F.lane, r32 = lane & 31, hi = lane >> 5, wave = F.wave, half = wave >> 2;
    const size_t rb = (size_t)b * SEQ; const int qw = qb * 256 + wave * 32;
    const bf16* RQ = (const bf16*)(F.ws + WS_RQ); const bf16* RK = (const bf16*)(F.ws + WS_RK); const bf16* RV = (const bf16*)(F.ws + WS_RV); const bf16* RG = (const bf16*)(F.ws + WS_RG);
    float l2f, l2b;
    { const float xf = __builtin_amdgcn_exp2f(-5.0f - (float)h); l2f = ln1m(xf) * LOG2E; l2b = ln1m(xf * 0.70710678118654752f) * LOG2E; }
    bf16x8 qr[8];
#pragma unroll
    for (int ks = 0; ks < 8; ++ks) qr[ks] = *(const bf16x8*)(RQ + (rb + qw + r32) * 512 + h * 128 + ks * 16 + hi * 8);
    const bf16* ksrc = RK + (rb + lane) * 512 + h * 128 + wave * 8;
    const bf16* vsrc0 = RV + (rb + ((2 * wave) & 3) * 16 + (lane >> 2)) * 512 + h * 128 + ((2 * wave) >> 2) * 32 + (lane & 3) * 8;
    const bf16* vsrc1 = RV + (rb + ((2 * wave + 1) & 3) * 16 + (lane >> 2)) * 512 + h * 128 + ((2 * wave + 1) >> 2) * 32 + (lane & 3) * 8;
    const lds_cptr L = (lds_cptr)F.lds;
    const int kfo = hi * 1024 + r32 * 16;
    const int vfo = ST_V + ((lane >> 4) & 1) * 32 + (lane & 3) * 8 + (4 * hi + ((lane & 15) >> 2)) * 64;
#define RET_DMA(u) do { const int so_ = ((u) % 3) * ST_BYTES; const size_t o_ = (size_t)(u) * 64 * 512; \
        glds(ksrc + o_, F.lds + so_ + wave * 1024); glds(ksrc + o_ + 64, F.lds + so_ + 8192 + wave * 1024); \
        glds(vsrc0 + o_, F.lds + so_ + ST_V + wave * 2048); glds(vsrc1 + o_, F.lds + so_ + ST_V + wave * 2048 + 1024); } while (0)
    constexpr int T = 32;
#pragma unroll
    for (int ks = 0; ks < 8; ++ks) asm volatile("" : "+v"(qr[ks]));
    __syncthreads();
    RET_DMA(0); RET_DMA(1);
    MX_WAITBAR(0);
    f32x16 o[4]; o[0] = f32x16{}; o[1] = f32x16{}; o[2] = f32x16{}; o[3] = f32x16{};
    bf16x8 pw[4];
    const float nl2f = -l2f, nl2b = -l2b;
    if (half) MX_WAITBAR(0);
    for (int t = 0; t < T; ++t) {
        const lds_cptr stg = L + (t % 3) * ST_BYTES;
        if (!(VAR & 8) && half && t + 2 < T) RET_DMA(t + 2);
        {
            f32x16 a0, a1; const f32x16 zero16 = {};
            if (VAR & 4) { a0 = splat16((float)t); a1 = splat16((float)(t + 1)); } else
            { bf16x8 ka[8], kb_[8]; kload<8>(ka, stg + kfo); kload<8>(kb_, stg + kfo + 512); MX_SB(); kmma<8>(a0, zero16, ka, qr); kmma<8>(a1, zero16, kb_, qr); MX_SB(); }
            const int kt = t * 64;
            const float e0 = (float)(qw + r32 - kt - 4 * hi);
            if (VAR & 1) { } else if (kt + 63 <= qw) {
                const float bl = e0 * l2f;
#pragma unroll
                for (int r = 0; r < 16; ++r) { const float cr = (float)((r & 3) + 8 * (r >> 2)); a0[r] *= __builtin_amdgcn_exp2f(__builtin_fmaf(cr, nl2f, bl)); a1[r] *= __builtin_amdgcn_exp2f(__builtin_fmaf(cr + 32.f, nl2f, bl)); }
            } else if (kt > qw + 31) {
                const float bl = -e0 * l2b;
#pragma unroll
                for (int r = 0; r < 16; ++r) { const float cr = (float)((r & 3) + 8 * (r >> 2)); a0[r] *= __builtin_amdgcn_exp2f(__builtin_fmaf(cr, l2b, bl)); a1[r] *= __builtin_amdgcn_exp2f(__builtin_fmaf(cr + 32.f, l2b, bl)); }
            } else {
#pragma unroll
                for (int r = 0; r < 16; ++r) { const float cr = (float)((r & 3) + 8 * (r >> 2)); const float d0 = e0 - cr, d1 = e0 - cr - 32.f;
                    a0[r] *= __builtin_amdgcn_exp2f(fminf(d0 * l2f, d0 * nl2b)); a1[r] *= __builtin_amdgcn_exp2f(fminf(d1 * l2f, d1 * nl2b)); }
            }
            pw[0] = packp(a0, 0); pw[1] = packp(a0, 1); pw[2] = packp(a1, 0); pw[3] = packp(a1, 1);
        }
        if (t + 2 < T) MX_WAITBAR(4); else MX_WAITBAR(0);
        if (!(VAR & 8) && !half && t + 2 < T) RET_DMA(t + 2);
        if (!(VAR & 2)) pv(o, stg + vfo, pw);
        if (t + 2 < T) MX_WAITBAR(4); else MX_WAITBAR(0);
    }
    if (!half) MX_WAITBAR(0);
#undef RET_DMA
    float sm = 0.f;
#pragma unroll
    for (int d0 = 0; d0 < 4; ++d0)
#pragma unroll
        for (int r = 0; r < 16; ++r) sm += o[d0][r];
    sm += __shfl_xor(sm, 32);
    const float mean = sm * (1.f / 128.f); float q = 0.f;
#pragma unroll
    for (int d0 = 0; d0 < 4; ++d0)
#pragma unroll
        for (int r = 0; r < 16; ++r) { o[d0][r] -= mean; q += o[d0][r] * o[d0][r]; }
    q += __shfl_xor(q, 32);
    const float rstd = 1.0f / sqrtf(q * (1.f / 128.f) + EPS);
    const size_t row = rb + qw + r32;
#pragma unroll
    for (int d0 = 0; d0 < 4; ++d0)
#pragma unroll
        for (int g = 0; g < 4; ++g) { const int dv = 32 * d0 + 8 * g + 4 * hi; const f32x4 gg = *(const f32x4*)(F.in[6] + h * 128 + dv); const v2u gw = *(const v2u*)(RG + row * 512 + h * 128 + dv);
            v2u w; w.x = cvtpk(o[d0][4 * g] * rstd * gg[0] * bf2f_lo(gw.x), o[d0][4 * g + 1] * rstd * gg[1] * bf2f_hi(gw.x));
            w.y = cvtpk(o[d0][4 * g + 2] * rstd * gg[2] * bf2f_lo(gw.y), o[d0][4 * g + 3] * rstd * gg[3] * bf2f_hi(gw.y));
            *(v2u*)(YCAT + row * 1024 + h * 128 + dv) = w; }
    __syncthreads();
}

constexpr int CH = 128;
__device__ __forceinline__ void ret_state_job(Frame& F, int job, bf16* ST) {
    const int lane = F.lane, hi = lane >> 5, wave = F.wave, tid = F.tid;
    const int bh = job >> 3, dir = (job >> 2) & 1, dvq = job & 3, b = bh >> 2, h = bh & 3;
    const size_t rb = (size_t)b * SEQ;
    const bf16* RK = (const bf16*)(F.ws + WS_RK); const bf16* RV = (const bf16*)(F.ws + WS_RV);
    float l2g; { const float xf = __builtin_amdgcn_exp2f(-5.0f - (float)h); l2g = dir ? ln1m(xf * 0.70710678118654752f) * LOG2E : ln1m(xf) * LOG2E; }
    const float cdec = __builtin_amdgcn_exp2f(128.f * l2g);
    constexpr int SB_ = 40960, DEC_OFF = 3 * SB_;
    __syncthreads();
    if (tid < 128) ((LAS float*)(F.lds + DEC_OFF))[tid] = __builtin_amdgcn_exp2f((dir ? (float)tid : (float)(127 - tid)) * l2g);
    auto chunk_of = [&](int i) { return dir ? (15 - i) : i; };
#define ST_DMA(i) do { const int so_ = ((i) % 3) * SB_; const size_t o_ = (size_t)chunk_of(i) * CH * 512; \
        _Pragma("unroll") for (int j_ = 0; j_ < 4; ++j_) { const int blk_ = wave * 4 + j_, d0_ = blk_ >> 3, rg_ = blk_ & 7; \
            glds(RK + o_ + (rb + rg_ * 16 + (lane >> 2)) * 512 + h * 128 + d0_ * 32 + (lane & 3) * 8, F.lds + so_ + blk_ * 1024); } \
        glds(RV + o_ + (rb + wave * 16 + (lane >> 2)) * 512 + h * 128 + dvq * 32 + (lane & 3) * 8, F.lds + so_ + 32768 + wave * 1024); } while (0)
    ST_DMA(0); ST_DMA(1);
    MX_WAITBAR(0);
    const lds_cptr L = (lds_cptr)F.lds;
    const int trp = ((lane >> 4) & 1) * 32 + (lane & 3) * 8 + (4 * hi + ((lane & 15) >> 2)) * 64;
    const LAS float* dec = (const LAS float*)(F.lds + DEC_OFF) + 4 * hi;
    f32x16 acc = {};
    for (int i = 0; i < 16; ++i) {
        const int st = (i % 3) * SB_;
        if (i + 2 < 16) ST_DMA(i + 2);
        if (wave < 4) {
            const int n = chunk_of(i);
            bf16* sp = ST + ((size_t)((dir * 32 + bh) * 16 + n) * 128 + dvq * 32 + (lane & 31)) * 128 + wave * 32 + 4 * hi;
#pragma unroll
            for (int g = 0; g < 4; ++g) { v2u w; w.x = cvtpk(acc[4 * g], acc[4 * g + 1]); w.y = cvtpk(acc[4 * g + 2], acc[4 * g + 3]); *(v2u*)(sp + 8 * g) = w; }
#pragma unroll
            for (int r = 0; r < 16; ++r) acc[r] *= cdec;
            s16x4 kl[8], kh[8], vl[8], vh[8]; f32x4 dl[8], dh_[8];
#pragma unroll
            for (int ks = 0; ks < 8; ++ks) { const lds_cptr kp = L + st + (wave * 8 + ks) * 1024 + trp, vp = L + st + 32768 + ks * 1024 + trp;
                kl[ks] = vtr(kp); kh[ks] = vtr(kp + 512); vl[ks] = vtr(vp); vh[ks] = vtr(vp + 512);
                dl[ks] = *(const LAS f32x4*)(dec + 16 * ks); dh_[ks] = *(const LAS f32x4*)(dec + 16 * ks + 8); }
            MX_SB();
#pragma unroll
            for (int ks = 0; ks < 8; ++ks) {
                const bf16x8 kf = (bf16x8){kl[ks][0], kl[ks][1], kl[ks][2], kl[ks][3], kh[ks][0], kh[ks][1], kh[ks][2], kh[ks][3]};
                const v2u ul = __builtin_bit_cast(v2u, vl[ks]), uh = __builtin_bit_cast(v2u, vh[ks]); v4u w;
                w.x = cvtpk(bf2f_lo(ul.x) * dl[ks][0], bf2f_hi(ul.x) * dl[ks][1]); w.y = cvtpk(bf2f_lo(ul.y) * dl[ks][2], bf2f_hi(ul.y) * dl[ks][3]);
                w.z = cvtpk(bf2f_lo(uh.x) * dh_[ks][0], bf2f_hi(uh.x) * dh_[ks][1]); w.w = cvtpk(bf2f_lo(uh.y) * dh_[ks][2], bf2f_hi(uh.y) * dh_[ks][3]);
                acc = __builtin_amdgcn_mfma_f32_32x32x16_bf16(kf, __builtin_bit_cast(bf16x8, w), acc, 0, 0, 0);
            }
        }
        if (i + 2 < 16) MX_WAITBAR(5); else MX_WAITBAR(0);
    }
#undef ST_DMA
    __syncthreads();
}
__device__ __forceinline__ bf16x8 scale8(const bf16x8& q, float s) {
    const v4u u = __builtin_bit_cast(v4u, q); v4u w;
    w.x = cvtpk(bf2f_lo(u.x) * s, bf2f_hi(u.x) * s); w.y = cvtpk(bf2f_lo(u.y) * s, bf2f_hi(u.y) * s); w.z = cvtpk(bf2f_lo(u.z) * s, bf2f_hi(u.z) * s); w.w = cvtpk(bf2f_lo(u.w) * s, bf2f_hi(u.w) * s);
    return __builtin_bit_cast(bf16x8, w);
}
__device__ __forceinline__ void ret_out_unit(Frame& F, int b, int h, int m, const bf16* ST, bf16* YCAT) {
    const int lane = F.lane, r32 = lane & 31, hi = lane >> 5, wave = F.wave, rbk = wave & 3, dh = wave >> 2;
    const size_t rb = (size_t)b * SEQ; const int bh = b * 4 + h; const int row0 = m * CH;
    const bf16* RQ = (const bf16*)(F.ws + WS_RQ); const bf16* RK = (const bf16*)(F.ws + WS_RK); const bf16* RV = (const bf16*)(F.ws + WS_RV); const bf16* RG = (const bf16*)(F.ws + WS_RG);
    float l2f, l2b;
    { const float xf = __builtin_amdgcn_exp2f(-5.0f - (float)h); l2f = ln1m(xf) * LOG2E; l2b = ln1m(xf * 0.70710678118654752f) * LOG2E; }
    const int il = rbk * 32 + r32;
    bf16x8 qr[8];
#pragma unroll
    for (int ks = 0; ks < 8; ++ks) qr[ks] = *(const bf16x8*)(RQ + (rb + row0 + il) * 512 + h * 128 + ks * 16 + hi * 8);
#pragma unroll
    for (int ks = 0; ks < 8; ++ks) asm volatile("" : "+v"(qr[ks]));
    const bf16* sfp = ST + (size_t)((0 * 32 + bh) * 16 + m) * 128 * 128; const bf16* sbp = ST + (size_t)((1 * 32 + bh) * 16 + m) * 128 * 128;
    __syncthreads();
#pragma unroll
    for (int i = 0; i < 4; ++i) { const int pc = wave * 4 + i, c = pc >> 1, hf = pc & 1;
        glds(RK + (rb + row0 + hf * 64 + lane) * 512 + h * 128 + c * 8, F.lds + c * 2048 + hf * 1024);
        glds(sfp + (size_t)(hf * 64 + lane) * 128 + c * 8, F.lds + 65536 + c * 2048 + hf * 1024);
        glds(sbp + (size_t)(hf * 64 + lane) * 128 + c * 8, F.lds + 98304 + c * 2048 + hf * 1024);
        const int blk = wave * 4 + i, d0 = blk >> 3, rg = blk & 7;
        glds(RV + (rb + row0 + rg * 16 + (lane >> 2)) * 512 + h * 128 + d0 * 32 + (lane & 3) * 8, F.lds + 32768 + blk * 1024); }
    MX_WAITBAR(0);
    const lds_cptr L = (lds_cptr)F.lds;
    const int kfo = hi * 2048 + r32 * 16;
    const int trp = ((lane >> 4) & 1) * 32 + (lane & 3) * 8 + (4 * hi + ((lane & 15) >> 2)) * 64;
    f32x16 o[2]; o[0] = f32x16{}; o[1] = f32x16{};
    const f32x16 zero16 = {};
    const float nl2b = -l2b;
#pragma unroll
    for (int t = 0; t < 2; ++t) {
        f32x16 a0, a1;
        { bf16x8 ka[8], kb_[8];
#pragma unroll
          for (int ks = 0; ks < 8; ++ks) { ka[ks] = *(const LAS bf16x8*)(L + kfo + ks * 4096 + (2 * t) * 512); kb_[ks] = *(const LAS bf16x8*)(L + kfo + ks * 4096 + (2 * t + 1) * 512); }
          kmma<8>(a0, zero16, ka, qr); kmma<8>(a1, zero16, kb_, qr); }
        const float e0 = (float)(il - 64 * t - 4 * hi);
#pragma unroll
        for (int r = 0; r < 16; ++r) { const float cr = (float)((r & 3) + 8 * (r >> 2)); const float d0 = e0 - cr, d1 = e0 - cr - 32.f;
            a0[r] *= __builtin_amdgcn_exp2f(fminf(d0 * l2f, d0 * nl2b)); a1[r] *= __builtin_amdgcn_exp2f(fminf(d1 * l2f, d1 * nl2b)); }
        bf16x8 pw[4]; pw[0] = packp(a0, 0); pw[1] = packp(a0, 1); pw[2] = packp(a1, 0); pw[3] = packp(a1, 1);
#pragma unroll
        for (int dd = 0; dd < 2; ++dd)
#pragma unroll
            for (int kk = 0; kk < 4; ++kk) { const lds_cptr vp = L + 32768 + ((2 * dh + dd) * 8 + 4 * t + kk) * 1024 + trp; const s16x4 lo = vtr(vp), hh = vtr(vp + 512);
                const bf16x8 vf = (bf16x8){lo[0], lo[1], lo[2], lo[3], hh[0], hh[1], hh[2], hh[3]};
                o[dd] = __builtin_amdgcn_mfma_f32_32x32x16_bf16(vf, pw[kk], o[dd], 0, 0, 0); }
    }
    { const float sf = __builtin_amdgcn_exp2f((float)(il + 1) * l2f), sb = __builtin_amdgcn_exp2f((float)(CH - il) * l2b);
#pragma unroll
      for (int ks = 0; ks < 8; ++ks) { const bf16x8 qf = scale8(qr[ks], sf), qb = scale8(qr[ks], sb);
#pragma unroll
          for (int dd = 0; dd < 2; ++dd) { const int off = kfo + ks * 4096 + (2 * dh + dd) * 512;
              o[dd] = __builtin_amdgcn_mfma_f32_32x32x16_bf16(*(const LAS bf16x8*)(L + 65536 + off), qf, o[dd], 0, 0, 0);
              o[dd] = __builtin_amdgcn_mfma_f32_32x32x16_bf16(*(const LAS bf16x8*)(L + 98304 + off), qb, o[dd], 0, 0, 0); } } }
    float s = 0.f, ss = 0.f;
#pragma unroll
    for (int dd = 0; dd < 2; ++dd)
#pragma unroll
        for (int r = 0; r < 16; ++r) { s += o[dd][r]; ss += o[dd][r] * o[dd][r]; }
    s += __shfl_xor(s, 32); ss += __shfl_xor(ss, 32);
    LAS float* ex = (LAS float*)(F.lds + QS_OFF);
    if (hi == 0) { ex[(wave * 32 + r32) * 2] = s; ex[(wave * 32 + r32) * 2 + 1] = ss; }
    __syncthreads();
    { const int pw_ = wave ^ 4; s += ex[(pw_ * 32 + r32) * 2]; ss += ex[(pw_ * 32 + r32) * 2 + 1]; }
    const float mean = s * (1.f / 128.f); const float var = fmaxf(ss * (1.f / 128.f) - mean * mean, 0.f); const float rstd = 1.0f / sqrtf(var + EPS);
    const size_t row = rb + row0 + il;
#pragma unroll
    for (int dd = 0; dd < 2; ++dd)
#pragma unroll
        for (int g = 0; g < 4; ++g) { const int dv = 32 * (2 * dh + dd) + 8 * g + 4 * hi; const f32x4 gg = *(const f32x4*)(F.in[6] + h * 128 + dv); const v2u gw = *(const v2u*)(RG + row * 512 + h * 128 + dv);
            v2u w; w.x = cvtpk((o[dd][4 * g] - mean) * rstd * gg[0] * bf2f_lo(gw.x), (o[dd][4 * g + 1] - mean) * rstd * gg[1] * bf2f_hi(gw.x));
            w.y = cvtpk((o[dd][4 * g + 2] - mean) * rstd * gg[2] * bf2f_lo(gw.y), (o[dd][4 * g + 3] - mean) * rstd * gg[3] * bf2f_hi(gw.y));
            *(v2u*)(YCAT + row * 1024 + h * 128 + dv) = w; }
    __syncthreads();
}
#undef MX_WAITBAR
#undef MX_SB
}
#ifndef RET_CHUNKED
#define RET_CHUNKED 1
#endif
#ifndef MIX_FAST
#define MIX_FAST 3
#endif
#ifndef MK_PER_PHASE
#define MK_PER_PHASE 0
#endif
constexpr int N_PHASES = 12;
struct Args { const float* in[22]; float* out; unsigned char* ws; int ph_lo, ph_hi; };
__global__ void __launch_bounds__(NWAVES * 64, 2) fwd_kernel(Args args) {
    extern __shared__ __attribute__((aligned(16))) unsigned char lds[];
    Frame F;
    F.lds = (LAS unsigned char*)lds;
    F.MISC = (volatile LAS unsigned*)(F.lds + MISC_OFF);
    F.tid = threadIdx.x; F.lane = F.tid & 63; F.wave = __builtin_amdgcn_readfirstlane(F.tid >> 6);
    F.G = gridDim.x; { const int bx = blockIdx.x; F.vcu = (F.G % 8 == 0) ? (bx % 8) * (F.G / 8) + bx / 8 : bx; }
    F.ws = args.ws; F.out = args.out; F.ctl = (gu32*)(args.ws + WS_CTL);
#pragma unroll
    for (int i = 0; i < 22; ++i) F.in[i] = args.in[i];
    for (int u = F.tid; u < (LDS_BYTES - LDSCTL_OFF) / 4; u += NWAVES * 64) ((LAS unsigned*)(F.lds + LDSCTL_OFF))[u] = 0u;
    __syncthreads();
    XcdBarrier bar; bar.bar = (unsigned*)(F.ctl + CW_BAR); bar.x = 0; bar.st = nullptr;
    if (!MK_PER_PHASE) bar = xcd_barrier_post((unsigned*)(F.ctl + CW_BAR), F.MISC + 8);
    const int lo = args.ph_lo, hi = args.ph_hi;
#ifndef PHASE_MASK
#define PHASE_MASK 0xfff
#endif
#define IN(k) (((PHASE_MASK >> (k)) & 1) && lo <= (k) && (k) < hi)
#define GRID_BAR(k) do { if (IN(k) && IN((k) + 1)) xcd_barrier(bar); } while (0)
#ifndef DUP_MASK
#define DUP_MASK 0
#endif
#define REP(k) _Pragma("unroll") for (int rep_ = 0; rep_ < 1 + ((DUP_MASK >> (k)) & 1); ++rep_)
    unsigned char* ws = args.ws;
    bf16* XN = (bf16*)args.out;
    bf16* YCAT = (bf16*)args.out;
    float* X1 = args.out;
    const float* MOD = (const float*)(ws + WS_MOD);

    if (IN(0)) REP(0) { p0_prologue(F); }
    GRID_BAR(0);
    if (IN(1)) REP(1) { p1_norm(F, XN); }
    GRID_BAR(1);
    if (IN(2)) REP(2) {
        pg8::Gemm g{XN, (const bf16*)(ws + WS_WIN), M, NIN, D, D, D, 1 << 30, 0};
        pg8::StaticOrder S; S.init(M, NIN, F.G, (int)blockIdx.x);
        pg8::EpiProj E{(bf16*)ws, (const float*)(ws + WS_CS), WS_RQ / 2, WS_RK / 2, WS_RV / 2, WS_RG / 2, WS_DQ1 / 2, WS_DV / 2, WS_GR / 2, WS_GD / 2};
        pg8::gemm_phase<pg8::EpiProj, pg8::StaticOrder, true, true>(F.lds + RING_OFF, g, S, E);
        p0_tail_items(F);
    }
    GRID_BAR(2);
    if (IN(3)) REP(3) {
        float lam;
        { float a = F.lane < 64 ? F.in[8][F.lane] * F.in[9][F.lane] : 0.f, c = F.in[10][F.lane] * F.in[11][F.lane];
          lam = __expf(wave_sum(a)) - __expf(wave_sum(c)) + 0.2f; }
#if RET_CHUNKED
        { bf16* ST = (bf16*)args.out + (size_t)M * 1024; for (int j = F.vcu; j < 256; j += F.G) mx::ret_state_job(F, j, ST); }
        VM_WAIT(); __syncthreads();
        if (F.tid == 0) { __builtin_amdgcn_fence(__ATOMIC_RELEASE, "agent"); VM_WAIT(); __hip_atomic_fetch_add((unsigned*)(F.ctl + CW_RET), 1u, RLX_AGENT); }
#endif
#if (MIX_FAST & 1)
        { const int u = F.vcu; if (u < 256) mx::diff_unit<0>(F, u >> 5, (u >> 3) & 3, u & 7, lam, YCAT); }
#ifdef DIFF_VAR
        { const int u = F.vcu; if (u < 256) mx::diff_unit<DIFF_VAR>(F, u >> 5, (u >> 3) & 3, u & 7, lam, YCAT + (size_t)M * 1024); }
#endif
#else
        for (int u = F.vcu; u < 8192; u += F.G) naive_unit<1>(F, u, lam, YCAT);
#endif
#if (MIX_FAST & 2)
#if RET_CHUNKED
        { bf16* ST = (bf16*)args.out + (size_t)M * 1024;
          if (F.tid == 0) { unsigned sp_ = 0; const unsigned want = (unsigned)(F.G < 256 ? F.G : 256);
              while (__hip_atomic_load((unsigned*)(F.ctl + CW_RET), RLX_AGENT) < want) { __builtin_amdgcn_s_sleep(2); if (++sp_ > (1u << 22)) { __hip_atomic_store((unsigned*)(F.ctl + CW_TMO), 1u, RLX_AGENT); break; } }
              __builtin_amdgcn_fence(__ATOMIC_ACQUIRE, "agent"); VM_WAIT(); }
          __syncthreads();
          for (int u = F.vcu; u < 512; u += F.G) mx::ret_out_unit(F, u >> 6, (u >> 4) & 3, u & 15, ST, YCAT); }
#else
        { const int u = F.vcu; if (u < 256) mx::ret_unit<0>(F, u >> 5, (u >> 3) & 3, u & 7, YCAT); }
#endif
#else
        for (int u = F.vcu; u < 8192; u += F.G) naive_unit<0>(F, u, lam, YCAT);
#endif
    }
    GRID_BAR(3);
    if (IN(4)) REP(4) {
        pg8::Gemm g{YCAT, (const bf16*)(ws + WS_WCAT), M, D, D, D, D, 1 << 30, 0};
        pg8::StaticOrder S; S.init(M, D, F.G, (int)blockIdx.x);
        pg8::EpiGate2 E{(bf16*)(ws + WS_MERGED), (const bf16*)(ws + WS_GR), (const bf16*)(ws + WS_GD), D};
        pg8::gemm_phase<pg8::EpiGate2, pg8::StaticOrder, true, true>(F.lds + RING_OFF, g, S, E);
    }
    GRID_BAR(5);
    if (IN(6)) REP(6) {
        pg8::Gemm g{(const bf16*)(ws + WS_MERGED), (const bf16*)(ws + WS_WO), M, D, D, D, D, 1 << 30, 0};
        pg8::StaticOrder S; S.init(M, D, F.G, (int)blockIdx.x);
        pg8::EpiResidB E{(bf16*)(ws + WS_X1), F.in[0], MOD + 2048, D, 6144};
        pg8::gemm_phase<pg8::EpiResidB, pg8::StaticOrder, true, true>(F.lds + RING_OFF, g, S, E);
    }
    GRID_BAR(6);
    if (IN(7)) REP(7) { p7_router(F, (const bf16*)(ws + WS_X1), ws + WS_H2, (float*)(ws + WS_AFF)); }
    GRID_BAR(7);
    if (IN(8)) REP(8) { p8_topk(F, (const float*)(ws + WS_AFF), (int*)(ws + WS_SELG + 131072), (float*)(ws + WS_SELG), (int*)(ws + WS_INV)); }
    GRID_BAR(8);
    if (IN(9)) REP(9) {
        pg8::Gemm g{(const bf16*)(ws + WS_H2), (const bf16*)(ws + WS_WGU), MS, 2048, 512, 512, 512, 8, (size_t)2048 * 1024, (const int*)(ws + WS_SELG + 131072)};
        pg8::StaticOrder S; S.init(MS, 2048, F.G, (int)blockIdx.x);
        pg8::EpiSwiGLU8 E{ws + WS_ACT, D};
        pg8::gemm_phase<pg8::EpiSwiGLU8, pg8::StaticOrder, true, true>(F.lds + RING_OFF, g, S, E);
    }
    GRID_BAR(9);
    if (IN(10)) REP(10) {
        pg8::Gemm g{(const bf16*)(ws + WS_ACT), (const bf16*)(ws + WS_WD), MS, D, 512, 512, 512, 8, (size_t)1024 * 1024};
        pg8::StaticOrder S; S.init(MS, D, F.G, (int)blockIdx.x);
        pg8::EpiRowScale8 E{ws + WS_YS, (const float*)(ws + WS_SELG), D};
        pg8::gemm_phase<pg8::EpiRowScale8, pg8::StaticOrder, true, true>(F.lds + RING_OFF, g, S, E);
    }
    GRID_BAR(10);
#ifdef EXTRA_BARS
#pragma unroll 1
    for (int xb = 0; xb < EXTRA_BARS; ++xb) xcd_barrier(bar);
#endif
    if (IN(11)) { p11_final(F, (const bf16*)(ws + WS_X1), ws + WS_YS, (const int*)(ws + WS_INV)); }
#undef IN
#undef GRID_BAR
}

extern "C" void kernel_launch(void* const* d_in, const int* in_sizes, int n_in, void* d_out, int out_size, void* d_ws, size_t ws_size, hipStream_t stream) {
    static int grid = 0;
    if (grid == 0) {
        if (n_in != 22 || in_sizes[0] != M * D || out_size != M * D || ws_size < WS_END) { fprintf(stderr, "kernel_launch: unexpected problem (n_in %d, out %d, ws %zu); nothing launched\n", n_in, out_size, ws_size); grid = -1; return; }
        int dev = 0, cus = 0, per_cu = 0;
        if (hipGetDevice(&dev) != hipSuccess || hipDeviceGetAttribute(&cus, hipDeviceAttributeMultiprocessorCount, dev) != hipSuccess) { grid = -1; return; }
        if (hipFuncSetAttribute((const void*)fwd_kernel, hipFuncAttributeMaxDynamicSharedMemorySize, LDS_BYTES) != hipSuccess) { fprintf(stderr, "kernel_launch: hipFuncSetAttribute failed\n"); grid = -1; return; }
        if (hipOccupancyMaxActiveBlocksPerMultiprocessor(&per_cu, (const void*)fwd_kernel, NWAVES * 64, LDS_BYTES) != hipSuccess || per_cu < 1) { fprintf(stderr, "kernel_launch: occupancy query reports %d\n", per_cu); }
        (void)hipGetLastError();
        grid = cus;
        if (cus != 256) { fprintf(stderr, "kernel_launch: this kernel's unit deal is built for the 256 CUs of an MI355X (device reports %d); nothing launched\n", cus); grid = -1; return; }
    }
    if (grid < 0) return;
    if (hipMemsetAsync((char*)d_ws + WS_CTL, 0, CTL_ZERO_BYTES, stream) != hipSuccess) return;
    Args a{};
    for (int i = 0; i < 22; ++i) a.in[i] = (const float*)d_in[i];
    a.out = (float*)d_out; a.ws = (unsigned char*)d_ws;
#if MK_PER_PHASE
    for (int p = 0; p < N_PHASES; ++p) { a.ph_lo = p; a.ph_hi = p + 1; hipLaunchKernelGGL(fwd_kernel, dim3(grid), dim3(NWAVES * 64), LDS_BYTES, stream, a); }
#else
    a.ph_lo = 0; a.ph_hi = N_PHASES;
    hipLaunchKernelGGL(fwd_kernel, dim3(grid), dim3(NWAVES * 64), LDS_BYTES, stream, a);
#endif
}
```

```cpp
#include <hip/hip_runtime.h>
#include <cstdio>
#include <cstdint>
namespace pg8 {
#define PG8_LAS __attribute__((address_space(3)))
typedef unsigned short bf16_t;
typedef short bf16x8 __attribute__((ext_vector_type(8)));
typedef float f32x4 __attribute__((ext_vector_type(4)));
typedef unsigned u32x4 __attribute__((ext_vector_type(4)));
typedef int v4i_t __attribute__((ext_vector_type(4)));
typedef int v8i_t __attribute__((ext_vector_type(8)));
constexpr int BM = 256, BK = 64, HALF = 128, HTB = HALF * BK * 2  , STAGE_BYTES = 8 * HTB, NXCD = 8, WGM = 8;

__host__ __device__ __forceinline__ int lds_byte(int r, int c) { const int st = (r >> 4) * 2 + (c >> 5), rr = r & 15, cc = c & 31, ob = rr * 64 + cc * 2; return st * 1024 + (ob ^ (((ob >> 9) & 1) << 5)); }
__host__ __device__ __forceinline__ void stage_rc(int b, int& R, int& C) { const int st = b / 1024, sb = b % 1024, swz = sb ^ (((sb >> 9) & 1) << 5); R = (st >> 1) * 16 + swz / 64; C = (st & 1) * 32 + (swz % 64) / 2; }
__host__ __device__ __forceinline__ int perm32(int rho) { const int n = rho >> 4, i = rho & 15; return 8 * (i >> 2) + 4 * n + (i & 3); }

struct Unit { int pm, pn; };
struct Gemm { const bf16_t* A; const bf16_t* Bt; int M, N, K, lda, ldb, gdiv; size_t gstride; const int* gidx; };
typedef unsigned u32x2 __attribute__((ext_vector_type(2)));
__device__ __forceinline__ unsigned cvt_pk_bf16(float lo, float hi) { unsigned r; asm volatile("v_cvt_pk_bf16_f32 %0, %1, %2" : "=v"(r) : "v"(lo), "v"(hi)); return r; }
__device__ __forceinline__ float bflo(unsigned w) { return __builtin_bit_cast(float, w << 16); }
__device__ __forceinline__ float bfhi(unsigned w) { return __builtin_bit_cast(float, w & 0xffff0000u); }
__device__ __forceinline__ float sigmoidf_(float v) { return __builtin_amdgcn_rcpf(1.0f + __builtin_amdgcn_exp2f(-1.4426950408889634f * v)); }
__device__ __forceinline__ u32x4 pack8(const f32x4& v0, const f32x4& v1) { u32x4 w; w.x = cvt_pk_bf16(v0[0], v0[1]); w.y = cvt_pk_bf16(v0[2], v0[3]); w.z = cvt_pk_bf16(v1[0], v1[1]); w.w = cvt_pk_bf16(v1[2], v1[3]); return w; }
__device__ __forceinline__ void unpack8(const u32x4& w, f32x4& v0, f32x4& v1) { v0 = (f32x4){bflo(w.x), bfhi(w.x), bflo(w.y), bfhi(w.y)}; v1 = (f32x4){bflo(w.z), bfhi(w.z), bflo(w.w), bfhi(w.w)}; }

__device__ __forceinline__ float clamp448(float v) { return __builtin_fminf(__builtin_fmaxf(v, -448.f), 448.f); }
__device__ __forceinline__ unsigned pk_fp8x4(float a, float b, float c, float d) { int w = 0; w = __builtin_amdgcn_cvt_pk_fp8_f32(clamp448(a), clamp448(b), w, false); w = __builtin_amdgcn_cvt_pk_fp8_f32(clamp448(c), clamp448(d), w, true); return (unsigned)w; }

template <bool F8> struct EpiProjT {
    static constexpr bool PERM = true, AFTER_DRAIN = false, MID = false, FP8 = F8, GATHER = false;
    bf16_t* base; const float* cs;
    size_t oRQ, oRK, oRV, oRG, oDQ1, oDV, oGR, oGD;
    __device__ __forceinline__ void operator()(const f32x4 (&acc)[2][2][4][2], const Unit& u, int wr, int wc, int fr, int fq) const {
        const int pn = u.pn; size_t off; int ldc, colt, mode; float sc = 1.f;
        if (pn < 2)       { off = oRQ; ldc = 512; colt = pn * 256; mode = 1; }
        else if (pn < 4)  { off = oRK; ldc = 512; colt = (pn - 2) * 256; mode = 1; sc = 0.08838834764831845f; }
        else if (pn < 6)  { off = oRV; ldc = 512; colt = (pn - 4) * 256; mode = 0; }
        else if (pn < 8)  { off = oRG; ldc = 512; colt = (pn - 6) * 256; mode = 2; }
        else if (pn < 12) { off = oDQ1 + (size_t)(pn - 8) * ((size_t)16384 * 256); ldc = 256; colt = 0; mode = 0; sc = (pn < 10) ? 0.18033688011112042f : 1.f; }
        else if (pn < 14) { off = oDV; ldc = 512; colt = (pn - 12) * 256; mode = 0; }
        else if (pn < 18) { off = oGR; ldc = 1024; colt = (pn - 14) * 256; mode = 3; }
        else              { off = oGD; ldc = 1024; colt = (pn - 18) * 256; mode = 3; }
        const int row0 = u.pm * BM + wr * 64 + fr, col0 = colt + wc * 32 + 8 * fq;
        const int i0 = wc * 16 + 4 * fq;
#pragma unroll
        for (int ai = 0; ai < 2; ++ai)
#pragma unroll
            for (int m = 0; m < 4; ++m) { const int row = row0 + ai * HALF + m * 16; bf16_t* rowp = base + off + (size_t)row * ldc + col0;
                f32x4 c01 = (f32x4){1.f, 0.f, 1.f, 0.f}, c23 = c01;
                if (mode == 1) { const f32x4* cp = (const f32x4*)(cs + ((size_t)(row & 2047) * 64 + i0) * 2); c01 = cp[0]; c23 = cp[1]; }
#pragma unroll
                for (int bj = 0; bj < 2; ++bj) { f32x4 v0 = acc[ai][bj][m][0], v1 = acc[ai][bj][m][1];
                    if (F8) { v0 = v0 * (1.f / 64.f); v1 = v1 * (1.f / 64.f); }
                    if (mode == 1) {
                        const f32x4 a = v0, b = v1;
                        v0 = (f32x4){a[0] * c01[0] - a[1] * c01[1], a[0] * c01[1] + a[1] * c01[0], a[2] * c01[2] - a[3] * c01[3], a[2] * c01[3] + a[3] * c01[2]};
                        v1 = (f32x4){b[0] * c23[0] - b[1] * c23[1], b[0] * c23[1] + b[1] * c23[0], b[2] * c23[2] - b[3] * c23[3], b[2] * c23[3] + b[3] * c23[2]};
                    } else if (mode == 2) {
#pragma unroll
                        for (int j = 0; j < 4; ++j) { v0[j] = v0[j] * sigmoidf_(v0[j]); v1[j] = v1[j] * sigmoidf_(v1[j]); }
                    } else if (mode == 3) {
#pragma unroll
                        for (int j = 0; j < 4; ++j) { v0[j] = sigmoidf_(v0[j]); v1[j] = sigmoidf_(v1[j]); }
                    }
                    v0 = v0 * sc; v1 = v1 * sc;
                    *(u32x4*)(rowp + bj * HALF) = pack8(v0, v1); } }
    }
};
typedef EpiProjT<false> EpiProj; typedef EpiProjT<true> EpiProj8;
struct EpiGate {
    static constexpr bool PERM = true, AFTER_DRAIN = false, MID = false, FP8 = false, GATHER = false;
    bf16_t* O; const bf16_t* G; const bf16_t* T; int ldc;
    __device__ __forceinline__ void operator()(const f32x4 (&acc)[2][2][4][2], const Unit& u, int wr, int wc, int fr, int fq) const {
        const int row0 = u.pm * BM + wr * 64 + fr, col0 = u.pn * BM + wc * 32 + 8 * fq;
#pragma unroll
        for (int ai = 0; ai < 2; ++ai)
#pragma unroll
            for (int m = 0; m < 4; ++m) { const size_t ro = (size_t)(row0 + ai * HALF + m * 16) * ldc + col0;
#pragma unroll
                for (int bj = 0; bj < 2; ++bj) { f32x4 g0, g1; unpack8(*(const u32x4*)(G + ro + bj * HALF), g0, g1);
                    f32x4 v0 = acc[ai][bj][m][0] * g0, v1 = acc[ai][bj][m][1] * g1;
                    if (T) { f32x4 t0, t1; unpack8(*(const u32x4*)(T + ro + bj * HALF), t0, t1); v0 = v0 + t0; v1 = v1 + t1; }
                    *(u32x4*)(O + ro + bj * HALF) = pack8(v0, v1); } }
    }
};
struct EpiGate2 {
    static constexpr bool PERM = true, AFTER_DRAIN = false, MID = true, FP8 = false, GATHER = false;
    bf16_t* O; const bf16_t* GR; const bf16_t* GD; int ldc;
    __device__ __forceinline__ void mid(f32x4 (&acc)[2][2][4][2], const Unit& u, int wr, int wc, int fr, int fq) const {
        int row0 = u.pm * BM + wr * 64 + fr; const int col0 = u.pn * BM + wc * 32 + 8 * fq; asm volatile("" : "+v"(row0));
#pragma unroll
        for (int ai = 0; ai < 2; ++ai)
#pragma unroll
            for (int m = 0; m < 4; ++m) { const size_t ro = (size_t)(row0 + ai * HALF + m * 16) * ldc + col0;
#pragma unroll
                for (int bj = 0; bj < 2; ++bj) { f32x4 r0, r1, d0, d1; unpack8(*(const u32x4*)(GR + ro + bj * HALF), r0, r1); unpack8(*(const u32x4*)(GD + ro + bj * HALF), d0, d1);
#pragma unroll
                    for (int j = 0; j < 4; ++j) { acc[ai][bj][m][0][j] *= r0[j] * __builtin_amdgcn_rcpf(d0[j]); acc[ai][bj][m][1][j] *= r1[j] * __builtin_amdgcn_rcpf(d1[j]); }
                    asm volatile("" : "+v"(acc[ai][bj][m][0]), "+v"(acc[ai][bj][m][1]) :: "memory"); } }
    }
    __device__ __forceinline__ void operator()(const f32x4 (&acc)[2][2][4][2], const Unit& u, int wr, int wc, int fr, int fq) const {
        int row0 = u.pm * BM + wr * 64 + fr; const int col0 = u.pn * BM + wc * 32 + 8 * fq; asm volatile("" : "+v"(row0));
#pragma unroll
        for (int ai = 0; ai < 2; ++ai)
#pragma unroll
            for (int m = 0; m < 4; ++m) { const size_t ro = (size_t)(row0 + ai * HALF + m * 16) * ldc + col0;
#pragma unroll
                for (int bj = 0; bj < 2; ++bj) { f32x4 d0, d1; unpack8(*(const u32x4*)(GD + ro + bj * HALF), d0, d1);
                    *(u32x4*)(O + ro + bj * HALF) = pack8(acc[ai][bj][m][0] * d0, acc[ai][bj][m][1] * d1); } }
    }
};
struct EpiResid {
    static constexpr bool PERM = false, AFTER_DRAIN = false, MID = false, FP8 = false, GATHER = false;
    float* C; const float* base; const float* gate; int ldc, gpitch;
    __device__ __forceinline__ void operator()(const f32x4 (&acc)[2][2][4][2], const Unit& u, int wr, int wc, int fr, int fq) const {
        const int row0 = u.pm * BM + wr * 64 + fr, col0 = u.pn * BM + wc * 32 + 4 * fq;
        const float* gp = gate + (size_t)((u.pm * BM) >> 11) * gpitch + col0;
        f32x4 gv[2][2];
#pragma unroll
        for (int bj = 0; bj < 2; ++bj)
#pragma unroll
            for (int n = 0; n < 2; ++n) gv[bj][n] = *(const f32x4*)(gp + bj * HALF + n * 16);
#pragma unroll
        for (int ai = 0; ai < 2; ++ai)
#pragma unroll
            for (int m = 0; m < 4; ++m) { const size_t ro = (size_t)(row0 + ai * HALF + m * 16) * ldc + col0;
#pragma unroll
                for (int bj = 0; bj < 2; ++bj)
#pragma unroll
                    for (int n = 0; n < 2; ++n) *(f32x4*)(C + ro + bj * HALF + n * 16) = *(const f32x4*)(base + ro + bj * HALF + n * 16) + gv[bj][n] * acc[ai][bj][m][n]; }
    }
};
struct EpiSwiGLU {
    static constexpr bool PERM = false, AFTER_DRAIN = false, MID = false, FP8 = false, GATHER = false;
    bf16_t* O; int ldc;
    __device__ __forceinline__ void operator()(const f32x4 (&acc)[2][2][4][2], const Unit& u, int wr, int wc, int fr, int fq) const {
        const int row0 = u.pm * BM + wr * 64 + fr, col0 = u.pn * 128 + wc * 32 + 8 * fq;
#pragma unroll
        for (int ai = 0; ai < 2; ++ai)
#pragma unroll
            for (int m = 0; m < 4; ++m) { f32x4 o[2];
#pragma unroll
                for (int bj = 0; bj < 2; ++bj) { const f32x4 gt = acc[ai][bj][m][0], up = acc[ai][bj][m][1];
#pragma unroll
                    for (int j = 0; j < 4; ++j) o[bj][j] = gt[j] * sigmoidf_(gt[j]) * up[j]; }
                *(u32x4*)(O + (size_t)(row0 + ai * HALF + m * 16) * ldc + col0) = pack8(o[0], o[1]); }
    }
};
struct EpiRowScale {
    static constexpr bool PERM = true, AFTER_DRAIN = false, MID = false, FP8 = false, GATHER = false;
    bf16_t* O; const float* rs; int ldc;
    __device__ __forceinline__ void operator()(const f32x4 (&acc)[2][2][4][2], const Unit& u, int wr, int wc, int fr, int fq) const {
        const int row0 = u.pm * BM + wr * 64 + fr, col0 = u.pn * BM + wc * 32 + 8 * fq;
#pragma unroll
        for (int ai = 0; ai < 2; ++ai)
#pragma unroll
            for (int m = 0; m < 4; ++m) { const int row = row0 + ai * HALF + m * 16; const float s = rs[row];
#pragma unroll
                for (int bj = 0; bj < 2; ++bj) *(u32x4*)(O + (size_t)row * ldc + col0 + bj * HALF) = pack8(acc[ai][bj][m][0] * s, acc[ai][bj][m][1] * s); }
    }
};

constexpr float W8_SCALE = 64.f, ACT_SCALE = 16.f;
struct EpiSwiGLU8 {
    static constexpr bool PERM = false, AFTER_DRAIN = false, MID = false, FP8 = true, GATHER = true;
    unsigned char* O; int ldc;
    __device__ __forceinline__ void operator()(const f32x4 (&acc)[2][2][4][2], const Unit& u, int wr, int wc, int fr, int fq) const {
        const int row0 = u.pm * BM + wr * 64 + fr, col0 = u.pn * 128 + wc * 32 + 8 * fq;
#pragma unroll
        for (int ai = 0; ai < 2; ++ai)
#pragma unroll
            for (int m = 0; m < 4; ++m) { f32x4 o[2];
#pragma unroll
                for (int bj = 0; bj < 2; ++bj) { const f32x4 gt = acc[ai][bj][m][0] * (1.f / W8_SCALE), up = acc[ai][bj][m][1] * (ACT_SCALE / W8_SCALE);
#pragma unroll
                    for (int j = 0; j < 4; ++j) o[bj][j] = gt[j] * sigmoidf_(gt[j]) * up[j]; }
                u32x2 w; w.x = pk_fp8x4(o[0][0], o[0][1], o[0][2], o[0][3]); w.y = pk_fp8x4(o[1][0], o[1][1], o[1][2], o[1][3]);
                *(u32x2*)(O + (size_t)(row0 + ai * HALF + m * 16) * ldc + col0) = w; }
    }
};
constexpr float YS_SCALE = 64.f;
struct EpiRowScale8 {
    static constexpr bool PERM = true, AFTER_DRAIN = false, MID = false, FP8 = true, GATHER = false;
    unsigned char* O; const float* rs; int ldc;
    __device__ __forceinline__ void operator()(const f32x4 (&acc)[2][2][4][2], const Unit& u, int wr, int wc, int fr, int fq) const {
        const int row0 = u.pm * BM + wr * 64 + fr, col0 = u.pn * BM + wc * 32 + 8 * fq;
#pragma unroll
        for (int ai = 0; ai < 2; ++ai)
#pragma unroll
            for (int m = 0; m < 4; ++m) { const int row = row0 + ai * HALF + m * 16; const float s = rs[row] * (YS_SCALE / (ACT_SCALE * W8_SCALE));
#pragma unroll
                for (int bj = 0; bj < 2; ++bj) { const f32x4 v0 = acc[ai][bj][m][0] * s, v1 = acc[ai][bj][m][1] * s; u32x2 w; w.x = pk_fp8x4(v0[0], v0[1], v0[2], v0[3]); w.y = pk_fp8x4(v1[0], v1[1], v1[2], v1[3]);
                    *(u32x2*)(O + (size_t)row * ldc + col0 + bj * HALF) = w; } }
    }
};
struct EpiResidB {
    static constexpr bool PERM = true, AFTER_DRAIN = false, MID = false, FP8 = false, GATHER = false;
    bf16_t* C; const float* base; const float* gate; int ldc, gpitch;
    __device__ __forceinline__ void operator()(const f32x4 (&acc)[2][2][4][2], const Unit& u, int wr, int wc, int fr, int fq) const {
        const int row0 = u.pm * BM + wr * 64 + fr, col0 = u.pn * BM + wc * 32 + 8 * fq;
        const float* gp = gate + (size_t)((u.pm * BM) >> 11) * gpitch + col0;
        f32x4 gv[2][2];
#pragma unroll
        for (int bj = 0; bj < 2; ++bj)
#pragma unroll
            for (int n = 0; n < 2; ++n) gv[bj][n] = *(const f32x4*)(gp + bj * HALF + 4 * n);
#pragma unroll
        for (int ai = 0; ai < 2; ++ai)
#pragma unroll
            for (int m = 0; m < 4; ++m) { const size_t ro = (size_t)(row0 + ai * HALF + m * 16) * ldc + col0;
#pragma unroll
                for (int bj = 0; bj < 2; ++bj) { const f32x4 b0 = *(const f32x4*)(base + ro + bj * HALF), b1 = *(const f32x4*)(base + ro + bj * HALF + 4);
                    *(u32x4*)(C + ro + bj * HALF) = pack8(b0 + gv[bj][0] * acc[ai][bj][m][0], b1 + gv[bj][1] * acc[ai][bj][m][1]); } }
    }
};


struct StaticOrder {
    int nM, nN, nwg, G, c;
    __host__ __device__ void init(int M, int N, int G_, int c_) { nM = M / BM; nN = N / BM; nwg = nM * nN; G = G_; c = c_; }
    __host__ __device__ bool next(int i, Unit& u) const {
        const long L = (long)i * G + c; if (L >= nwg) return false;
        int wgid = (int)L; { const int q = nwg / NXCD, r = nwg % NXCD, xcd = wgid % NXCD, off = wgid / NXCD; wgid = (xcd < r ? xcd * (q + 1) : r * (q + 1) + (xcd - r) * q) + off; }
        const int nig = WGM * nN, gid = wgid / nig, fm = gid * WGM, gsz = (nM - fm) < WGM ? (nM - fm) : WGM;
        u.pm = fm + ((wgid % nig) % gsz); u.pn = (wgid % nig) / gsz; return true;
    }
    __device__ __forceinline__ void a_ready(const Unit&) const {}
    __device__ __forceinline__ void done(const Unit&) const {}
};

template <class Epi, class Sched, bool ALIGN_EPI = false, bool SP2 = false>
__device__ __forceinline__ void gemm_phase(PG8_LAS unsigned char* lds, const Gemm g, const Sched& S, const Epi& E) {
    const int tid = threadIdx.x, wid = __builtin_amdgcn_readfirstlane(tid >> 6), lane = tid & 63, wr = wid >> 2, wc = wid & 3, fr = lane & 15, fq = lane >> 4;
    const int K = g.K, nt = K / BK;
    unsigned voffA[2], voffB[2];
#pragma unroll
    for (int i = 0; i < 2; ++i) { int R, C; stage_rc(tid * 16 + i * 8192, R, C); const int Rb = Epi::PERM ? ((R & ~31) + perm32(R & 31)) : R;
        voffA[i] = (unsigned)(R * g.lda + C) * 2u; voffB[i] = (unsigned)(Rb * g.ldb + C) * 2u; }
    unsigned vgc[2][2] = {{0u, 0u}, {0u, 0u}}, vgn[2][2] = {{0u, 0u}, {0u, 0u}};
#define PG8_LOADVG(vg, pm_) do { _Pragma("unroll") for (int h_ = 0; h_ < 2; ++h_) _Pragma("unroll") for (int i_ = 0; i_ < 2; ++i_) { int R_, C_; stage_rc(tid * 16 + i_ * 8192, R_, C_); \
        vg[h_][i_] = (unsigned)(g.gidx[(pm_) * BM + h_ * HALF + R_] * g.lda + C_) * 2u; } } while (0)
    const size_t kstep = (size_t)(BK * 2);
    const size_t hstepA = (size_t)HALF * g.lda * 2, hstepB = (size_t)HALF * g.ldb * 2;
    const size_t tstepA = 2 * hstepA, tstepB = 2 * hstepB;
    const unsigned ldsw = (unsigned)wid * 1024u;
    const int aoff = lds_byte(wr * 64 + fr, fq * 8), boff = lds_byte(wc * 32 + fr, fq * 8);
#define PG8_SA(b, h) (((b) * 2 + (h)) * HTB)
#define PG8_SB(b, h) ((4 + (b) * 2 + (h)) * HTB)
#define PG8_STAGE(bufoff, gbase, voff) do { _Pragma("unroll") for (int _i = 0; _i < 2; ++_i) \
        __builtin_amdgcn_global_load_lds((const unsigned*)((const char*)(gbase) + (voff)[_i]), (PG8_LAS unsigned*)(lds + (bufoff) + ldsw + _i * 8192), 16, 0, 0); } while (0)
#define PG8_STAGE_A(bufoff, X, half, nx) do { if constexpr (Epi::GATHER) { unsigned vs_[2]; vs_[0] = (nx) ? vgn[half][0] : vgc[half][0]; vs_[1] = (nx) ? vgn[half][1] : vgc[half][1]; PG8_STAGE(bufoff, X, vs_); } \
        else PG8_STAGE(bufoff, (half) ? (X) + hstepA : (X), voffA); } while (0)
#define PG8_LDA(dst, b, h) do { _Pragma("unroll") for (int m = 0; m < 4; ++m) { const v4i_t l_ = *(const PG8_LAS v4i_t*)(lds + PG8_SA(b, h) + aoff + m * 2048), h_ = *(const PG8_LAS v4i_t*)(lds + PG8_SA(b, h) + aoff + m * 2048 + 1024); dst[m] = __builtin_shufflevector(l_, h_, 0, 1, 2, 3, 4, 5, 6, 7); } } while (0)
#define PG8_LDB(dst, b, h) do { _Pragma("unroll") for (int n = 0; n < 2; ++n) { const v4i_t l_ = *(const PG8_LAS v4i_t*)(lds + PG8_SB(b, h) + boff + n * 2048), h_ = *(const PG8_LAS v4i_t*)(lds + PG8_SB(b, h) + boff + n * 2048 + 1024); dst[n] = __builtin_shufflevector(l_, h_, 0, 1, 2, 3, 4, 5, 6, 7); } } while (0)
#define PG8_HALF(x, k) __builtin_bit_cast(bf16x8, __builtin_shufflevector(x, x, 4 * (k), 4 * (k) + 1, 4 * (k) + 2, 4 * (k) + 3))
#define PG8_MMA(ai, bj, At, Bt) do { if constexpr (Epi::FP8) __builtin_amdgcn_sched_barrier(0); __builtin_amdgcn_s_setprio(1); _Pragma("unroll") for (int m = 0; m < 4; ++m) _Pragma("unroll") for (int n = 0; n < 2; ++n) { \
        if constexpr (Epi::FP8) acc[ai][bj][m][n] = __builtin_amdgcn_mfma_scale_f32_16x16x128_f8f6f4(Bt[n], At[m], acc[ai][bj][m][n], 0, 0, 0, 0x7f7f7f7f, 0, 0x7f7f7f7f); \
        else { acc[ai][bj][m][n] = __builtin_amdgcn_mfma_f32_16x16x32_bf16(PG8_HALF(Bt[n], 0), PG8_HALF(At[m], 0), acc[ai][bj][m][n], 0, 0, 0); \
               acc[ai][bj][m][n] = __builtin_amdgcn_mfma_f32_16x16x32_bf16(PG8_HALF(Bt[n], 1), PG8_HALF(At[m], 1), acc[ai][bj][m][n], 0, 0, 0); } } \
        __builtin_amdgcn_s_setprio(0); if constexpr (Epi::FP8) { _Pragma("unroll") for (int m = 0; m < 4; ++m) _Pragma("unroll") for (int n = 0; n < 2; ++n) asm volatile("" : "+v"(acc[ai][bj][m][n])); __builtin_amdgcn_sched_barrier(0); } } while (0)
#define PG8_WAIT_V(n) asm volatile("s_waitcnt vmcnt(" #n ")" ::: "memory")
#define PG8_WAIT_L(n) asm volatile("s_waitcnt lgkmcnt(" #n ")" ::: "memory")
#define PG8_BAR __builtin_amdgcn_s_barrier()
#define PG8_SCHED __builtin_amdgcn_sched_barrier(0)
    Unit cur, nxt; int ui = 0;
    if (!S.next(0, cur)) return;
    f32x4 acc[2][2][4][2];
#pragma unroll
    for (int a = 0; a < 2; ++a)
#pragma unroll
        for (int b = 0; b < 2; ++b)
#pragma unroll
            for (int m = 0; m < 4; ++m)
#pragma unroll
                for (int n = 0; n < 2; ++n) acc[a][b][m][n] = (f32x4){0.f, 0.f, 0.f, 0.f};
    v8i_t At[4], B0[2], B1[2];
    const char* cA = (const char*)g.A + (Epi::GATHER ? (size_t)0 : (size_t)cur.pm * tstepA); const char* cB = (const char*)g.Bt + (size_t)(cur.pm / g.gdiv) * g.gstride + (size_t)cur.pn * tstepB;
    S.a_ready(cur);
    if constexpr (Epi::GATHER) { static_assert(SP2 || !Epi::GATHER, "gather: SP2 loop only"); PG8_LOADVG(vgc, cur.pm); }
    if constexpr (SP2) {
        PG8_STAGE(PG8_SB(0, 0), cB, voffB); PG8_STAGE(PG8_SB(0, 1), cB + hstepB, voffB); PG8_STAGE_A(PG8_SA(0, 0), cA, 0, false); PG8_STAGE_A(PG8_SA(0, 1), cA, 1, false);
        if (wr == 1) PG8_BAR;
        PG8_WAIT_V(2); PG8_BAR;
        PG8_STAGE(PG8_SB(1, 0), cB + kstep, voffB); PG8_STAGE_A(PG8_SA(1, 0), cA + kstep, 0, false); PG8_STAGE(PG8_SB(1, 1), cB + hstepB + kstep, voffB);
        PG8_WAIT_V(6); PG8_BAR;
    } else {
        PG8_STAGE(PG8_SB(0, 0), cB, voffB); PG8_STAGE(PG8_SA(0, 0), cA, voffA); PG8_STAGE(PG8_SB(0, 1), cB + hstepB, voffB); PG8_STAGE(PG8_SA(0, 1), cA + hstepA, voffA);
        if (wr == 1) PG8_BAR;
        PG8_WAIT_V(4); PG8_BAR;
        PG8_STAGE(PG8_SB(1, 0), cB + kstep, voffB); PG8_STAGE(PG8_SA(1, 0), cA + kstep, voffA); PG8_STAGE(PG8_SB(1, 1), cB + hstepB + kstep, voffB);
        PG8_WAIT_V(6); PG8_BAR;
    }
    for (;;) {
        const bool has_next = S.next(ui + 1, nxt);
        const char* nA = (has_next && !Epi::GATHER) ? (const char*)g.A + (size_t)nxt.pm * tstepA : cA; const char* nB = has_next ? (const char*)g.Bt + (size_t)(nxt.pm / g.gdiv) * g.gstride + (size_t)nxt.pn * tstepB : cB;
        for (int t = 0; t < nt; t += 2) {
            const bool last = (t == nt - 2);
            const char* a1 = cA + (size_t)(t + 1) * kstep;
            const char* a2 = last ? nA : cA + (size_t)(t + 2) * kstep; const char* b2 = last ? nB : cB + (size_t)(t + 2) * kstep;
            const char* a3 = a2 + kstep; const char* b3 = b2 + kstep;
            if (last && has_next) S.a_ready(nxt);
            const bool nx_ = last;
            if constexpr (Epi::GATHER) { if (last) { if (has_next) PG8_LOADVG(vgn, nxt.pm); else { vgn[0][0] = vgc[0][0]; vgn[0][1] = vgc[0][1]; vgn[1][0] = vgc[1][0]; vgn[1][1] = vgc[1][1]; } } }
            if constexpr (Epi::MID) { PG8_SCHED; if (t == nt / 2) E.mid(acc, cur, wr, wc, fr, fq); PG8_SCHED; }
            if constexpr (SP2) {
            PG8_LDB(B0, 0, 0); PG8_LDB(B1, 0, 1); PG8_SCHED; PG8_LDA(At, 0, 0); PG8_STAGE_A(PG8_SA(1, 1), a1, 1, false);
            PG8_WAIT_V(8); PG8_WAIT_L(0); PG8_BAR; PG8_MMA(0, 0, At, B0); PG8_MMA(0, 1, At, B1); PG8_BAR; PG8_SCHED;
            PG8_LDA(At, 0, 1); PG8_STAGE(PG8_SB(0, 0), b2, voffB); PG8_STAGE(PG8_SB(0, 1), b2 + hstepB, voffB); PG8_STAGE_A(PG8_SA(0, 0), a2, 0, nx_);
            PG8_WAIT_V(8); PG8_WAIT_L(0); PG8_BAR; PG8_MMA(1, 0, At, B0); PG8_MMA(1, 1, At, B1); PG8_BAR; PG8_SCHED;
            PG8_LDB(B0, 1, 0); PG8_LDB(B1, 1, 1); PG8_SCHED; PG8_LDA(At, 1, 0); PG8_STAGE_A(PG8_SA(0, 1), a2, 1, nx_);
            PG8_WAIT_V(8); PG8_WAIT_L(0); PG8_BAR; PG8_MMA(0, 0, At, B0); PG8_MMA(0, 1, At, B1); PG8_BAR; PG8_SCHED;
            PG8_LDA(At, 1, 1); PG8_STAGE(PG8_SB(1, 0), b3, voffB); PG8_STAGE(PG8_SB(1, 1), b3 + hstepB, voffB); PG8_STAGE_A(PG8_SA(1, 0), a3, 0, nx_);
            PG8_WAIT_V(8); PG8_WAIT_L(0); PG8_BAR; PG8_MMA(1, 0, At, B0); PG8_MMA(1, 1, At, B1); PG8_BAR; PG8_SCHED;
            } else {
            PG8_LDB(B0, 0, 0); PG8_SCHED; PG8_LDA(At, 0, 0); PG8_STAGE(PG8_SA(1, 1), a1 + hstepA, voffA);
            PG8_WAIT_L(8); PG8_BAR; PG8_WAIT_L(0); PG8_MMA(0, 0, At, B0); PG8_BAR; PG8_SCHED;
            PG8_LDB(B1, 0, 1); PG8_STAGE(PG8_SB(0, 0), b2, voffB);
            PG8_BAR; PG8_WAIT_L(0); PG8_MMA(0, 1, At, B1); PG8_BAR;
            PG8_LDA(At, 0, 1); PG8_STAGE(PG8_SA(0, 0), a2, voffA);
            PG8_BAR; PG8_WAIT_L(0); PG8_MMA(1, 0, At, B0); PG8_BAR; PG8_SCHED;
            PG8_STAGE(PG8_SB(0, 1), b2 + hstepB, voffB);
            PG8_WAIT_V(6); PG8_BAR; PG8_MMA(1, 1, At, B1); PG8_BAR;
            PG8_LDB(B0, 1, 0); PG8_SCHED; PG8_LDA(At, 1, 0); PG8_STAGE(PG8_SA(0, 1), a2 + hstepA, voffA);
            PG8_WAIT_L(8); PG8_BAR; PG8_WAIT_L(0); PG8_MMA(0, 0, At, B0); PG8_BAR; PG8_SCHED;
            PG8_LDB(B1, 1, 1); PG8_STAGE(PG8_SB(1, 0), b3, voffB);
            PG8_BAR; PG8_WAIT_L(0); PG8_MMA(0, 1, At, B1); PG8_BAR;
            PG8_LDA(At, 1, 1); PG8_STAGE(PG8_SA(1, 0), a3, voffA);
            PG8_BAR; PG8_WAIT_L(0); PG8_MMA(1, 0, At, B0); PG8_BAR; PG8_SCHED;
            PG8_STAGE(PG8_SB(1, 1), b3 + hstepB, voffB);
            PG8_WAIT_V(6); PG8_BAR; PG8_MMA(1, 1, At, B1); PG8_BAR;
            }
        }
        if constexpr (ALIGN_EPI) { if (wr == 0) PG8_BAR; }
        if constexpr (!Epi::AFTER_DRAIN) { E(acc, cur, wr, wc, fr, fq); S.done(cur); }
        if (!has_next) break;
#pragma unroll
        for (int a = 0; a < 2; ++a)
#pragma unroll
            for (int b = 0; b < 2; ++b)
#pragma unroll
                for (int m = 0; m < 4; ++m)
#pragma unroll
                    for (int n = 0; n < 2; ++n) acc[a][b][m][n] = (f32x4){0.f, 0.f, 0.f, 0.f};
        cur = nxt; cA = nA; cB = nB; ++ui;
        if constexpr (Epi::GATHER) { vgc[0][0] = vgn[0][0]; vgc[0][1] = vgn[0][1]; vgc[1][0] = vgn[1][0]; vgc[1][1] = vgn[1][1]; }
        if constexpr (ALIGN_EPI) { if (wr == 1) PG8_BAR; }
    }
    PG8_WAIT_V(0);
    if constexpr (!ALIGN_EPI) { if (wr == 0) PG8_BAR; }
    PG8_BAR;
    if constexpr (Epi::AFTER_DRAIN) { E.fused(acc, cur, wr, wc, fr, fq, lds, wid, lane); S.done(cur); }
#undef PG8_SA
#undef PG8_SB
#undef PG8_STAGE
#undef PG8_STAGE_A
#undef PG8_LOADVG
#undef PG8_LDA
#undef PG8_LDB
#undef PG8_MMA
#undef PG8_HALF
#undef PG8_WAIT_V
#undef PG8_WAIT_L
#undef PG8_BAR
#undef PG8_SCHED
}
}

#define GAS __attribute__((address_space(1)))
#define LAS __attribute__((address_space(3)))
typedef unsigned short bf16;
typedef unsigned v4u __attribute__((ext_vector_type(4)));
typedef float f32x4 __attribute__((ext_vector_type(4)));
typedef short bf16x8 __attribute__((ext_vector_type(8)));
typedef GAS unsigned gu32;
typedef GAS unsigned long long gu64;
#define RLX_AGENT __ATOMIC_RELAXED, __HIP_MEMORY_SCOPE_AGENT
#define LDS_WAIT() asm volatile("s_waitcnt lgkmcnt(0)" ::: "memory")
#define VM_WAIT() asm volatile("s_waitcnt vmcnt(0)" ::: "memory")
__device__ __forceinline__ unsigned long long rt() { return __builtin_amdgcn_s_memrealtime(); }
__device__ __forceinline__ unsigned f2bf(float f) { unsigned u = __builtin_bit_cast(unsigned, f); return (u + 0x7fffu + ((u >> 16) & 1u)) >> 16; }
__device__ __forceinline__ unsigned pk2(float lo, float hi) { return f2bf(lo) | (f2bf(hi) << 16); }

#define XB_TMO      128
#define XB_XCNT(j)  (256  + 64 * (j))
#define XB_XSUB(j)  (1280 + 64 * (j))
#define XB_XGEN(j)  (2304 + 64 * (j))
#define XB_TOP      3328
#define XB_TOPGEN   3392
#define XCD_BAR_WORDS 3456
#define XB_SPIN_CAP (1u << 18)

__device__ __forceinline__ unsigned xb_ld(unsigned* p)              { return __hip_atomic_load(p, __ATOMIC_RELAXED, __HIP_MEMORY_SCOPE_AGENT); }
__device__ __forceinline__ unsigned xb_add(unsigned* p, unsigned v) { return __hip_atomic_fetch_add(p, v, __ATOMIC_RELAXED, __HIP_MEMORY_SCOPE_AGENT); }
__device__ __forceinline__ unsigned xb_xcc_id() { return (unsigned)__builtin_amdgcn_s_getreg((3 << 11) | 20) & 0xFu; }
#define XB_SPIN(cond, bar) do { unsigned _sp = 0; while (cond) { __builtin_amdgcn_s_sleep(1); \
    if ((++_sp & 255u) == 0u) { if (xb_ld(&(bar)[XB_TMO])) break; if (_sp > XB_SPIN_CAP) { atomicAdd(&(bar)[XB_TMO], 1u); break; } } } } while (0)

struct XcdBarrier {
    unsigned* bar; unsigned x;
    volatile LAS unsigned* st;
};

__device__ __forceinline__ XcdBarrier xcd_barrier_post(unsigned* bar, volatile LAS unsigned* st) {
    XcdBarrier b; b.bar = bar; b.x = xb_xcc_id(); b.st = st;
    if (threadIdx.x == 0) (void)xb_add(&bar[XB_XCNT(b.x)], 1u);
    return b;
}
__device__ __forceinline__ void xcd_barrier_complete(unsigned* bar, unsigned x, unsigned& nloc, unsigned& nx) {
    const unsigned G = gridDim.x * gridDim.y * gridDim.z;
    unsigned sum, cnt, mine, sp = 0u;
    for (;;) {
        sum = 0u; cnt = 0u; mine = 0u;
#pragma unroll
        for (unsigned j = 0; j < 16; ++j) { const unsigned c = xb_ld(&bar[XB_XCNT(j)]); sum += c; cnt += (c > 0u) ? 1u : 0u; mine = (j == x) ? c : mine; }
        if (sum == G) break;
        __builtin_amdgcn_s_sleep(1);
        if ((++sp & 255u) == 0u) { if (xb_ld(&bar[XB_TMO])) break; if (sp > XB_SPIN_CAP) { atomicAdd(&bar[XB_TMO], 1u); break; } }
    }
    nloc = mine > 0u ? mine : 1u; nx = cnt > 0u ? cnt : 1u;
}

__device__ __forceinline__ void xcd_barrier(const XcdBarrier& b) {
    asm volatile("s_waitcnt vmcnt(0)" ::: "memory");
    __syncthreads();
    if (threadIdx.x == 0) {
        unsigned* bar = b.bar;
        __builtin_amdgcn_s_waitcnt(0);
        unsigned nloc = b.st[0], nx = b.st[1];
        if (nloc == 0u) { xcd_barrier_complete(bar, b.x, nloc, nx); b.st[0] = nloc; b.st[1] = nx; }
        const unsigned old = xb_add(&bar[XB_XSUB(b.x)], 1u);
        const unsigned gen = old / nloc;
        if (old + 1u == (gen + 1u) * nloc) {
            __builtin_amdgcn_fence(__ATOMIC_RELEASE, "agent");
            asm volatile("s_waitcnt vmcnt(0)" ::: "memory");
            const unsigned og = xb_add(&bar[XB_TOP], 1u);
            const unsigned tg = og / nx;
            if (og + 1u == (tg + 1u) * nx) xb_add(&bar[XB_TOPGEN], 1u);
            else XB_SPIN(xb_ld(&bar[XB_TOPGEN]) == tg, bar);
            __builtin_amdgcn_fence(__ATOMIC_ACQUIRE, "agent");
            xb_add(&bar[XB_XGEN(b.x)], 1u);
            asm volatile("s_waitcnt vmcnt(0)" ::: "memory");
        } else {
            XB_SPIN(xb_ld(&bar[XB_XGEN(b.x)]) == gen, bar);
            __builtin_amdgcn_fence(__ATOMIC_ACQUIRE, "agent");
            asm volatile("s_waitcnt vmcnt(0)" ::: "memory");
        }
    }
    __syncthreads();
}

constexpr int NWAVES = 8;
constexpr int NB = 8, SEQ = 2048, D = 1024, M = NB * SEQ;
constexpr int NIN = 5632, NE = 16, CAP = 256, MS = NE * NB * CAP;
constexpr float EPS = 1e-6f;
constexpr float LOG2E = 1.4426950408889634f;
constexpr size_t MiB = 1u << 20;
constexpr size_t WS_CTL = 0, CTL_ZERO_BYTES = 1 * MiB;
constexpr size_t WS_MOD = 1 * MiB;
constexpr size_t WS_CS = 1 * MiB + 256 * 1024;
constexpr size_t WS_AFF = 3 * MiB;
constexpr size_t WS_INV = 4 * MiB;
constexpr size_t WS_SELG = 5 * MiB;
constexpr size_t WS_WIN = 6 * MiB;
constexpr size_t WS_WIN8 = 12 * MiB + 512 * 1024;
constexpr size_t WS_WCAT = 17 * MiB;
constexpr size_t WS_WO = 19 * MiB;
constexpr size_t WS_WGU = 21 * MiB;
constexpr size_t WS_WD = 85 * MiB;
constexpr size_t WS_ACT0 = 117 * MiB;
constexpr size_t WS_RQ = 117 * MiB, WS_RK = 133 * MiB, WS_RV = 149 * MiB, WS_RG = 165 * MiB;
constexpr size_t WS_DQ1 = 181 * MiB;
constexpr size_t WS_DV = 213 * MiB;
constexpr size_t WS_GR = 229 * MiB, WS_GD = 261 * MiB;
constexpr size_t WS_END = 293 * MiB;
constexpr size_t WS_T1 = 117 * MiB;
constexpr size_t WS_MERGED = 149 * MiB;
constexpr size_t WS_H2 = 181 * MiB;
constexpr size_t WS_XG = 117 * MiB;
constexpr size_t WS_ACT = 213 * MiB;
constexpr size_t WS_X1 = 261 * MiB;
constexpr size_t WS_YS = 117 * MiB;
constexpr int CW_TMO = 0, CW_CODE = 1, CW_RET = 64, CW_MOD = 128, CW_BAR = 4096;
constexpr int RING_OFF = 0, RING_BYTES = 131072;
constexpr int LDSCTL_OFF = RING_BYTES, MISC_OFF = LDSCTL_OFF + 320;
constexpr int QS_OFF = RING_BYTES + 1024;
constexpr int LDS_BYTES = 147456;

typedef unsigned v2u __attribute__((ext_vector_type(2)));
typedef float f32x2 __attribute__((ext_vector_type(2)));
struct Frame {
    LAS unsigned char* lds;
    volatile LAS unsigned* MISC;
    gu32* ctl;
    int tid, lane, wave;
    int vcu, G;
    const float* in[22]; float* out; unsigned char* ws;
};
__device__ __forceinline__ float wave_sum(float v) {
#pragma unroll
    for (int o = 1; o < 64; o <<= 1) v += __shfl_xor(v, o);
    return v;
}
__device__ __forceinline__ float wave_max(float v) {
#pragma unroll
    for (int o = 1; o < 64; o <<= 1) v = fmaxf(v, __shfl_xor(v, o));
    return v;
}
__device__ __forceinline__ float bf2f_lo(unsigned w) { return __builtin_bit_cast(float, w << 16); }
__device__ __forceinline__ float bf2f_hi(unsigned w) { return __builtin_bit_cast(float, w & 0xffff0000u); }
__device__ __forceinline__ float bf2f(bf16 h) { return __builtin_bit_cast(float, ((unsigned)h) << 16); }
__device__ __forceinline__ float sigm(float v) { return __builtin_amdgcn_rcpf(1.0f + __builtin_amdgcn_exp2f(-LOG2E * v)); }
__device__ __forceinline__ float silu_exact(float v) { return v / (1.0f + __expf(-v)); }

__device__ __forceinline__ int gu_base(int o) { return (o >> 7) * 256 + ((o >> 2) & 1) * 128 + ((o >> 5) & 3) * 32 + ((o >> 3) & 3) * 4 + (o & 3); }
__device__ __forceinline__ void p0_transpose_item(const float* W, int N, bf16* WT, int dpitch, int kcol_off, int k0, int n0, int mode, int row_off, LAS float* scr, int lane) {
    float wv[32];
#pragma unroll
    for (int i = 0; i < 32; ++i) wv[i] = W[(size_t)(k0 + 2 * i + (lane >> 5)) * N + n0 + (lane & 31)];
#pragma unroll
    for (int i = 0; i < 32; ++i) scr[(2 * i + (lane >> 5)) * 33 + (lane & 31)] = wv[i];
    LDS_WAIT(); asm volatile("" ::: "memory");
    const int c = lane & 7;
#pragma unroll
    for (int j = 0; j < 4; ++j) { const int n = (lane >> 3) + 8 * j; const LAS float* s = scr + (8 * c) * 33 + n;
        v4u o; o.x = pk2(s[0 * 33], s[1 * 33]); o.y = pk2(s[2 * 33], s[3 * 33]); o.z = pk2(s[4 * 33], s[5 * 33]); o.w = pk2(s[6 * 33], s[7 * 33]);
        const int drow = row_off + (mode ? gu_base(n0 + n) : (n0 + n));
        *(GAS v4u*)(WT + (size_t)drow * dpitch + kcol_off + k0 + 8 * c) = o; }
    LDS_WAIT(); asm volatile("" ::: "memory");
}
__device__ __forceinline__ void p0_transpose_item8(const float* W, int N, unsigned char* WT, int dpitch, int k0, int n0, int mode, int row_off, LAS float* scr, int lane) {
    float wv[32];
#pragma unroll
    for (int i = 0; i < 32; ++i) wv[i] = W[(size_t)(k0 + 2 * i + (lane >> 5)) * N + n0 + (lane & 31)];
#pragma unroll
    for (int i = 0; i < 32; ++i) scr[(2 * i + (lane >> 5)) * 33 + (lane & 31)] = wv[i] * pg8::W8_SCALE;
    LDS_WAIT(); asm volatile("" ::: "memory");
    const int c = lane & 7;
#pragma unroll
    for (int j = 0; j < 4; ++j) { const int n = (lane >> 3) + 8 * j; const LAS float* s = scr + (8 * c) * 33 + n;
        v2u o; o.x = pg8::pk_fp8x4(s[0 * 33], s[1 * 33], s[2 * 33], s[3 * 33]); o.y = pg8::pk_fp8x4(s[4 * 33], s[5 * 33], s[6 * 33], s[7 * 33]);
        const int drow = row_off + (mode ? gu_base(n0 + n) : (n0 + n));
        *(GAS v2u*)(WT + (size_t)drow * dpitch + k0 + 8 * c) = o; }
    LDS_WAIT(); asm volatile("" ::: "memory");
}
constexpr int I_IN = 16 * 176, I_RO = 8 * 32, I_WO = 16 * 32, I_EX = 16 * 32;
constexpr int P0_NITEMS = I_IN + 2 * I_RO + I_WO + 48 * I_EX, P0_ITEMS = P0_NITEMS - 24 * I_EX, P0_MIX_ITEMS = I_IN + 2 * I_RO + I_WO;
__device__ __forceinline__ void p0_item(Frame& F, int it, LAS float* scr) {
    int r = it;
    if (r < I_IN) { p0_transpose_item(F.in[5], NIN, (bf16*)(F.ws + WS_WIN), 1024, 0, 64 * (r / 176), 32 * (r % 176), 0, 0, scr, F.lane); return; } r -= I_IN;
    if (r < I_RO) { p0_transpose_item(F.in[12], 1024, (bf16*)(F.ws + WS_WCAT), 1024, 0, 64 * (r / 32), 32 * (r % 32), 0, 0, scr, F.lane); return; } r -= I_RO;
    if (r < I_RO) { p0_transpose_item(F.in[13], 1024, (bf16*)(F.ws + WS_WCAT), 1024, 512, 64 * (r / 32), 32 * (r % 32), 0, 0, scr, F.lane); return; } r -= I_RO;
    if (r < I_WO) { p0_transpose_item(F.in[14], 1024, (bf16*)(F.ws + WS_WO), 1024, 0, 64 * (r / 32), 32 * (r % 32), 0, 0, scr, F.lane); return; } r -= I_WO;
    const int mat = r / I_EX, q = r % I_EX, ty = mat >> 4, e = mat & 15; const int k0 = 64 * (q / 32), n0 = 32 * (q % 32);
    if (ty == 0)      p0_transpose_item8(F.in[18] + (size_t)e * 1048576, 1024, F.ws + WS_WGU, 1024, k0, n0, 1, e * 2048, scr, F.lane);
    else if (ty == 1) p0_transpose_item8(F.in[19] + (size_t)e * 1048576, 1024, F.ws + WS_WGU, 1024, k0, n0, 1, e * 2048 + 16, scr, F.lane);
    else              p0_transpose_item8(F.in[20] + (size_t)e * 1048576, 1024, F.ws + WS_WD, 1024, k0, n0, 0, e * 1024, scr, F.lane);
}
__device__ __forceinline__ void p0_prologue(Frame& F) {
    if (blockIdx.x < 96) {
        LAS float* sc = (LAS float*)(F.lds);
        LAS float* red = (LAS float*)(F.lds + 32768);
        const float* cin = F.in[1];
        { float t_[16];
#pragma unroll
          for (int i = 0; i < 16; ++i) t_[i] = cin[F.tid + 512 * i];
#pragma unroll
          for (int i = 0; i < 16; ++i) { const int idx = F.tid + 512 * i, b = idx >> 10, k = idx & 1023; sc[k * 8 + b] = silu_exact(t_[i]); } }
        __syncthreads();
        const int j0 = blockIdx.x * 64; const float* wa = F.in[2] + j0 + F.lane;
        float a[8];
#pragma unroll
        for (int b = 0; b < 8; ++b) a[b] = 0.f;
        const int kb = F.wave * 128;
#pragma unroll 16
        for (int k = 0; k < 128; ++k) { const float wv = wa[(size_t)(kb + k) * 6144]; const f32x4 s0 = *(const LAS f32x4*)(sc + (kb + k) * 8), s1 = *(const LAS f32x4*)(sc + (kb + k) * 8 + 4);
            a[0] += s0[0] * wv; a[1] += s0[1] * wv; a[2] += s0[2] * wv; a[3] += s0[3] * wv; a[4] += s1[0] * wv; a[5] += s1[1] * wv; a[6] += s1[2] * wv; a[7] += s1[3] * wv; }
#pragma unroll
        for (int b = 0; b < 8; ++b) red[(F.wave * 8 + b) * 64 + F.lane] = a[b];
        __syncthreads();
        { const int b = F.wave; float s = F.in[3][j0 + F.lane];
#pragma unroll
          for (int w = 0; w < 8; ++w) s += red[(w * 8 + b) * 64 + F.lane];
          ((float*)(F.ws + WS_MOD))[b * 6144 + j0 + F.lane] = s; }
        __syncthreads();
    }
    { float* cs = (float*)(F.ws + WS_CS);
      for (int idx = blockIdx.x * 512 + F.tid; idx < 2048 * 64; idx += F.G * 512) { const int pos = idx >> 6, i = idx & 63;
          double inv = 1.0, r = 0.8639884494839686; int e = i;
          for (int t = 0; t < 6; ++t) { if (e & 1) inv *= r; r *= r; e >>= 1; }
          const float ang = (float)pos * (float)inv;
          const double rev = (double)ang * 0.15915494309189535; const float fr = (float)(rev - __builtin_rint(rev));
          cs[2 * idx] = __builtin_amdgcn_cosf(fr); cs[2 * idx + 1] = __builtin_amdgcn_sinf(fr); } }
    LAS float* scr = (LAS float*)(F.lds + RING_OFF + F.wave * 16384);
    const int gw = F.vcu * NWAVES + F.wave, NGW = F.G * NWAVES;
    for (int it = gw; it < P0_MIX_ITEMS; it += NGW) p0_item(F, it, scr);
    __syncthreads();
}
__device__ __forceinline__ void p3_items(Frame& F) {
    LAS float* scr = (LAS float*)(F.lds + RING_OFF + F.wave * 16384);
    for (int it = P0_MIX_ITEMS + F.vcu * NWAVES + F.wave; it < P0_ITEMS; it += F.G * NWAVES) p0_item(F, it, scr);
    __syncthreads();
}
__device__ __forceinline__ void p0_tail_items(Frame& F) {
    if (F.G != 256 || blockIdx.x < 128) { if (F.G != 256) { LAS float* scr = (LAS float*)(F.lds + RING_OFF + F.wave * 16384); for (int it = P0_ITEMS + F.vcu * NWAVES + F.wave; it < P0_NITEMS; it += F.G * NWAVES) p0_item(F, it, scr); } return; }
    LAS float* scr = (LAS float*)(F.lds + RING_OFF + F.wave * 16384);
    for (int it = P0_ITEMS + ((int)blockIdx.x - 128) * NWAVES + F.wave; it < P0_NITEMS; it += 128 * NWAVES) p0_item(F, it, scr);
}
__device__ __forceinline__ void p1_norm(Frame& F, bf16* XN) {
    const int gw = F.vcu * NWAVES + F.wave, NGW = F.G * NWAVES;
    const float* mod = (const float*)(F.ws + WS_MOD);
    for (int i = 0; i < M / NGW; ++i) { const int m = (F.G == 256) ? (F.vcu * 64 + F.wave * 8 + i) : (gw + i * NGW);
        const int b = m >> 11;
        const f32x4* xr = (const f32x4*)(F.in[0] + (size_t)m * D) + F.lane;
        const f32x4* gp = (const f32x4*)(F.in[4]) + F.lane;
        const f32x4* shp = (const f32x4*)(mod + b * 6144) + F.lane;
        const f32x4* scp = (const f32x4*)(mod + b * 6144 + 1024) + F.lane;
        f32x4 v[4]; float s = 0.f;
#pragma unroll
        for (int j = 0; j < 4; ++j) { v[j] = xr[64 * j]; s += (v[j].x * v[j].x + v[j].y * v[j].y) + (v[j].z * v[j].z + v[j].w * v[j].w); }
        const float rstd = 1.0f / sqrtf(wave_sum(s) * (1.f / D) + EPS);
        unsigned long long* o8 = (unsigned long long*)(XN + (size_t)m * D) + F.lane;
#pragma unroll
        for (int j = 0; j < 4; ++j) { const f32x4 g = gp[64 * j], sh = shp[64 * j], sc = scp[64 * j]; const f32x4 h = (v[j] * rstd) * g * (sc + 1.0f) + sh;
            o8[64 * j] = (unsigned long long)pk2(h.x, h.y) | ((unsigned long long)pk2(h.z, h.w) << 32); }
    }
}
__device__ __forceinline__ int t5_bucket(int rel) {
    const int n = rel < 0 ? -rel : rel; int bk;
    if (n < 8) bk = n; else if (n < 12) bk = 8; else if (n < 16) bk = 9; else if (n < 23) bk = 10; else if (n < 32) bk = 11; else if (n < 46) bk = 12; else if (n < 64) bk = 13; else if (n < 91) bk = 14; else bk = 15;
    return bk + (rel > 0 ? 16 : 0);
}
__device__ __forceinline__ float ln1m(float x) { return -x * (1.f + x * (0.5f + x * (0.33333334f + x * (0.25f + x * (0.2f + x * (0.16666667f + x * 0.14285715f)))))); }
template <int MODE>
__device__ __forceinline__ void naive_unit(Frame& F, int unit, float lam, bf16* YCAT) {
    const int b = unit >> 10, h = (unit >> 8) & 3, q0 = (unit & 255) * 8;
    LAS float* S = (LAS float*)(F.lds);
    unsigned qs_off = QS_OFF; asm volatile("" : "+v"(qs_off));
    LAS float* Qs = (LAS float*)(F.lds + qs_off);
    LAS float* BT = Qs + 1024;
    const bf16* RQ = (const bf16*)(F.ws + WS_RQ); const bf16* RK = (const bf16*)(F.ws + WS_RK); const bf16* RV = (const bf16*)(F.ws + WS_RV); const bf16* RG = (const bf16*)(F.ws + WS_RG);
    const bf16* DQ1 = (const bf16*)(F.ws + WS_DQ1); const bf16* DQ2 = DQ1 + (size_t)M * 256; const bf16* DK1 = DQ2 + (size_t)M * 256; const bf16* DK2 = DK1 + (size_t)M * 256;
    const bf16* DV = (const bf16*)(F.ws + WS_DV);
    const size_t rb = (size_t)b * SEQ;
    for (int idx = F.tid; idx < 1024; idx += 512) { const int qi = idx >> 7, d = idx & 127; const size_t row = rb + q0 + qi;
        float v;
        if (MODE == 0) v = bf2f(RQ[row * 512 + h * 128 + d]);
        else v = d < 64 ? bf2f(DQ1[row * 256 + h * 64 + d]) : bf2f(DQ2[row * 256 + h * 64 + d - 64]);
        Qs[idx] = v; }
    if (MODE == 1 && F.tid < 32) BT[F.tid] = F.in[15][F.tid * 4 + h] * LOG2E;
    __syncthreads();
    float l2f, l2b;
    { const float xf = __builtin_amdgcn_exp2f(-5.0f - (float)h); l2f = ln1m(xf) * LOG2E; l2b = ln1m(xf * 0.70710678118654752f) * LOG2E; }
    for (int j = F.tid; j < SEQ; j += 512) {
        asm volatile("" ::: "memory");
        float s1[8], s2[8];
#pragma unroll
        for (int qi = 0; qi < 8; ++qi) { s1[qi] = 0.f; s2[qi] = 0.f; }
#pragma unroll 1
        for (int c = 0; c < 16; ++c) {
            const bf16* kp;
            if (MODE == 0) kp = RK + (rb + j) * 512 + h * 128 + c * 8;
            else kp = (c < 8) ? (DK1 + (rb + j) * 256 + h * 64 + c * 8) : (DK2 + (rb + j) * 256 + h * 64 + (c - 8) * 8);
            const v4u kw = *(const v4u*)kp;
            const float kf[8] = {bf2f_lo(kw.x), bf2f_hi(kw.x), bf2f_lo(kw.y), bf2f_hi(kw.y), bf2f_lo(kw.z), bf2f_hi(kw.z), bf2f_lo(kw.w), bf2f_hi(kw.w)};
            float t[8];
#pragma unroll
            for (int qi = 0; qi < 8; ++qi) { const f32x4 qa = *(const LAS f32x4*)(Qs + qi * 128 + c * 8), qb = *(const LAS f32x4*)(Qs + qi * 128 + c * 8 + 4);
                t[qi] = (qa[0] * kf[0] + qa[1] * kf[1]) + (qa[2] * kf[2] + qa[3] * kf[3]) + (qb[0] * kf[4] + qb[1] * kf[5]) + (qb[2] * kf[6] + qb[3] * kf[7]); }
            if (MODE == 1 && c >= 8) {
#pragma unroll
                for (int qi = 0; qi < 8; ++qi) s2[qi] += t[qi];
            } else {
#pragma unroll
                for (int qi = 0; qi < 8; ++qi) s1[qi] += t[qi];
            }
        }
#pragma unroll
        for (int qi = 0; qi < 8; ++qi) { const int i = q0 + qi;
            if (MODE == 0) { const float w = (j <= i) ? __builtin_amdgcn_exp2f((float)(i - j) * l2f) : __builtin_amdgcn_exp2f((float)(j - i) * l2b); S[qi * SEQ + j] = s1[qi] * w; }
            else { const float bias = BT[t5_bucket(j - i)]; S[qi * SEQ + j] = s1[qi] + bias; S[(8 + qi) * SEQ + j] = s2[qi] + bias; } }
    }
    __syncthreads();
    const int qi = F.wave; LAS float* S1 = S + qi * SEQ; LAS float* S2 = S + (8 + qi) * SEQ;
    if (MODE == 1) {
        float m1 = -3.0e38f, m2 = -3.0e38f;
        for (int j = F.lane; j < SEQ; j += 64) { m1 = fmaxf(m1, S1[j]); m2 = fmaxf(m2, S2[j]); }
        m1 = wave_max(m1); m2 = wave_max(m2);
        float l1 = 0.f, l2 = 0.f;
        for (int j = F.lane; j < SEQ; j += 64) { l1 += __builtin_amdgcn_exp2f(S1[j] - m1); l2 += __builtin_amdgcn_exp2f(S2[j] - m2); }
        l1 = wave_sum(l1); l2 = wave_sum(l2);
        const float r1 = 1.0f / l1, r2 = lam / l2;
        for (int j = F.lane; j < SEQ; j += 64) S1[j] = __builtin_amdgcn_exp2f(S1[j] - m1) * r1 - __builtin_amdgcn_exp2f(S2[j] - m2) * r2;
        LDS_WAIT(); asm volatile("" ::: "memory");
    }
    const bf16* V = (MODE == 0 ? RV : DV) + rb * 512 + h * 128 + 2 * F.lane;
    float o0 = 0.f, o1 = 0.f;
#pragma unroll 8
    for (int j = 0; j < SEQ; ++j) { const float p = S1[j]; const unsigned vv = *(const unsigned*)(V + (size_t)j * 512); o0 += p * bf2f_lo(vv); o1 += p * bf2f_hi(vv); }
    const size_t row = rb + q0 + qi;
    if (MODE == 0) {
        const float mean = wave_sum(o0 + o1) * (1.f / 128.f); const float d0 = o0 - mean, d1 = o1 - mean;
        const float var = wave_sum(d0 * d0 + d1 * d1) * (1.f / 128.f); const float rstd = 1.0f / sqrtf(var + EPS);
        const unsigned gw = *(const unsigned*)(RG + row * 512 + h * 128 + 2 * F.lane);
        const float y0 = d0 * rstd * F.in[6][h * 128 + 2 * F.lane] * bf2f_lo(gw), y1 = d1 * rstd * F.in[6][h * 128 + 2 * F.lane + 1] * bf2f_hi(gw);
        *(unsigned*)(YCAT + row * 1024 + h * 128 + 2 * F.lane) = pk2(y0, y1);
    } else {
        const float ms = wave_sum(o0 * o0 + o1 * o1) * (1.f / 128.f); const float rstd = 1.0f / sqrtf(ms + EPS);
        const float y0 = o0 * rstd * F.in[7][2 * F.lane] * 0.8f, y1 = o1 * rstd * F.in[7][2 * F.lane + 1] * 0.8f;
        *(unsigned*)(YCAT + row * 1024 + 512 + h * 128 + 2 * F.lane) = pk2(y0, y1);
    }
    __syncthreads();
}
__device__ __forceinline__ void router_finish(const float (&lg)[16], int lane, float* affrow) {
    float r8[8], r4[4], r2[2], r1;
    { const bool up = (lane & 32) != 0;
#pragma unroll
      for (int e = 0; e < 8; ++e) { const float keep = up ? lg[e + 8] : lg[e], send = up ? lg[e] : lg[e + 8]; r8[e] = keep + __shfl_xor(send, 32); } }
    { const bool up = (lane & 16) != 0;
#pragma unroll
      for (int e = 0; e < 4; ++e) { const float keep = up ? r8[e + 4] : r8[e], send = up ? r8[e] : r8[e + 4]; r4[e] = keep + __shfl_xor(send, 16); } }
    { const bool up = (lane & 8) != 0;
#pragma unroll
      for (int e = 0; e < 2; ++e) { const float keep = up ? r4[e + 2] : r4[e], send = up ? r4[e] : r4[e + 2]; r2[e] = keep + __shfl_xor(send, 8); } }
    { const bool up = (lane & 4) != 0; const float keep = up ? r2[1] : r2[0], send = up ? r2[0] : r2[1]; r1 = keep + __shfl_xor(send, 4); }
    r1 += __shfl_xor(r1, 2); r1 += __shfl_xor(r1, 1);
    float mx = r1;
#pragma unroll
    for (int o = 4; o < 64; o <<= 1) mx = fmaxf(mx, __shfl_xor(mx, o));
    const float ex = __expf(r1 - mx); float den = ex;
#pragma unroll
    for (int o = 4; o < 64; o <<= 1) den += __shfl_xor(den, o);
    if ((lane & 3) == 0) { const int e = ((lane >> 5) & 1) * 8 + ((lane >> 4) & 1) * 4 + ((lane >> 3) & 1) * 2 + ((lane >> 2) & 1); affrow[e] = ex / den; }
}
__device__ __forceinline__ void p7_router(Frame& F, const bf16* X1, unsigned char* H2, float* AFF) {
    LAS float* wr = (LAS float*)(F.lds);
    { f32x4 t_[8];
#pragma unroll
      for (int i = 0; i < 8; ++i) { const int q = F.tid + 512 * i, eq = q >> 10, k = q & 1023; t_[i] = *(const f32x4*)(F.in[17] + k * 16 + 4 * eq); }
#pragma unroll
      for (int i = 0; i < 8; ++i) { const int q = F.tid + 512 * i, eq = q >> 10, k = q & 1023;
          wr[(4 * eq + 0) * 1024 + k] = t_[i].x; wr[(4 * eq + 1) * 1024 + k] = t_[i].y; wr[(4 * eq + 2) * 1024 + k] = t_[i].z; wr[(4 * eq + 3) * 1024 + k] = t_[i].w; } }
    __syncthreads();
    const int gw = F.vcu * NWAVES + F.wave, NGW = F.G * NWAVES;
    const float* mod = (const float*)(F.ws + WS_MOD);
#pragma unroll 1
    for (int i = 0; i < M / 4 / NGW; ++i) {
        const int m = (F.G == 256) ? (F.vcu * 64 + F.wave * 8 + 4 * i) : 4 * (gw + i * NGW), b = m >> 11;
        const f32x4* gp = (const f32x4*)(F.in[16]) + F.lane;
        const f32x4* shp = (const f32x4*)(mod + b * 6144 + 3072) + F.lane;
        const f32x4* scp = (const f32x4*)(mod + b * 6144 + 4096) + F.lane;
        f32x4 v[4][4]; float ss[4];
        { const v2u* x0 = (const v2u*)(X1 + (size_t)m * D) + F.lane;
#pragma unroll
          for (int r = 0; r < 4; ++r) { ss[r] = 0.f;
#pragma unroll
              for (int j = 0; j < 4; ++j) { const v2u w = x0[r * (D / 4) + 64 * j]; v[r][j] = (f32x4){bf2f_lo(w.x), bf2f_hi(w.x), bf2f_lo(w.y), bf2f_hi(w.y)};
                  ss[r] += (v[r][j].x * v[r][j].x + v[r][j].y * v[r][j].y) + (v[r][j].z * v[r][j].z + v[r][j].w * v[r][j].w); } } }
        f32x4 gs[4], sh[4];
#pragma unroll
        for (int j = 0; j < 4; ++j) { gs[j] = gp[64 * j] * (scp[64 * j] + 1.0f); sh[j] = shp[64 * j]; }
#pragma unroll
        for (int r = 0; r < 4; ++r) { const float rstd = 1.0f / sqrtf(wave_sum(ss[r]) * (1.f / D) + EPS);
            unsigned pk[4];
#pragma unroll
            for (int j = 0; j < 4; ++j) { v[r][j] = (v[r][j] * rstd) * gs[j] + sh[j]; pk[j] = pg8::pk_fp8x4(v[r][j].x, v[r][j].y, v[r][j].z, v[r][j].w); }
            const int qi = F.lane & 3; v4u st;
            { unsigned c0, c1, c2, c3;
              const unsigned mine0 = pk[0], mine1 = pk[1], mine2 = pk[2], mine3 = pk[3];
#define QSEL(s) ({ const unsigned a0_ = (unsigned)__builtin_amdgcn_mov_dpp((int)mine0, 0x55 * (s), 0xf, 0xf, true), a1_ = (unsigned)__builtin_amdgcn_mov_dpp((int)mine1, 0x55 * (s), 0xf, 0xf, true), \
                               a2_ = (unsigned)__builtin_amdgcn_mov_dpp((int)mine2, 0x55 * (s), 0xf, 0xf, true), a3_ = (unsigned)__builtin_amdgcn_mov_dpp((int)mine3, 0x55 * (s), 0xf, 0xf, true); \
                               qi == 0 ? a0_ : (qi == 1 ? a1_ : (qi == 2 ? a2_ : a3_)); })
              c0 = QSEL(0); c1 = QSEL(1); c2 = QSEL(2); c3 = QSEL(3);
#undef QSEL
              st = (v4u){c0, c1, c2, c3}; }
            *(v4u*)(H2 + (size_t)(m + r) * D + 256 * qi + 16 * (F.lane >> 2)) = st; }
        float l0[16], l1[16], l2[16], l3[16];
#pragma unroll
        for (int e = 0; e < 16; ++e) { float a0 = 0.f, a1 = 0.f, a2 = 0.f, a3 = 0.f;
#pragma unroll
            for (int j = 0; j < 4; ++j) { const f32x4 w = *(const LAS f32x4*)(wr + e * 1024 + 4 * F.lane + 256 * j);
                a0 += (v[0][j].x * w.x + v[0][j].y * w.y) + (v[0][j].z * w.z + v[0][j].w * w.w); a1 += (v[1][j].x * w.x + v[1][j].y * w.y) + (v[1][j].z * w.z + v[1][j].w * w.w);
                a2 += (v[2][j].x * w.x + v[2][j].y * w.y) + (v[2][j].z * w.z + v[2][j].w * w.w); a3 += (v[3][j].x * w.x + v[3][j].y * w.y) + (v[3][j].z * w.z + v[3][j].w * w.w); }
            asm volatile("" : "+v"(a0), "+v"(a1), "+v"(a2), "+v"(a3));
            l0[e] = a0; l1[e] = a1; l2[e] = a2; l3[e] = a3; }
        router_finish(l0, F.lane, AFF + (size_t)m * 16); router_finish(l1, F.lane, AFF + (size_t)(m + 1) * 16);
        router_finish(l2, F.lane, AFF + (size_t)(m + 2) * 16); router_finish(l3, F.lane, AFF + (size_t)(m + 3) * 16);
    }
    __syncthreads();
}
__device__ __forceinline__ void p8_topk(Frame& F, const float* AFF, int* SELI, float* SELG, int* INV) {
    LAS int* wsum = (LAS int*)(F.lds);
    LAS int* sel = (LAS int*)(F.lds + 1024);
    for (int item = blockIdx.x; item < NB * NE; item += F.G) {
        const int pe = item, half = 0, b = pe >> 4, e = pe & 15;
        unsigned key[4];
#pragma unroll
        for (int c = 0; c < 4; ++c) key[c] = __builtin_bit_cast(unsigned, AFF[((size_t)b * SEQ + 4 * F.tid + c) * 16 + e]);
        unsigned tau = 0u;
        for (int bit = 30; bit >= 0; --bit) {
            const unsigned cand = tau | (1u << bit);
            int cnt = 0;
#pragma unroll
            for (int c = 0; c < 4; ++c) cnt += __builtin_popcountll(__ballot(key[c] >= cand));
            LAS int* ws_ = wsum + (bit & 1) * 8;
            if (F.lane == 0) ws_[F.wave] = cnt;
            __syncthreads();
            int tot = 0;
#pragma unroll
            for (int w = 0; w < 8; ++w) tot += ws_[w];
            if (tot >= CAP) tau = cand;
        }
        int gt_before = 0, eq_before = 0;
        int my_gt = 0, my_eq = 0;
#pragma unroll
        for (int c = 0; c < 4; ++c) { my_gt += key[c] > tau; my_eq += key[c] == tau; }
        int pk = my_gt | (my_eq << 16), sc = pk;
#pragma unroll
        for (int o = 1; o < 64; o <<= 1) { const int v = __shfl_up(sc, o); if (F.lane >= o) sc += v; }
        LAS int* wtot = wsum + 16;
        __syncthreads();
        if (F.lane == 63) wtot[F.wave] = sc;
        __syncthreads();
        int base = 0, total = 0;
#pragma unroll
        for (int w = 0; w < 8; ++w) { const int v = wtot[w]; if (w < F.wave) base += v; total += v; }
        const int excl = base + sc - pk; gt_before = excl & 0xffff; eq_before = excl >> 16;
        const int n_gt = total & 0xffff, need = CAP - n_gt;
        const int slot0 = (e * NB + b) * CAP;
        int g = gt_before, q = eq_before;
#pragma unroll
        for (int c = 0; c < 4; ++c) { const int s = 4 * F.tid + c; int slot = -1;
            if (key[c] > tau) { slot = g; ++g; } else if (key[c] == tau) { if (q < need) slot = n_gt + q; ++q; }
            if (half == 0) INV[((size_t)b * SEQ + s) * 16 + e] = slot;
            if (slot >= 0) { SELI[slot0 + slot] = b * SEQ + s; SELG[slot0 + slot] = __builtin_bit_cast(float, key[c]); } }
        __syncthreads();
    }
}
__device__ __forceinline__ void p11_final(Frame& F, const bf16* X1, const unsigned char* YS, const int* INV) {
    const int gw = F.vcu * NWAVES + F.wave, NGW = F.G * NWAVES;
    const float* mod = (const float*)(F.ws + WS_MOD);
    for (int i = 0; i < M / 2 / NGW; ++i) {
        const int m0 = (F.G == 256) ? (F.vcu * 64 + F.wave * 8 + 2 * i) : 2 * (gw + i * NGW); const int b = m0 >> 11;
        const int inv0 = INV[(size_t)m0 * 16 + (F.lane & 15)], inv1 = INV[(size_t)(m0 + 1) * 16 + (F.lane & 15)];
        f32x4 v[2][4], y[2][4];
#pragma unroll
        for (int r = 0; r < 2; ++r) { const v2u* xr = (const v2u*)(X1 + (size_t)(m0 + r) * D) + F.lane;
#pragma unroll
            for (int j = 0; j < 4; ++j) { const v2u w = xr[64 * j]; v[r][j] = (f32x4){bf2f_lo(w.x), bf2f_hi(w.x), bf2f_lo(w.y), bf2f_hi(w.y)}; y[r][j] = (f32x4){0.f, 0.f, 0.f, 0.f}; } }
#pragma unroll
        for (int r = 0; r < 2; ++r) {
            const int myinv = r ? inv1 : inv0;
            unsigned mask = (unsigned)(__ballot(myinv >= 0) & 0xffffull);
            while (mask) {
                int w4[4][4]; int cnt = 0;
#pragma unroll
                for (int q = 0; q < 4; ++q) { if (mask) { const int e = __builtin_ctz(mask); mask &= mask - 1; const int slot = __builtin_amdgcn_readlane(myinv, e);
                        const int* yp = (const int*)(YS + (size_t)((e * NB + b) * CAP + slot) * D) + F.lane;
#pragma unroll
                        for (int j = 0; j < 4; ++j) w4[q][j] = yp[64 * j];
                        cnt = q + 1; } else {
#pragma unroll
                        for (int j = 0; j < 4; ++j) w4[q][j] = 0; } }
#pragma unroll
                for (int q = 0; q < 4; ++q)
#pragma unroll
                    for (int j = 0; j < 4; ++j) { const f32x2 lo = __builtin_amdgcn_cvt_pk_f32_fp8(w4[q][j], false), hi = __builtin_amdgcn_cvt_pk_f32_fp8(w4[q][j], true);
                        y[r][j] = y[r][j] + (f32x4){lo.x, lo.y, hi.x, hi.y}; }
                (void)cnt;
            }
        }
        const f32x4* gap = (const f32x4*)(mod + b * 6144 + 5120) + F.lane;
        const f32x4* gp = (const f32x4*)(F.in[21]) + F.lane;
#pragma unroll
        for (int r = 0; r < 2; ++r) { float s = 0.f;
#pragma unroll
            for (int j = 0; j < 4; ++j) { v[r][j] = v[r][j] + gap[64 * j] * y[r][j] * (1.f / pg8::YS_SCALE); s += (v[r][j].x * v[r][j].x + v[r][j].y * v[r][j].y) + (v[r][j].z * v[r][j].z + v[r][j].w * v[r][j].w); }
            const float rstd = 1.0f / sqrtf(wave_sum(s) * (1.f / D) + EPS);
            f32x4* orow = (f32x4*)(F.out + (size_t)(m0 + r) * D) + F.lane;
#pragma unroll
            for (int j = 0; j < 4; ++j) orow[64 * j] = (v[r][j] * rstd) * gp[64 * j]; }
    }
}

namespace mx {
typedef float f32x16 __attribute__((ext_vector_type(16)));
typedef short s16x4 __attribute__((ext_vector_type(4)));
typedef short v4i16_t __attribute__((ext_vector_type(4)));
typedef float f32x2_t __attribute__((ext_vector_type(2)));
typedef __bf16 bf16x2_t __attribute__((ext_vector_type(2)));
typedef LAS const char* lds_cptr;
constexpr int ST_K1 = 0, ST_K2 = 8192, ST_V = 16384, ST_BYTES = 32768;
constexpr int BT_OFF = QS_OFF;
__device__ __forceinline__ int crow(int r, int hi) { return (r & 3) + 8 * (r >> 2) + 4 * hi; }
__device__ __forceinline__ unsigned cvtpk(float lo, float hi) { f32x2_t v = {lo, hi}; bf16x2_t b = __builtin_convertvector(v, bf16x2_t); return __builtin_bit_cast(unsigned, b); }
__device__ __forceinline__ s16x4 vtr(lds_cptr p) { return __builtin_bit_cast(s16x4, __builtin_amdgcn_ds_read_tr16_b64_v4i16((LAS v4i16_t*)p)); }
template <int NKS>
__device__ __forceinline__ void qkt(f32x16& p0, f32x16& p1, lds_cptr kb, const bf16x8* qr) {
#pragma unroll
    for (int ks = 0; ks < NKS; ++ks) { const bf16x8 b0 = *(const LAS bf16x8*)(kb + ks * 2048), b1 = *(const LAS bf16x8*)(kb + ks * 2048 + 512);
        p0 = __builtin_amdgcn_mfma_f32_32x32x16_bf16(b0, qr[ks], p0, 0, 0, 0); p1 = __builtin_amdgcn_mfma_f32_32x32x16_bf16(b1, qr[ks], p1, 0, 0, 0); }
}
template <int NKS>
__device__ __forceinline__ void qkt1(f32x16& p, lds_cptr kb, const bf16x8* qr) {
#pragma unroll
    for (int ks = 0; ks < NKS; ++ks) { const bf16x8 b0 = *(const LAS bf16x8*)(kb + ks * 2048); p = __builtin_amdgcn_mfma_f32_32x32x16_bf16(b0, qr[ks], p, 0, 0, 0); }
}
template <int NKS>
__device__ __forceinline__ void kload(bf16x8 (&kf)[NKS], lds_cptr kb) {
#pragma unroll
    for (int ks = 0; ks < NKS; ++ks) kf[ks] = *(const LAS bf16x8*)(kb + ks * 2048);
}
template <int NKS>
__device__ __forceinline__ void kmma(f32x16& p, const f32x16& init, const bf16x8 (&kf)[NKS], const bf16x8* qr) {
    p = __builtin_amdgcn_mfma_f32_32x32x16_bf16(kf[0], qr[0], init, 0, 0, 0);
#pragma unroll
    for (int ks = 1; ks < NKS; ++ks) p = __builtin_amdgcn_mfma_f32_32x32x16_bf16(kf[ks], qr[ks], p, 0, 0, 0);
}
__device__ __forceinline__ bf16x8 packp(const f32x16& p, int s) {
    v4u w; w.x = cvtpk(p[8 * s + 0], p[8 * s + 1]); w.y = cvtpk(p[8 * s + 2], p[8 * s + 3]); w.z = cvtpk(p[8 * s + 4], p[8 * s + 5]); w.w = cvtpk(p[8 * s + 6], p[8 * s + 7]);
    return __builtin_bit_cast(bf16x8, w);
}
#define MX_SB() __builtin_amdgcn_sched_barrier(0)
__device__ __forceinline__ void vload(s16x4 (&lo)[4], s16x4 (&hh)[4], lds_cptr vp, int d0) {
#pragma unroll
    for (int kk = 0; kk < 4; ++kk) { lo[kk] = vtr(vp + d0 * 4096 + kk * 1024); hh[kk] = vtr(vp + d0 * 4096 + kk * 1024 + 512); }
}
__device__ __forceinline__ void vmma(f32x16& o, const s16x4 (&lo)[4], const s16x4 (&hh)[4], const bf16x8 (&pw)[4]) {
#pragma unroll
    for (int kk = 0; kk < 4; ++kk) { const bf16x8 vf = (bf16x8){lo[kk][0], lo[kk][1], lo[kk][2], lo[kk][3], hh[kk][0], hh[kk][1], hh[kk][2], hh[kk][3]};
        o = __builtin_amdgcn_mfma_f32_32x32x16_bf16(vf, pw[kk], o, 0, 0, 0); }
}
__device__ __forceinline__ void pv(f32x16 (&o)[4], lds_cptr vp, const bf16x8 (&pw)[4]) {
    s16x4 la[4], ha[4], lb[4], hb[4];
    vload(la, ha, vp, 0); vload(lb, hb, vp, 1); MX_SB();
    vmma(o[0], la, ha, pw); MX_SB(); vload(la, ha, vp, 2); MX_SB();
    vmma(o[1], lb, hb, pw); MX_SB(); vload(lb, hb, vp, 3); MX_SB();
    vmma(o[2], la, ha, pw); MX_SB();
    vmma(o[3], lb, hb, pw); MX_SB();
}
__device__ __forceinline__ float max32(const f32x16& a, const f32x16& b) {
    float m = fmaxf(a[0], b[0]);
#pragma unroll
    for (int r = 1; r < 16; ++r) m = fmaxf(m, fmaxf(a[r], b[r]));
    return m;
}

#define MX_WAITBAR(N) asm volatile("s_waitcnt vmcnt(" #N ") lgkmcnt(0)\n\ts_barrier" ::: "memory")
__device__ __forceinline__ void glds(const void* g, LAS unsigned char* l) { unsigned keep; const unsigned dst = (unsigned)__builtin_amdgcn_readfirstlane((int)(unsigned)(size_t)l);
    asm volatile("s_mov_b32 %0, m0\n\ts_mov_b32 m0, %2\n\ts_nop 0\n\tglobal_load_lds_dwordx4 %1, off\n\ts_mov_b32 m0, %0" : "=&s"(keep) : "v"(g), "s"(dst) : "memory"); }
__device__ __forceinline__ f32x16 splat16(float v) { f32x16 r;
#pragma unroll
    for (int i = 0; i < 16; ++i) r[i] = v;
    return r; }
template <int NKS>
__device__ __forceinline__ void qkt1i(f32x16& p, const f32x16& init, lds_cptr kb, const bf16x8* qr) {
    p = __builtin_amdgcn_mfma_f32_32x32x16_bf16(*(const LAS bf16x8*)(kb), qr[0], init, 0, 0, 0);
#pragma unroll
    for (int ks = 1; ks < NKS; ++ks) p = __builtin_amdgcn_mfma_f32_32x32x16_bf16(*(const LAS bf16x8*)(kb + ks * 2048), qr[ks], p, 0, 0, 0);
}

template <int VAR>
__device__ __forceinline__ void diff_unit(Frame& F, int b, int h, int qb, float lam, bf16* YCAT) {
    const int lane = F.lane, r32 = lane & 31, hi = lane >> 5, wave = F.wave, half = wave >> 2;
    const size_t rb = (size_t)b * SEQ; const int qw = qb * 256 + wave * 32;
    const bf16* DQ1 = (const bf16*)(F.ws + WS_DQ1); const bf16* DQ2 = DQ1 + (size_t)M * 256; const bf16* DK1 = DQ2 + (size_t)M * 256; const bf16* DK2 = DK1 + (size_t)M * 256;
    const bf16* DV = (const bf16*)(F.ws + WS_DV);
    LAS float* bt = (LAS float*)(F.lds + BT_OFF);
    __syncthreads();
    for (int i = F.tid; i < 512; i += 512) bt[i] = F.in[15][t5_bucket(i - 256) * 4 + h] * LOG2E;
    const float cneg = F.in[15][15 * 4 + h] * LOG2E, cpos = F.in[15][31 * 4 + h] * LOG2E;
    bf16x8 qr1[4], qr2[4];
#pragma unroll
    for (int ks = 0; ks < 4; ++ks) { qr1[ks] = *(const bf16x8*)(DQ1 + (rb + qw + r32) * 256 + h * 64 + ks * 16 + hi * 8); qr2[ks] = *(const bf16x8*)(DQ2 + (rb + qw + r32) * 256 + h * 64 + ks * 16 + hi * 8); }
    const bf16* k1src = DK1 + (rb + lane) * 256 + h * 64 + wave * 8; const bf16* k2src = DK2 + (rb + lane) * 256 + h * 64 + wave * 8;
    const bf16* vsrc0 = DV + (rb + ((2 * wave) & 3) * 16 + (lane >> 2)) * 512 + h * 128 + ((2 * wave) >> 2) * 32 + (lane & 3) * 8;
    const bf16* vsrc1 = DV + (rb + ((2 * wave + 1) & 3) * 16 + (lane >> 2)) * 512 + h * 128 + ((2 * wave + 1) >> 2) * 32 + (lane & 3) * 8;
    const lds_cptr L = (lds_cptr)F.lds;
    const int kfo = hi * 1024 + r32 * 16;
    const int vfo = ST_V + ((lane >> 4) & 1) * 32 + (lane & 3) * 8 + (4 * hi + ((lane & 15) >> 2)) * 64;
    const int btb = (256 - qw - r32 + 4 * hi) * 4;
#define DIFF_DMA(u, WITHV) do { const int so_ = ((u) % 3) * ST_BYTES; const size_t ko_ = (size_t)(u) * 64 * 256; \
        glds(k1src + ko_, F.lds + so_ + ST_K1 + wave * 1024); glds(k2src + ko_, F.lds + so_ + ST_K2 + wave * 1024); \
        if (WITHV) { const size_t vo_ = (size_t)(u) * 64 * 512; glds(vsrc0 + vo_, F.lds + so_ + ST_V + wave * 2048); glds(vsrc1 + vo_, F.lds + so_ + ST_V + wave * 2048 + 1024); } } while (0)
    constexpr int T = 32;
#define P1_DMA(u) do { const int so_ = ((u) % 6) * 16384; const size_t ko_ = (size_t)(u) * 64 * 256; \
        glds(k1src + ko_, F.lds + so_ + wave * 1024); glds(k2src + ko_, F.lds + so_ + 8192 + wave * 1024); } while (0)
#define P1_WAIT(t) do { const int rem_ = T - 2 - (t); if (rem_ >= 3) MX_WAITBAR(6); else if (rem_ == 2) MX_WAITBAR(4); else if (rem_ == 1) MX_WAITBAR(2); else MX_WAITBAR(0); } while (0)
#pragma unroll
    for (int ks = 0; ks < 4; ++ks) { asm volatile("" : "+v"(qr1[ks])); asm volatile("" : "+v"(qr2[ks])); }
    P1_DMA(0); P1_DMA(1); P1_DMA(2); P1_DMA(3);
    MX_WAITBAR(0);
    float mref1 = 0.f, mref2 = 0.f, l1 = 0.f, l2 = 0.f;
    f32x16 ni1 = splat16(0.f), ni2 = splat16(0.f);
    f32x16 a0, a1, c0, c1;
    const float ecneg = __builtin_amdgcn_exp2f(cneg), ecpos = __builtin_amdgcn_exp2f(cpos);
    for (int t = 0; t < ((VAR & 1) ? 0 : T); ++t) {
        const lds_cptr stg = L + (t % 6) * 16384;
        if (t + 4 < T) P1_DMA(t + 4);
        { bf16x8 ka[4], kb_[4], kc[4], kd[4];
          kload<4>(ka, stg + ST_K1 + kfo); kload<4>(kb_, stg + ST_K1 + kfo + 512); kload<4>(kc, stg + ST_K2 + kfo); kload<4>(kd, stg + ST_K2 + kfo + 512); MX_SB();
          kmma<4>(a0, ni1, ka, qr1); kmma<4>(a1, ni1, kb_, qr1); kmma<4>(c0, ni2, kc, qr2); kmma<4>(c1, ni2, kd, qr2); MX_SB(); }
        if (!(VAR & 16)) {
            const int kt = t * 64; float cc = 0.f, ecc = 1.f;
            if (kt <= qw - 191) { cc = cneg; ecc = ecneg; } else if (kt >= qw + 159) { cc = cpos; ecc = ecpos; }
            else { const LAS float* bp = (const LAS float*)((lds_cptr)bt + btb + kt * 4);
#pragma unroll
                for (int r = 0; r < 16; ++r) { const float b0 = bp[(r & 3) + 8 * (r >> 2)], b1 = bp[32 + (r & 3) + 8 * (r >> 2)]; a0[r] += b0; c0[r] += b0; a1[r] += b1; c1[r] += b1; } }
            float s1 = 0.f, s2 = 0.f;
#pragma unroll
            for (int r = 0; r < 16; ++r) { s1 += __builtin_amdgcn_exp2f(a0[r]) + __builtin_amdgcn_exp2f(a1[r]); s2 += __builtin_amdgcn_exp2f(c0[r]) + __builtin_amdgcn_exp2f(c1[r]); }
            s1 *= ecc; s2 *= ecc;
            if (__any(t == 0 || !(s1 < 1e15f) || !(s2 < 1e15f))) {
                { float d = max32(a0, a1) + cc; if (t != 0) d = fmaxf(d, 0.f); mref1 += d; l1 *= __builtin_amdgcn_exp2f(-d); const float sh = d - cc; s1 = 0.f;
#pragma unroll
                  for (int r = 0; r < 16; ++r) s1 += __builtin_amdgcn_exp2f(a0[r] - sh) + __builtin_amdgcn_exp2f(a1[r] - sh);
                  ni1 = splat16(-mref1); }
                { float d = max32(c0, c1) + cc; if (t != 0) d = fmaxf(d, 0.f); mref2 += d; l2 *= __builtin_amdgcn_exp2f(-d); const float sh = d - cc; s2 = 0.f;
#pragma unroll
                  for (int r = 0; r < 16; ++r) s2 += __builtin_amdgcn_exp2f(c0[r] - sh) + __builtin_amdgcn_exp2f(c1[r] - sh);
                  ni2 = splat16(-mref2); }
            }
            l1 += s1; l2 += s2;
        }
        P1_WAIT(t);
    }
    float ml1, ml2;
    { const float mo = __shfl_xor(mref1, 32), lo = __shfl_xor(l1, 32), mm = fmaxf(mref1, mo); const float ll = l1 * __builtin_amdgcn_exp2f(mref1 - mm) + lo * __builtin_amdgcn_exp2f(mo - mm); ml1 = mm + __builtin_amdgcn_logf(ll); }
    { const float mo = __shfl_xor(mref2, 32), lo = __shfl_xor(l2, 32), mm = fmaxf(mref2, mo); const float ll = l2 * __builtin_amdgcn_exp2f(mref2 - mm) + lo * __builtin_amdgcn_exp2f(mo - mm); ml2 = mm + __builtin_amdgcn_logf(ll); }
#define P2_DMA(u) do { const int so_ = ((u) & 3) * ST_BYTES; const size_t ko_ = (size_t)(u) * 64 * 256, vo_ = (size_t)(u) * 64 * 512; \
        glds(k1src + ko_, F.lds + so_ + ST_K1 + wave * 1024); glds(k2src + ko_, F.lds + so_ + ST_K2 + wave * 1024); \
        glds(vsrc0 + vo_, F.lds + so_ + ST_V + wave * 2048); glds(vsrc1 + vo_, F.lds + so_ + ST_V + wave * 2048 + 1024); } while (0)
    P2_DMA(0); P2_DMA(1);
    MX_WAITBAR(0);
    f32x16 o[4]; o[0] = f32x16{}; o[1] = f32x16{}; o[2] = f32x16{}; o[3] = f32x16{};
    bf16x8 pw[4];
    int cls = -1;
    for (int t = 0; t < T; ++t) {
        const lds_cptr stg = L + (t & 3) * ST_BYTES;
        if (t + 2 < T) P2_DMA(t + 2);
        if (t > 0) pv(o, L + ((t - 1) & 3) * ST_BYTES + vfo, pw);
        const int kt = t * 64; const int c3 = (kt <= qw - 191) ? 0 : ((kt >= qw + 159) ? 2 : 1);
        if (c3 != cls) { cls = c3; const float cc = (c3 == 0) ? cneg : ((c3 == 2) ? cpos : 0.f); ni1 = splat16(cc - ml1); ni2 = splat16(cc - ml2); }
        { bf16x8 ka[4], kc[4], kb_[4], kd[4];
          kload<4>(ka, stg + ST_K1 + kfo); kload<4>(kc, stg + ST_K2 + kfo); kload<4>(kb_, stg + ST_K1 + kfo + 512); kload<4>(kd, stg + ST_K2 + kfo + 512); MX_SB();
          kmma<4>(a0, ni1, ka, qr1); kmma<4>(c0, ni2, kc, qr2); kmma<4>(a1, ni1, kb_, qr1); kmma<4>(c1, ni2, kd, qr2); MX_SB(); }
        {
            if (c3 == 1) { const LAS float* bp = (const LAS float*)((lds_cptr)bt + btb + kt * 4);
#pragma unroll
                for (int r = 0; r < 16; ++r) { const float b0 = bp[(r & 3) + 8 * (r >> 2)], b1 = bp[32 + (r & 3) + 8 * (r >> 2)]; a0[r] += b0; c0[r] += b0; a1[r] += b1; c1[r] += b1; } }
#pragma unroll
            for (int r = 0; r < 16; ++r) a0[r] = __builtin_amdgcn_exp2f(a0[r]) - lam * __builtin_amdgcn_exp2f(c0[r]);
            pw[0] = packp(a0, 0); pw[1] = packp(a0, 1);
#pragma unroll
            for (int r = 0; r < 16; ++r) a1[r] = __builtin_amdgcn_exp2f(a1[r]) - lam * __builtin_amdgcn_exp2f(c1[r]);
            pw[2] = packp(a1, 0); pw[3] = packp(a1, 1);
        }
        if (t + 2 < T) MX_WAITBAR(4); else MX_WAITBAR(0);
    }
    pv(o, L + ((T - 1) & 3) * ST_BYTES + vfo, pw);
#undef P2_DMA
#undef DIFF_DMA
#undef P1_DMA
#undef P1_WAIT
    float ss = 0.f;
#pragma unroll
    for (int d0 = 0; d0 < 4; ++d0)
#pragma unroll
        for (int r = 0; r < 16; ++r) ss += o[d0][r] * o[d0][r];
    ss += __shfl_xor(ss, 32);
    const float rstd = 0.8f / sqrtf(ss * (1.f / 128.f) + EPS);
    bf16* yrow = YCAT + (rb + qw + r32) * 1024 + 512 + h * 128;
#pragma unroll
    for (int d0 = 0; d0 < 4; ++d0)
#pragma unroll
        for (int g = 0; g < 4; ++g) { const int dv = 32 * d0 + 8 * g + 4 * hi; const f32x4 gg = *(const f32x4*)(F.in[7] + dv);
            v2u w; w.x = cvtpk(o[d0][4 * g] * rstd * gg[0], o[d0][4 * g + 1] * rstd * gg[1]); w.y = cvtpk(o[d0][4 * g + 2] * rstd * gg[2], o[d0][4 * g + 3] * rstd * gg[3]);
            *(v2u*)(yrow + dv) = w; }
}

template <int VAR>
__device__ __forceinline__ void ret_unit(Frame& F, int b, int h, int qb, bf16* YCAT) {
    const int lane = F.lane, r32 = lane & 31, hi = lane >> 5, wave = F.wave, half = wave >> 2;
    const size_t rb = (size_t)b * SEQ; const int qw = qb * 256 + wave * 32;
    const bf16* RQ = (const bf16*)(F.ws + WS_RQ); const bf16* RK = (const bf16*)(F.ws + WS_RK); const bf16* RV = (const bf16*)(F.ws + WS_RV); const bf16* RG = (const bf16*)(F.ws + WS_RG);
    float l2f, l2b;
    { const float xf = __builtin_amdgcn_exp2f(-5.0f - (float)h); l2f = ln1m(xf) * LOG2E; l2b = ln1m(xf * 0.70710678118654752f) * LOG2E; }
    bf16x8 qr[8];
#pragma unroll
    for (int ks = 0; ks < 8; ++ks) qr[ks] = *(const bf16x8*)(RQ + (rb + qw + r32) * 512 + h * 128 + ks * 16 + hi * 8);
    const bf16* ksrc = RK + (rb + lane) * 512 + h * 128 + wave * 8;
    const bf16* vsrc0 = RV + (rb + ((2 * wave) & 3) * 16 + (lane >> 2)) * 512 + h * 128 + ((2 * wave) >> 2) * 32 + (lane & 3) * 8;
    const bf16* vsrc1 = RV + (rb + ((2 * wave + 1) & 3) * 16 + (lane >> 2)) * 512 + h * 128 + ((2 * wave + 1) >> 2) * 32 + (lane & 3) * 8;
    const lds_cptr L = (lds_cptr)F.lds;
    const int kfo = hi * 1024 + r32 * 16;
    const int vfo = ST_V + ((lane >> 4) & 1) * 32 + (lane & 3) * 8 + (4 * hi + ((lane & 15) >> 2)) * 64;
#define RET_DMA(u) do { const int so_ = ((u) % 3) * ST_BYTES; const size_t o_ = (size_t)(u) * 64 * 512; \
        glds(ksrc + o_, F.lds + so_ + wave * 1024); glds(ksrc + o_ + 64, F.lds + so_ + 8192 + wave * 1024); \
        glds(vsrc0 + o_, F.lds + so_ + ST_V + wave * 2048); glds(vsrc1 + o_, F.lds + so_ + ST_V + wave * 2048 + 1024); } while (0)
    constexpr int T = 32;
#pragma unroll
    for (int ks = 0; ks < 8; ++ks) asm volatile("" : "+v"(qr[ks]));
    __syncthreads();
    RET_DMA(0); RET_DMA(1);
    MX_WAITBAR(0);
    f32x16 o[4]; o[0] = f32x16{}; o[1] = f32x16{}; o[2] = f32x16{}; o[3] = f32x16{};
    bf16x8 pw[4];
    const float nl2f = -l2f, nl2b = -l2b;
    if (half) MX_WAITBAR(0);
    for (int t = 0; t < T; ++t) {
        const lds_cptr stg = L + (t % 3) * ST_BYTES;
        if (!(VAR & 8) && half && t + 2 < T) RET_DMA(t + 2);
        {
            f32x16 a0, a1; const f32x16 zero16 = {};
            if (VAR & 4) { a0 = splat16((float)t); a1 = splat16((float)(t + 1)); } else
            { bf16x8 ka[8], kb_[8]; kload<8>(ka, stg + kfo); kload<8>(kb_, stg + kfo + 512); MX_SB(); kmma<8>(a0, zero16, ka, qr); kmma<8>(a1, zero16, kb_, qr); MX_SB(); }
            const int kt = t * 64;
            const float e0 = (float)(qw + r32 - kt - 4 * hi);
            if (VAR & 1) { } else if (kt + 63 <= qw) {
                const float bl = e0 * l2f;
#pragma unroll
                for (int r = 0; r < 16; ++r) { const float cr = (float)((r & 3) + 8 * (r >> 2)); a0[r] *= __builtin_amdgcn_exp2f(__builtin_fmaf(cr, nl2f, bl)); a1[r] *= __builtin_amdgcn_exp2f(__builtin_fmaf(cr + 32.f, nl2f, bl)); }
            } else if (kt > qw + 31) {
                const float bl = -e0 * l2b;
#pragma unroll
                for (int r = 0; r < 16; ++r) { const float cr = (float)((r & 3) + 8 * (r >> 2)); a0[r] *= __builtin_amdgcn_exp2f(__builtin_fmaf(cr, l2b, bl)); a1[r] *= __builtin_amdgcn_exp2f(__builtin_fmaf(cr + 32.f, l2b, bl)); }
            } else {
#pragma unroll
                for (int r = 0; r < 16; ++r) { const float cr = (float)((r & 3) + 8 * (r >> 2)); const float d0 = e0 - cr, d1 = e0 - cr - 32.f;
                    a0[r] *= __builtin_amdgcn_exp2f(fminf(d0 * l2f, d0 * nl2b)); a1[r] *= __builtin_amdgcn_exp2f(fminf(d1 * l2f, d1 * nl2b)); }
            }
            pw[0] = packp(a0, 0); pw[1] = packp(a0, 1); pw[2] = packp(a1, 0); pw[3] = packp(a1, 1);
        }
        if (t + 2 < T) MX_WAITBAR(4); else MX_WAITBAR(0);
        if (!(VAR & 8) && !half && t + 2 < T) RET_DMA(t + 2);
        if (!(VAR & 2)) pv(o, stg + vfo, pw);
        if (t + 2 < T) MX_WAITBAR(4); else MX_WAITBAR(0);
    }
    if (!half) MX_WAITBAR(0);
#undef RET_DMA
    float sm = 0.f;
#pragma unroll
    for (int d0 = 0; d0 < 4; ++d0)
#pragma unroll
        for (int r = 0; r < 16; ++r) sm += o[d0][r];
    sm += __shfl_xor(sm, 32);
    const float mean = sm * (1.f / 128.f); float q = 0.f;
#pragma unroll
    for (int d0 = 0; d0 < 4; ++d0)
#pragma unroll
        for (int r = 0; r < 16; ++r) { o[d0][r] -= mean; q += o[d0][r] * o[d0][r]; }
    q += __shfl_xor(q, 32);
    const float rstd = 1.0f / sqrtf(q * (1.f / 128.f) + EPS);
    const size_t row = rb + qw + r32;
#pragma unroll
    for (int d0 = 0; d0 < 4; ++d0)
#pragma unroll
        for (int g = 0; g < 4; ++g) { const int dv = 32 * d0 + 8 * g + 4 * hi; const f32x4 gg = *(const f32x4*)(F.in[6] + h * 128 + dv); const v2u gw = *(const v2u*)(RG + row * 512 + h * 128 + dv);
            v2u w; w.x = cvtpk(o[d0][4 * g] * rstd * gg[0] * bf2f_lo(gw.x), o[d0][4 * g + 1] * rstd * gg[1] * bf2f_hi(gw.x));
            w.y = cvtpk(o[d0][4 * g + 2] * rstd * gg[2] * bf2f_lo(gw.y), o[d0][4 * g + 3] * rstd * gg[3] * bf2f_hi(gw.y));
            *(v2u*)(YCAT + row * 1024 + h * 128 + dv) = w; }
    __syncthreads();
}

constexpr int CH = 128;
__device__ __forceinline__ void ret_state_job(Frame& F, int job, bf16* ST) {
    const int lane = F.lane, hi = lane >> 5, wave = F.wave, tid = F.tid;
    const int bh = job >> 3, dir = (job >> 2) & 1, dvq = job & 3, b = bh >> 2, h = bh & 3;
    const size_t rb = (size_t)b * SEQ;
    const bf16* RK = (const bf16*)(F.ws + WS_RK); const bf16* RV = (const bf16*)(F.ws + WS_RV);
    float l2g; { const float xf = __builtin_amdgcn_exp2f(-5.0f - (float)h); l2g = dir ? ln1m(xf * 0.70710678118654752f) * LOG2E : ln1m(xf) * LOG2E; }
    const float cdec = __builtin_amdgcn_exp2f(128.f * l2g);
    constexpr int SB_ = 40960, DEC_OFF = 3 * SB_;
    __syncthreads();
    if (tid < 128) ((LAS float*)(F.lds + DEC_OFF))[tid] = __builtin_amdgcn_exp2f((dir ? (float)tid : (float)(127 - tid)) * l2g);
    auto chunk_of = [&](int i) { return dir ? (15 - i) : i; };
#define ST_DMA(i) do { const int so_ = ((i) % 3) * SB_; const size_t o_ = (size_t)chunk_of(i) * CH * 512; \
        _Pragma("unroll") for (int j_ = 0; j_ < 4; ++j_) { const int blk_ = wave * 4 + j_, d0_ = blk_ >> 3, rg_ = blk_ & 7; \
            glds(RK + o_ + (rb + rg_ * 16 + (lane >> 2)) * 512 + h * 128 + d0_ * 32 + (lane & 3) * 8, F.lds + so_ + blk_ * 1024); } \
        glds(RV + o_ + (rb + wave * 16 + (lane >> 2)) * 512 + h * 128 + dvq * 32 + (lane & 3) * 8, F.lds + so_ + 32768 + wave * 1024); } while (0)
    ST_DMA(0); ST_DMA(1);
    MX_WAITBAR(0);
    const lds_cptr L = (lds_cptr)F.lds;
    const int trp = ((lane >> 4) & 1) * 32 + (lane & 3) * 8 + (4 * hi + ((lane & 15) >> 2)) * 64;
    const LAS float* dec = (const LAS float*)(F.lds + DEC_OFF) + 4 * hi;
    f32x16 acc = {};
    for (int i = 0; i < 16; ++i) {
        const int st = (i % 3) * SB_;
        if (i + 2 < 16) ST_DMA(i + 2);
        if (wave < 4) {
            const int n = chunk_of(i);
            bf16* sp = ST + ((size_t)((dir * 32 + bh) * 16 + n) * 128 + dvq * 32 + (lane & 31)) * 128 + wave * 32 + 4 * hi;
#pragma unroll
            for (int g = 0; g < 4; ++g) { v2u w; w.x = cvtpk(acc[4 * g], acc[4 * g + 1]); w.y = cvtpk(acc[4 * g + 2], acc[4 * g + 3]); *(v2u*)(sp + 8 * g) = w; }
#pragma unroll
            for (int r = 0; r < 16; ++r) acc[r] *= cdec;
            s16x4 kl[8], kh[8], vl[8], vh[8]; f32x4 dl[8], dh_[8];
#pragma unroll
            for (int ks = 0; ks < 8; ++ks) { const lds_cptr kp = L + st + (wave * 8 + ks) * 1024 + trp, vp = L + st + 32768 + ks * 1024 + trp;
                kl[ks] = vtr(kp); kh[ks] = vtr(kp + 512); vl[ks] = vtr(vp); vh[ks] = vtr(vp + 512);
                dl[ks] = *(const LAS f32x4*)(dec + 16 * ks); dh_[ks] = *(const LAS f32x4*)(dec + 16 * ks + 8); }
            MX_SB();
#pragma unroll
            for (int ks = 0; ks < 8; ++ks) {
                const bf16x8 kf = (bf16x8){kl[ks][0], kl[ks][1], kl[ks][2], kl[ks][3], kh[ks][0], kh[ks][1], kh[ks][2], kh[ks][3]};
                const v2u ul = __builtin_bit_cast(v2u, vl[ks]), uh = __builtin_bit_cast(v2u, vh[ks]); v4u w;
                w.x = cvtpk(bf2f_lo(ul.x) * dl[ks][0], bf2f_hi(ul.x) * dl[ks][1]); w.y = cvtpk(bf2f_lo(ul.y) * dl[ks][2], bf2f_hi(ul.y) * dl[ks][3]);
                w.z = cvtpk(bf2f_lo(uh.x) * dh_[ks][0], bf2f_hi(uh.x) * dh_[ks][1]); w.w = cvtpk(bf2f_lo(uh.y) * dh_[ks][2], bf2f_hi(uh.y) * dh_[ks][3]);
                acc = __builtin_amdgcn_mfma_f32_32x32x16_bf16(kf, __builtin_bit_cast(bf16x8, w), acc, 0, 0, 0);
            }
        }
        if (i + 2 < 16) MX_WAITBAR(5); else MX_WAITBAR(0);
    }
#undef ST_DMA
    __syncthreads();
}
__device__ __forceinline__ bf16x8 scale8(const bf16x8& q, float s) {
    const v4u u = __builtin_bit_cast(v4u, q); v4u w;
    w.x = cvtpk(bf2f_lo(u.x) * s, bf2f_hi(u.x) * s); w.y = cvtpk(bf2f_lo(u.y) * s, bf2f_hi(u.y) * s); w.z = cvtpk(bf2f_lo(u.z) * s, bf2f_hi(u.z) * s); w.w = cvtpk(bf2f_lo(u.w) * s, bf2f_hi(u.w) * s);
    return __builtin_bit_cast(bf16x8, w);
}
__device__ __forceinline__ void ret_out_unit(Frame& F, int b, int h, int m, const bf16* ST, bf16* YCAT) {
    const int lane = F.lane, r32 = lane & 31, hi = lane >> 5, wave = F.wave, rbk = wave & 3, dh = wave >> 2;
    const size_t rb = (size_t)b * SEQ; const int bh = b * 4 + h; const int row0 = m * CH;
    const bf16* RQ = (const bf16*)(F.ws + WS_RQ); const bf16* RK = (const bf16*)(F.ws + WS_RK); const bf16* RV = (const bf16*)(F.ws + WS_RV); const bf16* RG = (const bf16*)(F.ws + WS_RG);
    float l2f, l2b;
    { const float xf = __builtin_amdgcn_exp2f(-5.0f - (float)h); l2f = ln1m(xf) * LOG2E; l2b = ln1m(xf * 0.70710678118654752f) * LOG2E; }
    const int il = rbk * 32 + r32;
    bf16x8 qr[8];
#pragma unroll
    for (int ks = 0; ks < 8; ++ks) qr[ks] = *(const bf16x8*)(RQ + (rb + row0 + il) * 512 + h * 128 + ks * 16 + hi * 8);
#pragma unroll
    for (int ks = 0; ks < 8; ++ks) asm volatile("" : "+v"(qr[ks]));
    const bf16* sfp = ST + (size_t)((0 * 32 + bh) * 16 + m) * 128 * 128; const bf16* sbp = ST + (size_t)((1 * 32 + bh) * 16 + m) * 128 * 128;
    __syncthreads();
#pragma unroll
    for (int i = 0; i < 4; ++i) { const int pc = wave * 4 + i, c = pc >> 1, hf = pc & 1;
        glds(RK + (rb + row0 + hf * 64 + lane) * 512 + h * 128 + c * 8, F.lds + c * 2048 + hf * 1024);
        glds(sfp + (size_t)(hf * 64 + lane) * 128 + c * 8, F.lds + 65536 + c * 2048 + hf * 1024);
        glds(sbp + (size_t)(hf * 64 + lane) * 128 + c * 8, F.lds + 98304 + c * 2048 + hf * 1024);
        const int blk = wave * 4 + i, d0 = blk >> 3, rg = blk & 7;
        glds(RV + (rb + row0 + rg * 16 + (lane >> 2)) * 512 + h * 128 + d0 * 32 + (lane & 3) * 8, F.lds + 32768 + blk * 1024); }
    MX_WAITBAR(0);
    const lds_cptr L = (lds_cptr)F.lds;
    const int kfo = hi * 2048 + r32 * 16;
    const int trp = ((lane >> 4) & 1) * 32 + (lane & 3) * 8 + (4 * hi + ((lane & 15) >> 2)) * 64;
    f32x16 o[2]; o[0] = f32x16{}; o[1] = f32x16{};
    const f32x16 zero16 = {};
    const float nl2b = -l2b;
#pragma unroll
    for (int t = 0; t < 2; ++t) {
        f32x16 a0, a1;
        { bf16x8 ka[8], kb_[8];
#pragma unroll
          for (int ks = 0; ks < 8; ++ks) { ka[ks] = *(const LAS bf16x8*)(L + kfo + ks * 4096 + (2 * t) * 512); kb_[ks] = *(const LAS bf16x8*)(L + kfo + ks * 4096 + (2 * t + 1) * 512); }
          kmma<8>(a0, zero16, ka, qr); kmma<8>(a1, zero16, kb_, qr); }
        const float e0 = (float)(il - 64 * t - 4 * hi);
#pragma unroll
        for (int r = 0; r < 16; ++r) { const float cr = (float)((r & 3) + 8 * (r >> 2)); const float d0 = e0 - cr, d1 = e0 - cr - 32.f;
            a0[r] *= __builtin_amdgcn_exp2f(fminf(d0 * l2f, d0 * nl2b)); a1[r] *= __builtin_amdgcn_exp2f(fminf(d1 * l2f, d1 * nl2b)); }
        bf16x8 pw[4]; pw[0] = packp(a0, 0); pw[1] = packp(a0, 1); pw[2] = packp(a1, 0); pw[3] = packp(a1, 1);
#pragma unroll
        for (int dd = 0; dd < 2; ++dd)
#pragma unroll
            for (int kk = 0; kk < 4; ++kk) { const lds_cptr vp = L + 32768 + ((2 * dh + dd) * 8 + 4 * t + kk) * 1024 + trp; const s16x4 lo = vtr(vp), hh = vtr(vp + 512);
                const bf16x8 vf = (bf16x8){lo[0], lo[1], lo[2], lo[3], hh[0], hh[1], hh[2], hh[3]};
                o[dd] = __builtin_amdgcn_mfma_f32_32x32x16_bf16(vf, pw[kk], o[dd], 0, 0, 0); }
    }
    { const float sf = __builtin_amdgcn_exp2f((float)(il + 1) * l2f), sb = __builtin_amdgcn_exp2f((float)(CH - il) * l2b);
#pragma unroll
      for (int ks = 0; ks < 8; ++ks) { const bf16x8 qf = scale8(qr[ks], sf), qb = scale8(qr[ks], sb);
#pragma unroll
          for (int dd = 0; dd < 2; ++dd) { const int off = kfo + ks * 4096 + (2 * dh + dd) * 512;
              o[dd] = __builtin_amdgcn_mfma_f32_32x32x16_bf16(*(const LAS bf16x8*)(L + 65536 + off), qf, o[dd], 0, 0, 0);
              o[dd] = __builtin_amdgcn_mfma_f32_32x32x16_bf16(*(const LAS bf16x8*)(L + 98304 + off), qb, o[dd], 0, 0, 0); } } }
    float s = 0.f, ss = 0.f;
#pragma unroll
    for (int dd = 0; dd < 2; ++dd)
#pragma unroll
        for (int r = 0; r < 16; ++r) { s += o[dd][r]; ss += o[dd][r] * o[dd][r]; }
    s += __shfl_xor(s, 32); ss += __shfl_xor(ss, 32);
    LAS float* ex = (LAS float*)(F.lds + QS_OFF);
    if (hi == 0) { ex[(wave * 32 + r32) * 2] = s; ex[(wave * 32 + r32) * 2 + 1] = ss; }
    __syncthreads();
    { const int pw_ = wave ^ 4; s += ex[(pw_ * 32 + r32) * 2]; ss += ex[(pw_ * 32 + r32) * 2 + 1]; }
    const float mean = s * (1.f / 128.f); const float var = fmaxf(ss * (1.f / 128.f) - mean * mean, 0.f); const float rstd = 1.0f / sqrtf(var + EPS);
    const size_t row = rb + row0 + il;
#pragma unroll
    for (int dd = 0; dd < 2; ++dd)
#pragma unroll
        for (int g = 0; g < 4; ++g) { const int dv = 32 * (2 * dh + dd) + 8 * g + 4 * hi; const f32x4 gg = *(const f32x4*)(F.in[6] + h * 128 + dv); const v2u gw = *(const v2u*)(RG + row * 512 + h * 128 + dv);
            v2u w; w.x = cvtpk((o[dd][4 * g] - mean) * rstd * gg[0] * bf2f_lo(gw.x), (o[dd][4 * g + 1] - mean) * rstd * gg[1] * bf2f_hi(gw.x));
            w.y = cvtpk((o[dd][4 * g + 2] - mean) * rstd * gg[2] * bf2f_lo(gw.y), (o[dd][4 * g + 3] - mean) * rstd * gg[3] * bf2f_hi(gw.y));
            *(v2u*)(YCAT + row * 1024 + h * 128 + dv) = w; }
    __syncthreads();
}
#undef MX_WAITBAR
#undef MX_SB
}
#ifndef RET_CHUNKED
#define RET_CHUNKED 1
#endif
#ifndef MIX_FAST
#define MIX_FAST 3
#endif
#ifndef MK_PER_PHASE
#define MK_PER_PHASE 0
#endif
constexpr int N_PHASES = 12;
struct Args { const float* in[22]; float* out; unsigned char* ws; int ph_lo, ph_hi; };
__global__ void __launch_bounds__(NWAVES * 64, 2) fwd_kernel(Args args) {
    extern __shared__ __attribute__((aligned(16))) unsigned char lds[];
    Frame F;
    F.lds = (LAS unsigned char*)lds;
    F.MISC = (volatile LAS unsigned*)(F.lds + MISC_OFF);
    F.tid = threadIdx.x; F.lane = F.tid & 63; F.wave = __builtin_amdgcn_readfirstlane(F.tid >> 6);
    F.G = gridDim.x; { const int bx = blockIdx.x; F.vcu = (F.G % 8 == 0) ? (bx % 8) * (F.G / 8) + bx / 8 : bx; }
    F.ws = args.ws; F.out = args.out; F.ctl = (gu32*)(args.ws + WS_CTL);
#pragma unroll
    for (int i = 0; i < 22; ++i) F.in[i] = args.in[i];
    for (int u = F.tid; u < (LDS_BYTES - LDSCTL_OFF) / 4; u += NWAVES * 64) ((LAS unsigned*)(F.lds + LDSCTL_OFF))[u] = 0u;
    __syncthreads();
    XcdBarrier bar; bar.bar = (unsigned*)(F.ctl + CW_BAR); bar.x = 0; bar.st = nullptr;
    if (!MK_PER_PHASE) bar = xcd_barrier_post((unsigned*)(F.ctl + CW_BAR), F.MISC + 8);
    const int lo = args.ph_lo, hi = args.ph_hi;
#ifndef PHASE_MASK
#define PHASE_MASK 0xfff
#endif
#define IN(k) (((PHASE_MASK >> (k)) & 1) && lo <= (k) && (k) < hi)
#define GRID_BAR(k) do { if (IN(k) && IN((k) + 1)) xcd_barrier(bar); } while (0)
#ifndef DUP_MASK
#define DUP_MASK 0
#endif
#define REP(k) _Pragma("unroll") for (int rep_ = 0; rep_ < 1 + ((DUP_MASK >> (k)) & 1); ++rep_)
    unsigned char* ws = args.ws;
    bf16* XN = (bf16*)args.out;
    bf16* YCAT = (bf16*)args.out;
    float* X1 = args.out;
    const float* MOD = (const float*)(ws + WS_MOD);

    if (IN(0)) REP(0) { p0_prologue(F); }
    GRID_BAR(0);
    if (IN(1)) REP(1) { p1_norm(F, XN); }
    GRID_BAR(1);
    if (IN(2)) REP(2) {
        pg8::Gemm g{XN, (const bf16*)(ws + WS_WIN), M, NIN, D, D, D, 1 << 30, 0};
        pg8::StaticOrder S; S.init(M, NIN, F.G, (int)blockIdx.x);
        pg8::EpiProj E{(bf16*)ws, (const float*)(ws + WS_CS), WS_RQ / 2, WS_RK / 2, WS_RV / 2, WS_RG / 2, WS_DQ1 / 2, WS_DV / 2, WS_GR / 2, WS_GD / 2};
        pg8::gemm_phase<pg8::EpiProj, pg8::StaticOrder, true, true>(F.lds + RING_OFF, g, S, E);
        p0_tail_items(F);
    }
    GRID_BAR(2);
    if (IN(3)) REP(3) {
        float lam;
        { float a = F.lane < 64 ? F.in[8][F.lane] * F.in[9][F.lane] : 0.f, c = F.in[10][F.lane] * F.in[11][F.lane];
          lam = __expf(wave_sum(a)) - __expf(wave_sum(c)) + 0.2f; }
        p3_items(F);
#if RET_CHUNKED
        { bf16* ST = (bf16*)args.out + (size_t)M * 1024; for (int j = F.vcu; j < 256; j += F.G) mx::ret_state_job(F, j, ST); }
        VM_WAIT(); __syncthreads();
        if (F.tid == 0) { __builtin_amdgcn_fence(__ATOMIC_RELEASE, "agent"); VM_WAIT(); __hip_atomic_fetch_add((unsigned*)(F.ctl + CW_RET), 1u, RLX_AGENT); }
#endif
#if (MIX_FAST & 1)
        { const int u = F.vcu; if (u < 256) mx::diff_unit<0>(F, u >> 5, (u >> 3) & 3, u & 7, lam, YCAT); }
#ifdef DIFF_VAR
        { const int u = F.vcu; if (u < 256) mx::diff_unit<DIFF_VAR>(F, u >> 5, (u >> 3) & 3, u & 7, lam, YCAT + (size_t)M * 1024); }
#endif
#else
        for (int u = F.vcu; u < 8192; u += F.G) naive_unit<1>(F, u, lam, YCAT);
#endif
#if (MIX_FAST & 2)
#if RET_CHUNKED
        { bf16* ST = (bf16*)args.out + (size_t)M * 1024;
          if (F.tid == 0) { unsigned sp_ = 0; const unsigned want = (unsigned)(F.G < 256 ? F.G : 256);
              while (__hip_atomic_load((unsigned*)(F.ctl + CW_RET), RLX_AGENT) < want) { __builtin_amdgcn_s_sleep(2); if (++sp_ > (1u << 22)) { __hip_atomic_store((unsigned*)(F.ctl + CW_TMO), 1u, RLX_AGENT); break; } }
              __builtin_amdgcn_fence(__ATOMIC_ACQUIRE, "agent"); VM_WAIT(); }
          __syncthreads();
          for (int u = F.vcu; u < 512; u += F.G) mx::ret_out_unit(F, u >> 6, (u >> 4) & 3, u & 15, ST, YCAT); }
#else
        { const int u = F.vcu; if (u < 256) mx::ret_unit<0>(F, u >> 5, (u >> 3) & 3, u & 7, YCAT); }
#endif
#else
        for (int u = F.vcu; u < 8192; u += F.G) naive_unit<0>(F, u, lam, YCAT);
#endif
    }
    GRID_BAR(3);
    if (IN(4)) REP(4) {
        pg8::Gemm g{YCAT, (const bf16*)(ws + WS_WCAT), M, D, D, D, D, 1 << 30, 0};
        pg8::StaticOrder S; S.init(M, D, F.G, (int)blockIdx.x);
        pg8::EpiGate2 E{(bf16*)(ws + WS_MERGED), (const bf16*)(ws + WS_GR), (const bf16*)(ws + WS_GD), D};
        pg8::gemm_phase<pg8::EpiGate2, pg8::StaticOrder, true, true>(F.lds + RING_OFF, g, S, E);
    }
    GRID_BAR(5);
    if (IN(6)) REP(6) {
        pg8::Gemm g{(const bf16*)(ws + WS_MERGED), (const bf16*)(ws + WS_WO), M, D, D, D, D, 1 << 30, 0};
        pg8::StaticOrder S; S.init(M, D, F.G, (int)blockIdx.x);
        pg8::EpiResidB E{(bf16*)(ws + WS_X1), F.in[0], MOD + 2048, D, 6144};
        pg8::gemm_phase<pg8::EpiResidB, pg8::StaticOrder, true, true>(F.lds + RING_OFF, g, S, E);
    }
    GRID_BAR(6);
    if (IN(7)) REP(7) { p7_router(F, (const bf16*)(ws + WS_X1), ws + WS_H2, (float*)(ws + WS_AFF)); }
    GRID_BAR(7);
    if (IN(8)) REP(8) { p8_topk(F, (const float*)(ws + WS_AFF), (int*)(ws + WS_SELG + 131072), (float*)(ws + WS_SELG), (int*)(ws + WS_INV)); }
    GRID_BAR(8);
    if (IN(9)) REP(9) {
        pg8::Gemm g{(const bf16*)(ws + WS_H2), (const bf16*)(ws + WS_WGU), MS, 2048, 512, 512, 512, 8, (size_t)2048 * 1024, (const int*)(ws + WS_SELG + 131072)};
        pg8::StaticOrder S; S.init(MS, 2048, F.G, (int)blockIdx.x);
        pg8::EpiSwiGLU8 E{ws + WS_ACT, D};
        pg8::gemm_phase<pg8::EpiSwiGLU8, pg8::StaticOrder, true, true>(F.lds + RING_OFF, g, S, E);
    }
    GRID_BAR(9);
    if (IN(10)) REP(10) {
        pg8::Gemm g{(const bf16*)(ws + WS_ACT), (const bf16*)(ws + WS_WD), MS, D, 512, 512, 512, 8, (size_t)1024 * 1024};
        pg8::StaticOrder S; S.init(MS, D, F.G, (int)blockIdx.x);
        pg8::EpiRowScale8 E{ws + WS_YS, (const float*)(ws + WS_SELG), D};
        pg8::gemm_phase<pg8::EpiRowScale8, pg8::StaticOrder, true, true>(F.lds + RING_OFF, g, S, E);
    }
    GRID_BAR(10);
#ifdef EXTRA_BARS
#pragma unroll 1
    for (int xb = 0; xb < EXTRA_BARS; ++xb) xcd_barrier(bar);
#endif
    if (IN(11)) { p11_final(F, (const bf16*)(ws + WS_X1), ws + WS_YS, (const int*)(ws + WS_INV)); }
#undef IN
#undef GRID_BAR
}

extern "C" void kernel_launch(void* const* d_in, const int* in_sizes, int n_in, void* d_out, int out_size, void* d_ws, size_t ws_size, hipStream_t stream) {
    static int grid = 0;
    if (grid == 0) {
        if (n_in != 22 || in_sizes[0] != M * D || out_size != M * D || ws_size < WS_END) { fprintf(stderr, "kernel_launch: unexpected problem (n_in %d, out %d, ws %zu); nothing launched\n", n_in, out_size, ws_size); grid = -1; return; }
        int dev = 0, cus = 0, per_cu = 0;
        if (hipGetDevice(&dev) != hipSuccess || hipDeviceGetAttribute(&cus, hipDeviceAttributeMultiprocessorCount, dev) != hipSuccess) { grid = -1; return; }
        if (hipFuncSetAttribute((const void*)fwd_kernel, hipFuncAttributeMaxDynamicSharedMemorySize, LDS_BYTES) != hipSuccess) { fprintf(stderr, "kernel_launch: hipFuncSetAttribute failed\n"); grid = -1; return; }
        if (hipOccupancyMaxActiveBlocksPerMultiprocessor(&per_cu, (const void*)fwd_kernel, NWAVES * 64, LDS_BYTES) != hipSuccess || per_cu < 1) { fprintf(stderr, "kernel_launch: occupancy query reports %d\n", per_cu); }
        (void)hipGetLastError();
        grid = cus;
        if (cus != 256) { fprintf(stderr, "kernel_launch: this kernel's unit deal is built for the 256 CUs of an MI355X (device reports %d); nothing launched\n", cus); grid = -1; return; }
    }
    if (grid < 0) return;
    if (hipMemsetAsync((char*)d_ws + WS_CTL, 0, CTL_ZERO_BYTES, stream) != hipSuccess) return;
    Args a{};
    for (int i = 0; i < 22; ++i) a.in[i] = (const float*)d_in[i];
    a.out = (float*)d_out; a.ws = (unsigned char*)d_ws;
#if MK_PER_PHASE
    for (int p = 0; p < N_PHASES; ++p) { a.ph_lo = p; a.ph_hi = p + 1; hipLaunchKernelGGL(fwd_kernel, dim3(grid), dim3(NWAVES * 64), LDS_BYTES, stream, a); }
#else
    a.ph_lo = 0; a.ph_hi = N_PHASES;
    hipLaunchKernelGGL(fwd_kernel, dim3(grid), dim3(NWAVES * 64), LDS_BYTES, stream, a);
#endif
}
```

```cpp
#include <hip/hip_runtime.h>
#include <cstdio>
#include <cstdint>
namespace pg8 {
#define PG8_LAS __attribute__((address_space(3)))
typedef unsigned short bf16_t;
typedef short bf16x8 __attribute__((ext_vector_type(8)));
typedef float f32x4 __attribute__((ext_vector_type(4)));
typedef unsigned u32x4 __attribute__((ext_vector_type(4)));
typedef int v4i_t __attribute__((ext_vector_type(4)));
typedef int v8i_t __attribute__((ext_vector_type(8)));
constexpr int BM = 256, BK = 64, HALF = 128, HTB = HALF * BK * 2  , STAGE_BYTES = 8 * HTB, NXCD = 8, WGM = 8;

__host__ __device__ __forceinline__ int lds_byte(int r, int c) { const int st = (r >> 4) * 2 + (c >> 5), rr = r & 15, cc = c & 31, ob = rr * 64 + cc * 2; return st * 1024 + (ob ^ (((ob >> 9) & 1) << 5)); }
__host__ __device__ __forceinline__ void stage_rc(int b, int& R, int& C) { const int st = b / 1024, sb = b % 1024, swz = sb ^ (((sb >> 9) & 1) << 5); R = (st >> 1) * 16 + swz / 64; C = (st & 1) * 32 + (swz % 64) / 2; }
__host__ __device__ __forceinline__ int perm32(int rho) { const int n = rho >> 4, i = rho & 15; return 8 * (i >> 2) + 4 * n + (i & 3); }

struct Unit { int pm, pn; };
struct Gemm { const bf16_t* A; const bf16_t* Bt; int M, N, K, lda, ldb, gdiv; size_t gstride; const int* gidx; };
typedef unsigned u32x2 __attribute__((ext_vector_type(2)));
__device__ __forceinline__ unsigned cvt_pk_bf16(float lo, float hi) { unsigned r; asm volatile("v_cvt_pk_bf16_f32 %0, %1, %2" : "=v"(r) : "v"(lo), "v"(hi)); return r; }
__device__ __forceinline__ float bflo(unsigned w) { return __builtin_bit_cast(float, w << 16); }
__device__ __forceinline__ float bfhi(unsigned w) { return __builtin_bit_cast(float, w & 0xffff0000u); }
__device__ __forceinline__ float sigmoidf_(float v) { return __builtin_amdgcn_rcpf(1.0f + __builtin_amdgcn_exp2f(-1.4426950408889634f * v)); }
__device__ __forceinline__ u32x4 pack8(const f32x4& v0, const f32x4& v1) { u32x4 w; w.x = cvt_pk_bf16(v0[0], v0[1]); w.y = cvt_pk_bf16(v0[2], v0[3]); w.z = cvt_pk_bf16(v1[0], v1[1]); w.w = cvt_pk_bf16(v1[2], v1[3]); return w; }
__device__ __forceinline__ void unpack8(const u32x4& w, f32x4& v0, f32x4& v1) { v0 = (f32x4){bflo(w.x), bfhi(w.x), bflo(w.y), bfhi(w.y)}; v1 = (f32x4){bflo(w.z), bfhi(w.z), bflo(w.w), bfhi(w.w)}; }

__device__ __forceinline__ float clamp448(float v) { return __builtin_fminf(__builtin_fmaxf(v, -448.f), 448.f); }
__device__ __forceinline__ unsigned pk_fp8x4(float a, float b, float c, float d) { int w = 0; w = __builtin_amdgcn_cvt_pk_fp8_f32(clamp448(a), clamp448(b), w, false); w = __builtin_amdgcn_cvt_pk_fp8_f32(clamp448(c), clamp448(d), w, true); return (unsigned)w; }

template <bool F8> struct EpiProjT {
    static constexpr bool PERM = true, AFTER_DRAIN = false, MID = false, FP8 = F8, GATHER = false, PRE = false;
    bf16_t* base; const float* cs;
    size_t oRQ, oRK, oRV, oRG, oDQ1, oDV, oGR, oGD;
    __device__ __forceinline__ void operator()(const f32x4 (&acc)[2][2][4][2], const Unit& u, int wr, int wc, int fr, int fq) const {
        const int pn = u.pn; size_t off; int ldc, colt, mode; float sc = 1.f;
        if (pn < 2)       { off = oRQ; ldc = 512; colt = pn * 256; mode = 1; }
        else if (pn < 4)  { off = oRK; ldc = 512; colt = (pn - 2) * 256; mode = 1; sc = 0.08838834764831845f; }
        else if (pn < 6)  { off = oRV; ldc = 512; colt = (pn - 4) * 256; mode = 0; }
        else if (pn < 8)  { off = oRG; ldc = 512; colt = (pn - 6) * 256; mode = 2; }
        else if (pn < 12) { off = oDQ1 + (size_t)(pn - 8) * ((size_t)16384 * 256); ldc = 256; colt = 0; mode = 0; sc = (pn < 10) ? 0.18033688011112042f : 1.f; }
        else if (pn < 14) { off = oDV; ldc = 512; colt = (pn - 12) * 256; mode = 0; }
        else if (pn < 18) { off = oGR; ldc = 1024; colt = (pn - 14) * 256; mode = 3; }
        else              { off = oGD; ldc = 1024; colt = (pn - 18) * 256; mode = 3; }
        const int row0 = u.pm * BM + wr * 64 + fr, col0 = colt + wc * 32 + 8 * fq;
        const int i0 = wc * 16 + 4 * fq;
#pragma unroll
        for (int ai = 0; ai < 2; ++ai)
#pragma unroll
            for (int m = 0; m < 4; ++m) { const int row = row0 + ai * HALF + m * 16; bf16_t* rowp = base + off + (size_t)row * ldc + col0;
                f32x4 c01 = (f32x4){1.f, 0.f, 1.f, 0.f}, c23 = c01;
                if (mode == 1) { const f32x4* cp = (const f32x4*)(cs + ((size_t)(row & 2047) * 64 + i0) * 2); c01 = cp[0]; c23 = cp[1]; }
#pragma unroll
                for (int bj = 0; bj < 2; ++bj) { f32x4 v0 = acc[ai][bj][m][0], v1 = acc[ai][bj][m][1];
                    if (F8) { v0 = v0 * (1.f / 64.f); v1 = v1 * (1.f / 64.f); }
                    if (mode == 1) {
                        const f32x4 a = v0, b = v1;
                        v0 = (f32x4){a[0] * c01[0] - a[1] * c01[1], a[0] * c01[1] + a[1] * c01[0], a[2] * c01[2] - a[3] * c01[3], a[2] * c01[3] + a[3] * c01[2]};
                        v1 = (f32x4){b[0] * c23[0] - b[1] * c23[1], b[0] * c23[1] + b[1] * c23[0], b[2] * c23[2] - b[3] * c23[3], b[2] * c23[3] + b[3] * c23[2]};
                    } else if (mode == 2) {
#pragma unroll
                        for (int j = 0; j < 4; ++j) { v0[j] = v0[j] * sigmoidf_(v0[j]); v1[j] = v1[j] * sigmoidf_(v1[j]); }
                    } else if (mode == 3) {
#pragma unroll
                        for (int j = 0; j < 4; ++j) { v0[j] = sigmoidf_(v0[j]); v1[j] = sigmoidf_(v1[j]); }
                    }
                    v0 = v0 * sc; v1 = v1 * sc;
                    *(u32x4*)(rowp + bj * HALF) = pack8(v0, v1); } }
    }
};
typedef EpiProjT<false> EpiProj; typedef EpiProjT<true> EpiProj8;
struct EpiGate {
    static constexpr bool PERM = true, AFTER_DRAIN = false, MID = false, FP8 = false, GATHER = false, PRE = false;
    bf16_t* O; const bf16_t* G; const bf16_t* T; int ldc;
    __device__ __forceinline__ void operator()(const f32x4 (&acc)[2][2][4][2], const Unit& u, int wr, int wc, int fr, int fq) const {
        const int row0 = u.pm * BM + wr * 64 + fr, col0 = u.pn * BM + wc * 32 + 8 * fq;
#pragma unroll
        for (int ai = 0; ai < 2; ++ai)
#pragma unroll
            for (int m = 0; m < 4; ++m) { const size_t ro = (size_t)(row0 + ai * HALF + m * 16) * ldc + col0;
#pragma unroll
                for (int bj = 0; bj < 2; ++bj) { f32x4 g0, g1; unpack8(*(const u32x4*)(G + ro + bj * HALF), g0, g1);
                    f32x4 v0 = acc[ai][bj][m][0] * g0, v1 = acc[ai][bj][m][1] * g1;
                    if (T) { f32x4 t0, t1; unpack8(*(const u32x4*)(T + ro + bj * HALF), t0, t1); v0 = v0 + t0; v1 = v1 + t1; }
                    *(u32x4*)(O + ro + bj * HALF) = pack8(v0, v1); } }
    }
};
struct EpiGate2 {
    static constexpr bool PERM = true, AFTER_DRAIN = false, MID = true, FP8 = false, GATHER = false, PRE = false;
    bf16_t* O; const bf16_t* GR; const bf16_t* GD; int ldc;
    __device__ __forceinline__ void mid(f32x4 (&acc)[2][2][4][2], const Unit& u, int wr, int wc, int fr, int fq) const {
        int row0 = u.pm * BM + wr * 64 + fr; const int col0 = u.pn * BM + wc * 32 + 8 * fq; asm volatile("" : "+v"(row0));
#pragma unroll
        for (int ai = 0; ai < 2; ++ai) {
            u32x4 gr[4][2], gd[4][2];
#pragma unroll
            for (int m = 0; m < 4; ++m) { const size_t ro = (size_t)(row0 + ai * HALF + m * 16) * ldc + col0;
#pragma unroll
                for (int bj = 0; bj < 2; ++bj) { gr[m][bj] = __builtin_nontemporal_load((const u32x4*)(GR + ro + bj * HALF)); gd[m][bj] = *(const u32x4*)(GD + ro + bj * HALF); } }
#pragma unroll
            for (int m = 0; m < 4; ++m)
#pragma unroll
                for (int bj = 0; bj < 2; ++bj) { f32x4 r0, r1, d0, d1; unpack8(gr[m][bj], r0, r1); unpack8(gd[m][bj], d0, d1);
#pragma unroll
                    for (int j = 0; j < 4; ++j) { acc[ai][bj][m][0][j] *= r0[j] * __builtin_amdgcn_rcpf(d0[j]); acc[ai][bj][m][1][j] *= r1[j] * __builtin_amdgcn_rcpf(d1[j]); } }
            asm volatile("" ::: "memory");
        }
    }
    __device__ __forceinline__ void operator()(const f32x4 (&acc)[2][2][4][2], const Unit& u, int wr, int wc, int fr, int fq) const {
        int row0 = u.pm * BM + wr * 64 + fr; const int col0 = u.pn * BM + wc * 32 + 8 * fq; asm volatile("" : "+v"(row0));
        u32x4 gd[2][4][2];
#pragma unroll
        for (int ai = 0; ai < 2; ++ai)
#pragma unroll
            for (int m = 0; m < 4; ++m) { const size_t ro = (size_t)(row0 + ai * HALF + m * 16) * ldc + col0;
#pragma unroll
                for (int bj = 0; bj < 2; ++bj) gd[ai][m][bj] = __builtin_nontemporal_load((const u32x4*)(GD + ro + bj * HALF)); }
#pragma unroll
        for (int ai = 0; ai < 2; ++ai)
#pragma unroll
            for (int m = 0; m < 4; ++m) { const size_t ro = (size_t)(row0 + ai * HALF + m * 16) * ldc + col0;
#pragma unroll
                for (int bj = 0; bj < 2; ++bj) { f32x4 d0, d1; unpack8(gd[ai][m][bj], d0, d1);
                    *(u32x4*)(O + ro + bj * HALF) = pack8(acc[ai][bj][m][0] * d0, acc[ai][bj][m][1] * d1); } }
    }
};
struct EpiResid {
    static constexpr bool PERM = false, AFTER_DRAIN = false, MID = false, FP8 = false, GATHER = false, PRE = false;
    float* C; const float* base; const float* gate; int ldc, gpitch;
    __device__ __forceinline__ void operator()(const f32x4 (&acc)[2][2][4][2], const Unit& u, int wr, int wc, int fr, int fq) const {
        const int row0 = u.pm * BM + wr * 64 + fr, col0 = u.pn * BM + wc * 32 + 4 * fq;
        const float* gp = gate + (size_t)((u.pm * BM) >> 11) * gpitch + col0;
        f32x4 gv[2][2];
#pragma unroll
        for (int bj = 0; bj < 2; ++bj)
#pragma unroll
            for (int n = 0; n < 2; ++n) gv[bj][n] = *(const f32x4*)(gp + bj * HALF + n * 16);
#pragma unroll
        for (int ai = 0; ai < 2; ++ai)
#pragma unroll
            for (int m = 0; m < 4; ++m) { const size_t ro = (size_t)(row0 + ai * HALF + m * 16) * ldc + col0;
#pragma unroll
                for (int bj = 0; bj < 2; ++bj)
#pragma unroll
                    for (int n = 0; n < 2; ++n) *(f32x4*)(C + ro + bj * HALF + n * 16) = *(const f32x4*)(base + ro + bj * HALF + n * 16) + gv[bj][n] * acc[ai][bj][m][n]; }
    }
};
struct EpiSwiGLU {
    static constexpr bool PERM = false, AFTER_DRAIN = false, MID = false, FP8 = false, GATHER = false, PRE = false;
    bf16_t* O; int ldc;
    __device__ __forceinline__ void operator()(const f32x4 (&acc)[2][2][4][2], const Unit& u, int wr, int wc, int fr, int fq) const {
        const int row0 = u.pm * BM + wr * 64 + fr, col0 = u.pn * 128 + wc * 32 + 8 * fq;
#pragma unroll
        for (int ai = 0; ai < 2; ++ai)
#pragma unroll
            for (int m = 0; m < 4; ++m) { f32x4 o[2];
#pragma unroll
                for (int bj = 0; bj < 2; ++bj) { const f32x4 gt = acc[ai][bj][m][0], up = acc[ai][bj][m][1];
#pragma unroll
                    for (int j = 0; j < 4; ++j) o[bj][j] = gt[j] * sigmoidf_(gt[j]) * up[j]; }
                *(u32x4*)(O + (size_t)(row0 + ai * HALF + m * 16) * ldc + col0) = pack8(o[0], o[1]); }
    }
};
struct EpiRowScale {
    static constexpr bool PERM = true, AFTER_DRAIN = false, MID = false, FP8 = false, GATHER = false, PRE = false;
    bf16_t* O; const float* rs; int ldc;
    __device__ __forceinline__ void operator()(const f32x4 (&acc)[2][2][4][2], const Unit& u, int wr, int wc, int fr, int fq) const {
        const int row0 = u.pm * BM + wr * 64 + fr, col0 = u.pn * BM + wc * 32 + 8 * fq;
#pragma unroll
        for (int ai = 0; ai < 2; ++ai)
#pragma unroll
            for (int m = 0; m < 4; ++m) { const int row = row0 + ai * HALF + m * 16; const float s = rs[row];
#pragma unroll
                for (int bj = 0; bj < 2; ++bj) *(u32x4*)(O + (size_t)row * ldc + col0 + bj * HALF) = pack8(acc[ai][bj][m][0] * s, acc[ai][bj][m][1] * s); }
    }
};

constexpr float W8_SCALE = 64.f, ACT_SCALE = 16.f;
struct EpiSwiGLU8 {
    static constexpr bool PERM = false, AFTER_DRAIN = false, MID = false, FP8 = true, GATHER = true, PRE = false;
    unsigned char* O; int ldc;
    __device__ __forceinline__ void operator()(const f32x4 (&acc)[2][2][4][2], const Unit& u, int wr, int wc, int fr, int fq) const {
        const int row0 = u.pm * BM + wr * 64 + fr, col0 = u.pn * 128 + wc * 32 + 8 * fq;
#pragma unroll
        for (int ai = 0; ai < 2; ++ai)
#pragma unroll
            for (int m = 0; m < 4; ++m) { f32x4 o[2];
#pragma unroll
                for (int bj = 0; bj < 2; ++bj) { const f32x4 gt = acc[ai][bj][m][0] * (1.f / W8_SCALE), up = acc[ai][bj][m][1] * (ACT_SCALE / W8_SCALE);
#pragma unroll
                    for (int j = 0; j < 4; ++j) o[bj][j] = gt[j] * sigmoidf_(gt[j]) * up[j]; }
                u32x2 w; w.x = pk_fp8x4(o[0][0], o[0][1], o[0][2], o[0][3]); w.y = pk_fp8x4(o[1][0], o[1][1], o[1][2], o[1][3]);
                *(u32x2*)(O + (size_t)(row0 + ai * HALF + m * 16) * ldc + col0) = w; }
    }
};
constexpr float YS_SCALE = 64.f;
struct EpiRowScale8 {
    static constexpr bool PERM = true, AFTER_DRAIN = false, MID = false, FP8 = true, GATHER = false, PRE = true;
    unsigned char* O; const float* rs; int ldc;
    __device__ __forceinline__ void preload(const Unit& u, int wr, int fr, float (&pv)[8]) const {
        const float* rp = rs + u.pm * BM + wr * 64 + fr;
#pragma unroll
        for (int q = 0; q < 8; ++q) pv[q] = rp[(q >> 2) * HALF + (q & 3) * 16];
    }
    __device__ __forceinline__ void operator()(const f32x4 (&acc)[2][2][4][2], const Unit& u, int wr, int wc, int fr, int fq, const float (&pv)[8]) const {
        const int row0 = u.pm * BM + wr * 64 + fr, col0 = u.pn * BM + wc * 32 + 8 * fq;
#pragma unroll
        for (int ai = 0; ai < 2; ++ai)
#pragma unroll
            for (int m = 0; m < 4; ++m) { const int row = row0 + ai * HALF + m * 16; const float s = pv[ai * 4 + m] * (YS_SCALE / (ACT_SCALE * W8_SCALE));
#pragma unroll
                for (int bj = 0; bj < 2; ++bj) { const f32x4 v0 = acc[ai][bj][m][0] * s, v1 = acc[ai][bj][m][1] * s; u32x2 w; w.x = pk_fp8x4(v0[0], v0[1], v0[2], v0[3]); w.y = pk_fp8x4(v1[0], v1[1], v1[2], v1[3]);
                    *(u32x2*)(O + (size_t)row * ldc + col0 + bj * HALF) = w; } }
    }
};
struct EpiResidB {
    static constexpr bool PERM = true, AFTER_DRAIN = false, MID = false, FP8 = false, GATHER = false, PRE = false;
    bf16_t* C; const float* base; const float* gate; int ldc, gpitch;
    __device__ __forceinline__ void operator()(const f32x4 (&acc)[2][2][4][2], const Unit& u, int wr, int wc, int fr, int fq) const {
        const int row0 = u.pm * BM + wr * 64 + fr, col0 = u.pn * BM + wc * 32 + 8 * fq;
        const float* gp = gate + (size_t)((u.pm * BM) >> 11) * gpitch + col0;
        f32x4 gv[2][2];
#pragma unroll
        for (int bj = 0; bj < 2; ++bj)
#pragma unroll
            for (int n = 0; n < 2; ++n) gv[bj][n] = *(const f32x4*)(gp + bj * HALF + 4 * n);
#pragma unroll
        for (int ai = 0; ai < 2; ++ai) {
            f32x4 xb[4][2][2];
#pragma unroll
            for (int m = 0; m < 4; ++m) { const size_t ro = (size_t)(row0 + ai * HALF + m * 16) * ldc + col0;
#pragma unroll
                for (int bj = 0; bj < 2; ++bj) { xb[m][bj][0] = __builtin_nontemporal_load((const f32x4*)(base + ro + bj * HALF)); xb[m][bj][1] = __builtin_nontemporal_load((const f32x4*)(base + ro + bj * HALF + 4)); } }
#pragma unroll
            for (int m = 0; m < 4; ++m) { const size_t ro = (size_t)(row0 + ai * HALF + m * 16) * ldc + col0;
#pragma unroll
                for (int bj = 0; bj < 2; ++bj)
                    *(u32x4*)(C + ro + bj * HALF) = pack8(xb[m][bj][0] + gv[bj][0] * acc[ai][bj][m][0], xb[m][bj][1] + gv[bj][1] * acc[ai][bj][m][1]); }
            asm volatile("" ::: "memory");
        }
    }
};


struct StaticOrder {
    int nM, nN, nwg, G, c;
    __host__ __device__ void init(int M, int N, int G_, int c_) { nM = M / BM; nN = N / BM; nwg = nM * nN; G = G_; c = c_; }
    __host__ __device__ bool next(int i, Unit& u) const {
        const long L = (long)i * G + c; if (L >= nwg) return false;
        int wgid = (int)L; { const int q = nwg / NXCD, r = nwg % NXCD, xcd = wgid % NXCD, off = wgid / NXCD; wgid = (xcd < r ? xcd * (q + 1) : r * (q + 1) + (xcd - r) * q) + off; }
        const int nig = WGM * nN, gid = wgid / nig, fm = gid * WGM, gsz = (nM - fm) < WGM ? (nM - fm) : WGM;
        u.pm = fm + ((wgid % nig) % gsz); u.pn = (wgid % nig) / gsz; return true;
    }
    __device__ __forceinline__ void a_ready(const Unit&) const {}
    __device__ __forceinline__ void done(const Unit&) const {}
};

__device__ __forceinline__ void glds4(const void* gp, unsigned l) { unsigned keep; const unsigned dst = (unsigned)__builtin_amdgcn_readfirstlane((int)l);
    asm volatile("s_mov_b32 %0, m0\n\ts_mov_b32 m0, %2\n\ts_nop 0\n\tglobal_load_lds_dword %1, off\n\ts_mov_b32 m0, %0" : "=&s"(keep) : "v"(gp), "s"(dst) : "memory"); }
template <class Epi, class Sched, bool ALIGN_EPI = false, bool SP2 = false>
__device__ __forceinline__ void gemm_phase(PG8_LAS unsigned char* lds, const Gemm g, const Sched& S, const Epi& E) {
    const int tid = threadIdx.x, wid = __builtin_amdgcn_readfirstlane(tid >> 6), lane = tid & 63, wr = wid >> 2, wc = wid & 3, fr = lane & 15, fq = lane >> 4;
    const int K = g.K, nt = K / BK;
    unsigned voffA[2], voffB[2];
#pragma unroll
    for (int i = 0; i < 2; ++i) { int R, C; stage_rc(tid * 16 + i * 8192, R, C); const int Rb = Epi::PERM ? ((R & ~31) + perm32(R & 31)) : R;
        voffA[i] = (unsigned)(R * g.lda + C) * 2u; voffB[i] = (unsigned)(Rb * g.ldb + C) * 2u; }
    unsigned vgc[2][2] = {{0u, 0u}, {0u, 0u}}, vgn[2][2] = {{0u, 0u}, {0u, 0u}};
#define PG8_LOADVG(vg, pm_) do { _Pragma("unroll") for (int h_ = 0; h_ < 2; ++h_) _Pragma("unroll") for (int i_ = 0; i_ < 2; ++i_) { int R_, C_; stage_rc(tid * 16 + i_ * 8192, R_, C_); \
        vg[h_][i_] = (unsigned)(g.gidx[(pm_) * BM + h_ * HALF + R_] * g.lda + C_) * 2u; } } while (0)
    const size_t kstep = (size_t)(BK * 2);
    const size_t hstepA = (size_t)HALF * g.lda * 2, hstepB = (size_t)HALF * g.ldb * 2;
    const size_t tstepA = 2 * hstepA, tstepB = 2 * hstepB;
    const unsigned ldsw = (unsigned)wid * 1024u;
    const int aoff = lds_byte(wr * 64 + fr, fq * 8), boff = lds_byte(wc * 32 + fr, fq * 8);
#define PG8_SA(b, h) (((b) * 2 + (h)) * HTB)
#define PG8_SB(b, h) ((4 + (b) * 2 + (h)) * HTB)
#define PG8_STAGE(bufoff, gbase, voff) do { _Pragma("unroll") for (int _i = 0; _i < 2; ++_i) \
        __builtin_amdgcn_global_load_lds((const unsigned*)((const char*)(gbase) + (voff)[_i]), (PG8_LAS unsigned*)(lds + (bufoff) + ldsw + _i * 8192), 16, 0, 0); } while (0)
#define PG8_STAGE_A(bufoff, X, half, nx) do { if constexpr (Epi::GATHER) { unsigned vs_[2]; vs_[0] = (nx) ? vgn[half][0] : vgc[half][0]; vs_[1] = (nx) ? vgn[half][1] : vgc[half][1]; PG8_STAGE(bufoff, X, vs_); } \
        else PG8_STAGE(bufoff, (half) ? (X) + hstepA : (X), voffA); } while (0)
#define PG8_LDA(dst, b, h) do { _Pragma("unroll") for (int m = 0; m < 4; ++m) { const v4i_t l_ = *(const PG8_LAS v4i_t*)(lds + PG8_SA(b, h) + aoff + m * 2048), h_ = *(const PG8_LAS v4i_t*)(lds + PG8_SA(b, h) + aoff + m * 2048 + 1024); dst[m] = __builtin_shufflevector(l_, h_, 0, 1, 2, 3, 4, 5, 6, 7); } } while (0)
#define PG8_LDB(dst, b, h) do { _Pragma("unroll") for (int n = 0; n < 2; ++n) { const v4i_t l_ = *(const PG8_LAS v4i_t*)(lds + PG8_SB(b, h) + boff + n * 2048), h_ = *(const PG8_LAS v4i_t*)(lds + PG8_SB(b, h) + boff + n * 2048 + 1024); dst[n] = __builtin_shufflevector(l_, h_, 0, 1, 2, 3, 4, 5, 6, 7); } } while (0)
#define PG8_HALF(x, k) __builtin_bit_cast(bf16x8, __builtin_shufflevector(x, x, 4 * (k), 4 * (k) + 1, 4 * (k) + 2, 4 * (k) + 3))
#define PG8_MMA(ai, bj, At, Bt) do { if constexpr (Epi::FP8) __builtin_amdgcn_sched_barrier(0); __builtin_amdgcn_s_setprio(1); _Pragma("unroll") for (int m = 0; m < 4; ++m) _Pragma("unroll") for (int n = 0; n < 2; ++n) { \
        if constexpr (Epi::FP8) acc[ai][bj][m][n] = __builtin_amdgcn_mfma_scale_f32_16x16x128_f8f6f4(Bt[n], At[m], acc[ai][bj][m][n], 0, 0, 0, 0x7f7f7f7f, 0, 0x7f7f7f7f); \
        else { acc[ai][bj][m][n] = __builtin_amdgcn_mfma_f32_16x16x32_bf16(PG8_HALF(Bt[n], 0), PG8_HALF(At[m], 0), acc[ai][bj][m][n], 0, 0, 0); \
               acc[ai][bj][m][n] = __builtin_amdgcn_mfma_f32_16x16x32_bf16(PG8_HALF(Bt[n], 1), PG8_HALF(At[m], 1), acc[ai][bj][m][n], 0, 0, 0); } } \
        __builtin_amdgcn_s_setprio(0); if constexpr (Epi::FP8) { _Pragma("unroll") for (int m = 0; m < 4; ++m) _Pragma("unroll") for (int n = 0; n < 2; ++n) asm volatile("" : "+v"(acc[ai][bj][m][n])); __builtin_amdgcn_sched_barrier(0); } } while (0)
#define PG8_WAIT_V(n) asm volatile("s_waitcnt vmcnt(" #n ")" ::: "memory")
#define PG8_WAIT_L(n) asm volatile("s_waitcnt lgkmcnt(" #n ")" ::: "memory")
#define PG8_BAR __builtin_amdgcn_s_barrier()
#define PG8_SCHED __builtin_amdgcn_sched_barrier(0)
    Unit cur, nxt; int ui = 0;
    if (!S.next(0, cur)) return;
    f32x4 acc[2][2][4][2];
#pragma unroll
    for (int a = 0; a < 2; ++a)
#pragma unroll
        for (int b = 0; b < 2; ++b)
#pragma unroll
            for (int m = 0; m < 4; ++m)
#pragma unroll
                for (int n = 0; n < 2; ++n) acc[a][b][m][n] = (f32x4){0.f, 0.f, 0.f, 0.f};
    v8i_t At[4], B0[2], B1[2];
    const char* cA = (const char*)g.A + (Epi::GATHER ? (size_t)0 : (size_t)cur.pm * tstepA); const char* cB = (const char*)g.Bt + (size_t)(cur.pm / g.gdiv) * g.gstride + (size_t)cur.pn * tstepB;
    S.a_ready(cur);
    if constexpr (Epi::GATHER) { static_assert(SP2 || !Epi::GATHER, "gather: SP2 loop only"); PG8_LOADVG(vgc, cur.pm); }
    if constexpr (SP2) {
        PG8_STAGE(PG8_SB(0, 0), cB, voffB); PG8_STAGE(PG8_SB(0, 1), cB + hstepB, voffB); PG8_STAGE_A(PG8_SA(0, 0), cA, 0, false); PG8_STAGE_A(PG8_SA(0, 1), cA, 1, false);
        if (wr == 1) PG8_BAR;
        PG8_WAIT_V(2); PG8_BAR;
        PG8_STAGE(PG8_SB(1, 0), cB + kstep, voffB); PG8_STAGE_A(PG8_SA(1, 0), cA + kstep, 0, false); PG8_STAGE(PG8_SB(1, 1), cB + hstepB + kstep, voffB);
        PG8_WAIT_V(6); PG8_BAR;
    } else {
        PG8_STAGE(PG8_SB(0, 0), cB, voffB); PG8_STAGE(PG8_SA(0, 0), cA, voffA); PG8_STAGE(PG8_SB(0, 1), cB + hstepB, voffB); PG8_STAGE(PG8_SA(0, 1), cA + hstepA, voffA);
        if (wr == 1) PG8_BAR;
        PG8_WAIT_V(4); PG8_BAR;
        PG8_STAGE(PG8_SB(1, 0), cB + kstep, voffB); PG8_STAGE(PG8_SA(1, 0), cA + kstep, voffA); PG8_STAGE(PG8_SB(1, 1), cB + hstepB + kstep, voffB);
        PG8_WAIT_V(6); PG8_BAR;
    }
    for (;;) {
        const bool has_next = S.next(ui + 1, nxt);
        if constexpr (Epi::GATHER) { if (has_next && wid < 4) glds4(g.gidx + (size_t)nxt.pm * BM + wid * 64 + lane, (unsigned)(size_t)(lds + 8 * HTB + 1024 + ((ui + 1) & 1) * 1024 + wid * 256)); }
        const char* nA = (has_next && !Epi::GATHER) ? (const char*)g.A + (size_t)nxt.pm * tstepA : cA; const char* nB = has_next ? (const char*)g.Bt + (size_t)(nxt.pm / g.gdiv) * g.gstride + (size_t)nxt.pn * tstepB : cB;
        float pv[8];
        for (int t = 0; t < nt; t += 2) {
            const bool last = (t == nt - 2);
            if constexpr (Epi::PRE) { if (last) E.preload(cur, wr, fr, pv); }
            const char* a1 = cA + (size_t)(t + 1) * kstep;
            const char* a2 = last ? nA : cA + (size_t)(t + 2) * kstep; const char* b2 = last ? nB : cB + (size_t)(t + 2) * kstep;
            const char* a3 = a2 + kstep; const char* b3 = b2 + kstep;
            if (last && has_next) S.a_ready(nxt);
            const bool nx_ = last;
            if constexpr (Epi::GATHER) { if (last) { if (has_next) {
                    const PG8_LAS int* gl_ = (const PG8_LAS int*)(lds + 8 * HTB + 1024 + ((ui + 1) & 1) * 1024);
                    _Pragma("unroll") for (int h_ = 0; h_ < 2; ++h_) _Pragma("unroll") for (int i_ = 0; i_ < 2; ++i_) { int R_, C_; stage_rc(tid * 16 + i_ * 8192, R_, C_); vgn[h_][i_] = (unsigned)(gl_[h_ * HALF + R_] * g.lda + C_) * 2u; } }
                else { vgn[0][0] = vgc[0][0]; vgn[0][1] = vgc[0][1]; vgn[1][0] = vgc[1][0]; vgn[1][1] = vgc[1][1]; } } }
            if constexpr (Epi::MID) { PG8_SCHED; if (t == nt / 2) E.mid(acc, cur, wr, wc, fr, fq); PG8_SCHED; }
            if constexpr (SP2) {
            PG8_LDB(B0, 0, 0); PG8_LDB(B1, 0, 1); PG8_SCHED; PG8_LDA(At, 0, 0); PG8_STAGE_A(PG8_SA(1, 1), a1, 1, false);
            PG8_WAIT_V(8); PG8_WAIT_L(0); PG8_BAR; PG8_MMA(0, 0, At, B0); PG8_MMA(0, 1, At, B1); PG8_BAR; PG8_SCHED;
            PG8_LDA(At, 0, 1); PG8_STAGE(PG8_SB(0, 0), b2, voffB); PG8_STAGE(PG8_SB(0, 1), b2 + hstepB, voffB); PG8_STAGE_A(PG8_SA(0, 0), a2, 0, nx_);
            PG8_WAIT_V(8); PG8_WAIT_L(0); PG8_BAR; PG8_MMA(1, 0, At, B0); PG8_MMA(1, 1, At, B1); PG8_BAR; PG8_SCHED;
            PG8_LDB(B0, 1, 0); PG8_LDB(B1, 1, 1); PG8_SCHED; PG8_LDA(At, 1, 0); PG8_STAGE_A(PG8_SA(0, 1), a2, 1, nx_);
            PG8_WAIT_V(8); PG8_WAIT_L(0); PG8_BAR; PG8_MMA(0, 0, At, B0); PG8_MMA(0, 1, At, B1); PG8_BAR; PG8_SCHED;
            PG8_LDA(At, 1, 1); PG8_STAGE(PG8_SB(1, 0), b3, voffB); PG8_STAGE(PG8_SB(1, 1), b3 + hstepB, voffB); PG8_STAGE_A(PG8_SA(1, 0), a3, 0, nx_);
            PG8_WAIT_V(8); PG8_WAIT_L(0); PG8_BAR; PG8_MMA(1, 0, At, B0); PG8_MMA(1, 1, At, B1); PG8_BAR; PG8_SCHED;
            } else {
            PG8_LDB(B0, 0, 0); PG8_SCHED; PG8_LDA(At, 0, 0); PG8_STAGE(PG8_SA(1, 1), a1 + hstepA, voffA);
            PG8_WAIT_L(8); PG8_BAR; PG8_WAIT_L(0); PG8_MMA(0, 0, At, B0); PG8_BAR; PG8_SCHED;
            PG8_LDB(B1, 0, 1); PG8_STAGE(PG8_SB(0, 0), b2, voffB);
            PG8_BAR; PG8_WAIT_L(0); PG8_MMA(0, 1, At, B1); PG8_BAR;
            PG8_LDA(At, 0, 1); PG8_STAGE(PG8_SA(0, 0), a2, voffA);
            PG8_BAR; PG8_WAIT_L(0); PG8_MMA(1, 0, At, B0); PG8_BAR; PG8_SCHED;
            PG8_STAGE(PG8_SB(0, 1), b2 + hstepB, voffB);
            PG8_WAIT_V(6); PG8_BAR; PG8_MMA(1, 1, At, B1); PG8_BAR;
            PG8_LDB(B0, 1, 0); PG8_SCHED; PG8_LDA(At, 1, 0); PG8_STAGE(PG8_SA(0, 1), a2 + hstepA, voffA);
            PG8_WAIT_L(8); PG8_BAR; PG8_WAIT_L(0); PG8_MMA(0, 0, At, B0); PG8_BAR; PG8_SCHED;
            PG8_LDB(B1, 1, 1); PG8_STAGE(PG8_SB(1, 0), b3, voffB);
            PG8_BAR; PG8_WAIT_L(0); PG8_MMA(0, 1, At, B1); PG8_BAR;
            PG8_LDA(At, 1, 1); PG8_STAGE(PG8_SA(1, 0), a3, voffA);
            PG8_BAR; PG8_WAIT_L(0); PG8_MMA(1, 0, At, B0); PG8_BAR; PG8_SCHED;
            PG8_STAGE(PG8_SB(1, 1), b3 + hstepB, voffB);
            PG8_WAIT_V(6); PG8_BAR; PG8_MMA(1, 1, At, B1); PG8_BAR;
            }
        }
        if constexpr (ALIGN_EPI) { if (wr == 0) PG8_BAR; }
        if constexpr (Epi::PRE) { E(acc, cur, wr, wc, fr, fq, pv); S.done(cur); } else
        if constexpr (!Epi::AFTER_DRAIN) { E(acc, cur, wr, wc, fr, fq); S.done(cur); }
        if (!has_next) break;
#pragma unroll
        for (int a = 0; a < 2; ++a)
#pragma unroll
            for (int b = 0; b < 2; ++b)
#pragma unroll
                for (int m = 0; m < 4; ++m)
#pragma unroll
                    for (int n = 0; n < 2; ++n) acc[a][b][m][n] = (f32x4){0.f, 0.f, 0.f, 0.f};
        cur = nxt; cA = nA; cB = nB; ++ui;
        if constexpr (Epi::GATHER) { vgc[0][0] = vgn[0][0]; vgc[0][1] = vgn[0][1]; vgc[1][0] = vgn[1][0]; vgc[1][1] = vgn[1][1]; }
        if constexpr (ALIGN_EPI) { if (wr == 1) PG8_BAR; }
    }
    PG8_WAIT_V(0);
    if constexpr (!ALIGN_EPI) { if (wr == 0) PG8_BAR; }
    PG8_BAR;
    if constexpr (Epi::AFTER_DRAIN) { E.fused(acc, cur, wr, wc, fr, fq, lds, wid, lane); S.done(cur); }
#undef PG8_SA
#undef PG8_SB
#undef PG8_STAGE
#undef PG8_STAGE_A
#undef PG8_LOADVG
#undef PG8_LDA
#undef PG8_LDB
#undef PG8_MMA
#undef PG8_HALF
#undef PG8_WAIT_V
#undef PG8_WAIT_L
#undef PG8_BAR
#undef PG8_SCHED
}
}

#define GAS __attribute__((address_space(1)))
#define LAS __attribute__((address_space(3)))
typedef unsigned short bf16;
typedef unsigned v4u __attribute__((ext_vector_type(4)));
typedef float f32x4 __attribute__((ext_vector_type(4)));
typedef short bf16x8 __attribute__((ext_vector_type(8)));
typedef GAS unsigned gu32;
typedef GAS unsigned long long gu64;
#define RLX_AGENT __ATOMIC_RELAXED, __HIP_MEMORY_SCOPE_AGENT
#define LDS_WAIT() asm volatile("s_waitcnt lgkmcnt(0)" ::: "memory")
#define VM_WAIT() asm volatile("s_waitcnt vmcnt(0)" ::: "memory")
__device__ __forceinline__ unsigned long long rt() { return __builtin_amdgcn_s_memrealtime(); }
__device__ __forceinline__ unsigned f2bf(float f) { unsigned u = __builtin_bit_cast(unsigned, f); return (u + 0x7fffu + ((u >> 16) & 1u)) >> 16; }
__device__ __forceinline__ unsigned pk2(float lo, float hi) { return f2bf(lo) | (f2bf(hi) << 16); }

#define XB_TMO      128
#define XB_XCNT(j)  (256  + 64 * (j))
#define XB_XSUB(j)  (1280 + 64 * (j))
#define XB_XGEN(j)  (2304 + 64 * (j))
#define XB_TOP      3328
#define XB_TOPGEN   3392
#define XCD_BAR_WORDS 3456
#define XB_SPIN_CAP (1u << 18)

__device__ __forceinline__ unsigned xb_ld(unsigned* p)              { return __hip_atomic_load(p, __ATOMIC_RELAXED, __HIP_MEMORY_SCOPE_AGENT); }
__device__ __forceinline__ unsigned xb_add(unsigned* p, unsigned v) { return __hip_atomic_fetch_add(p, v, __ATOMIC_RELAXED, __HIP_MEMORY_SCOPE_AGENT); }
__device__ __forceinline__ unsigned xb_xcc_id() { return (unsigned)__builtin_amdgcn_s_getreg((3 << 11) | 20) & 0xFu; }
#define XB_SPIN(cond, bar) do { unsigned _sp = 0; while (cond) { __builtin_amdgcn_s_sleep(1); \
    if ((++_sp & 255u) == 0u) { if (xb_ld(&(bar)[XB_TMO])) break; if (_sp > XB_SPIN_CAP) { atomicAdd(&(bar)[XB_TMO], 1u); break; } } } } while (0)

struct XcdBarrier {
    unsigned* bar; unsigned x;
    volatile LAS unsigned* st;
};

__device__ __forceinline__ XcdBarrier xcd_barrier_post(unsigned* bar, volatile LAS unsigned* st) {
    XcdBarrier b; b.bar = bar; b.x = xb_xcc_id(); b.st = st;
    if (threadIdx.x == 0) (void)xb_add(&bar[XB_XCNT(b.x)], 1u);
    return b;
}
__device__ __forceinline__ void xcd_barrier_complete(unsigned* bar, unsigned x, unsigned& nloc, unsigned& nx) {
    const unsigned G = gridDim.x * gridDim.y * gridDim.z;
    unsigned sum, cnt, mine, sp = 0u;
    for (;;) {
        sum = 0u; cnt = 0u; mine = 0u;
#pragma unroll
        for (unsigned j = 0; j < 16; ++j) { const unsigned c = xb_ld(&bar[XB_XCNT(j)]); sum += c; cnt += (c > 0u) ? 1u : 0u; mine = (j == x) ? c : mine; }
        if (sum == G) break;
        __builtin_amdgcn_s_sleep(1);
        if ((++sp & 255u) == 0u) { if (xb_ld(&bar[XB_TMO])) break; if (sp > XB_SPIN_CAP) { atomicAdd(&bar[XB_TMO], 1u); break; } }
    }
    nloc = mine > 0u ? mine : 1u; nx = cnt > 0u ? cnt : 1u;
}

__device__ __forceinline__ void xcd_barrier(const XcdBarrier& b) {
    asm volatile("s_waitcnt vmcnt(0)" ::: "memory");
    __syncthreads();
    if (threadIdx.x == 0) {
        unsigned* bar = b.bar;
        __builtin_amdgcn_s_waitcnt(0);
        unsigned nloc = b.st[0], nx = b.st[1];
        if (nloc == 0u) { xcd_barrier_complete(bar, b.x, nloc, nx); b.st[0] = nloc; b.st[1] = nx; }
        const unsigned old = xb_add(&bar[XB_XSUB(b.x)], 1u);
        const unsigned gen = old / nloc;
        if (old + 1u == (gen + 1u) * nloc) {
            __builtin_amdgcn_fence(__ATOMIC_RELEASE, "agent");
            asm volatile("s_waitcnt vmcnt(0)" ::: "memory");
            const unsigned og = xb_add(&bar[XB_TOP], 1u);
            const unsigned tg = og / nx;
            if (og + 1u == (tg + 1u) * nx) xb_add(&bar[XB_TOPGEN], 1u);
            else XB_SPIN(xb_ld(&bar[XB_TOPGEN]) == tg, bar);
            __builtin_amdgcn_fence(__ATOMIC_ACQUIRE, "agent");
            xb_add(&bar[XB_XGEN(b.x)], 1u);
            asm volatile("s_waitcnt vmcnt(0)" ::: "memory");
        } else {
            XB_SPIN(xb_ld(&bar[XB_XGEN(b.x)]) == gen, bar);
            __builtin_amdgcn_fence(__ATOMIC_ACQUIRE, "agent");
            asm volatile("s_waitcnt vmcnt(0)" ::: "memory");
        }
    }
    __syncthreads();
}
template <class Pre>
__device__ __forceinline__ void xcd_barrier_hook(const XcdBarrier& b, Pre&& pre) {
    asm volatile("s_waitcnt vmcnt(0)" ::: "memory");
    __syncthreads();
    if (__builtin_amdgcn_readfirstlane(threadIdx.x) >= 64) pre();
    if (threadIdx.x == 0) {
        unsigned* bar = b.bar;
        __builtin_amdgcn_s_waitcnt(0);
        unsigned nloc = b.st[0], nx = b.st[1];
        if (nloc == 0u) { xcd_barrier_complete(bar, b.x, nloc, nx); b.st[0] = nloc; b.st[1] = nx; }
        const unsigned old = xb_add(&bar[XB_XSUB(b.x)], 1u);
        const unsigned gen = old / nloc;
        if (old + 1u == (gen + 1u) * nloc) {
            __builtin_amdgcn_fence(__ATOMIC_RELEASE, "agent");
            asm volatile("s_waitcnt vmcnt(0)" ::: "memory");
            const unsigned og = xb_add(&bar[XB_TOP], 1u);
            const unsigned tg = og / nx;
            if (og + 1u == (tg + 1u) * nx) xb_add(&bar[XB_TOPGEN], 1u);
            else XB_SPIN(xb_ld(&bar[XB_TOPGEN]) == tg, bar);
            __builtin_amdgcn_fence(__ATOMIC_ACQUIRE, "agent");
            xb_add(&bar[XB_XGEN(b.x)], 1u);
            asm volatile("s_waitcnt vmcnt(0)" ::: "memory");
        } else {
            XB_SPIN(xb_ld(&bar[XB_XGEN(b.x)]) == gen, bar);
            __builtin_amdgcn_fence(__ATOMIC_ACQUIRE, "agent");
            asm volatile("s_waitcnt vmcnt(0)" ::: "memory");
        }
    }
    __syncthreads();
}

constexpr int NWAVES = 8;
constexpr int NB = 8, SEQ = 2048, D = 1024, M = NB * SEQ;
constexpr int NIN = 5632, NE = 16, CAP = 256, MS = NE * NB * CAP;
constexpr float EPS = 1e-6f;
constexpr float LOG2E = 1.4426950408889634f;
constexpr size_t MiB = 1u << 20;
constexpr size_t WS_CTL = 0, CTL_ZERO_BYTES = 1 * MiB;
constexpr size_t WS_MOD = 1 * MiB;
constexpr size_t WS_CS = 1 * MiB + 256 * 1024;
constexpr size_t WS_AFF = 3 * MiB;
constexpr size_t WS_INV = 4 * MiB;
constexpr size_t WS_SELG = 5 * MiB;
constexpr size_t WS_WIN = 6 * MiB;
constexpr size_t WS_WIN8 = 12 * MiB + 512 * 1024;
constexpr size_t WS_WCAT = 17 * MiB;
constexpr size_t WS_WO = 19 * MiB;
constexpr size_t WS_WGU = 21 * MiB;
constexpr size_t WS_WD = 85 * MiB;
constexpr size_t WS_ACT0 = 117 * MiB;
constexpr size_t WS_RQ = 117 * MiB, WS_RK = 133 * MiB, WS_RV = 149 * MiB, WS_RG = 165 * MiB;
constexpr size_t WS_DQ1 = 181 * MiB;
constexpr size_t WS_DV = 213 * MiB;
constexpr size_t WS_GR = 229 * MiB, WS_GD = 261 * MiB;
constexpr size_t WS_END = 293 * MiB;
constexpr size_t WS_T1 = 117 * MiB;
constexpr size_t WS_MERGED = 149 * MiB;
constexpr size_t WS_H2 = 181 * MiB;
constexpr size_t WS_XG = 117 * MiB;
constexpr size_t WS_ACT = 213 * MiB;
constexpr size_t WS_X1 = 261 * MiB;
constexpr size_t WS_YS = 117 * MiB;
constexpr int CW_TMO = 0, CW_CODE = 1, CW_RET = 64, CW_MOD = 128, CW_BAR = 4096;
constexpr int RING_OFF = 0, RING_BYTES = 131072;
constexpr int LDSCTL_OFF = RING_BYTES, MISC_OFF = LDSCTL_OFF + 320;
constexpr int QS_OFF = RING_BYTES + 1024;
constexpr int LDS_BYTES = 147456;

typedef unsigned v2u __attribute__((ext_vector_type(2)));
typedef float f32x2 __attribute__((ext_vector_type(2)));
struct Frame {
    LAS unsigned char* lds;
    volatile LAS unsigned* MISC;
    gu32* ctl;
    int tid, lane, wave;
    int vcu, G;
    const float* in[22]; float* out; unsigned char* ws;
};
__device__ __forceinline__ float wave_sum(float v) {
#pragma unroll
    for (int o = 1; o < 64; o <<= 1) v += __shfl_xor(v, o);
    return v;
}
__device__ __forceinline__ float wave_max(float v) {
#pragma unroll
    for (int o = 1; o < 64; o <<= 1) v = fmaxf(v, __shfl_xor(v, o));
    return v;
}
__device__ __forceinline__ float bf2f_lo(unsigned w) { return __builtin_bit_cast(float, w << 16); }
__device__ __forceinline__ float bf2f_hi(unsigned w) { return __builtin_bit_cast(float, w & 0xffff0000u); }
__device__ __forceinline__ float bf2f(bf16 h) { return __builtin_bit_cast(float, ((unsigned)h) << 16); }
__device__ __forceinline__ float sigm(float v) { return __builtin_amdgcn_rcpf(1.0f + __builtin_amdgcn_exp2f(-LOG2E * v)); }
__device__ __forceinline__ float silu_exact(float v) { return v / (1.0f + __expf(-v)); }

__device__ __forceinline__ int gu_base(int o) { return (o >> 7) * 256 + ((o >> 2) & 1) * 128 + ((o >> 5) & 3) * 32 + ((o >> 3) & 3) * 4 + (o & 3); }
constexpr int I_IN = 16 * 176, I_RO = 8 * 32, I_WO = 16 * 32, I_EX = 16 * 32;
constexpr int P0_NITEMS = I_IN + 2 * I_RO + I_WO + 48 * I_EX, P0_ITEMS = P0_NITEMS - 16 * I_EX, P0_MIX_ITEMS = I_IN + 2 * I_RO + I_WO;
constexpr int P7_NMAT = 0, P7_LO = P0_ITEMS - P7_NMAT * I_EX;
__device__ __forceinline__ void p0_item_load(Frame& F, int it, f32x4 (&w)[8]) {
    const float* const w5 = F.in[5]; const float* const w12 = F.in[12]; const float* const w13 = F.in[13]; const float* const w14 = F.in[14];
    const float* const w18 = F.in[18]; const float* const w19 = F.in[19]; const float* const w20 = F.in[20];
    int r = it, N = 1024; const float* W; int k0, n0;
    if (r < I_IN) { W = w5; N = NIN; k0 = 64 * (r / 176); n0 = 32 * (r % 176); }
    else { r -= I_IN;
        if (r < I_RO) W = w12;
        else { r -= I_RO;
            if (r < I_RO) W = w13;
            else { r -= I_RO;
                if (r < I_WO) W = w14;
                else { r -= I_WO; const int mat = r / I_EX, ty = mat >> 4, e = mat & 15; r = r % I_EX; W = (ty == 0 ? w18 : ty == 1 ? w19 : w20) + (size_t)e * 1048576; } } }
        k0 = 64 * (r / 32); n0 = 32 * (r % 32); }
    const float* p = W + (size_t)(k0 + (F.lane >> 3)) * N + n0 + 4 * (F.lane & 7);
#pragma unroll
    for (int i = 0; i < 8; ++i) w[i] = __builtin_nontemporal_load((const f32x4*)(p + (size_t)(8 * i) * N));
}
__device__ __forceinline__ void p0_item_store(Frame& F, int it, const f32x4 (&w)[8], LAS float* scr) {
    int r = it; int fp8 = 0, mode = 0, row_off = 0, kcol_off = 0, k0, n0; unsigned char* dst;
    if (r < I_IN) { dst = F.ws + WS_WIN; k0 = 64 * (r / 176); n0 = 32 * (r % 176); }
    else { r -= I_IN;
        if (r < I_RO) dst = F.ws + WS_WCAT;
        else { r -= I_RO;
            if (r < I_RO) { dst = F.ws + WS_WCAT; kcol_off = 512; }
            else { r -= I_RO;
                if (r < I_WO) dst = F.ws + WS_WO;
                else { r -= I_WO; const int mat = r / I_EX, ty = mat >> 4, e = mat & 15; r = r % I_EX; fp8 = 1;
                    if (ty == 0)      { dst = F.ws + WS_WGU; mode = 1; row_off = e * 2048; }
                    else if (ty == 1) { dst = F.ws + WS_WGU; mode = 1; row_off = e * 2048 + 16; }
                    else              { dst = F.ws + WS_WD; row_off = e * 1024; } } } }
        k0 = 64 * (r / 32); n0 = 32 * (r % 32); }
    const float mul = fp8 ? pg8::W8_SCALE : 1.f;
    { LAS float* sw = scr + (F.lane >> 3) * 33 + 4 * (F.lane & 7);
#pragma unroll
      for (int i = 0; i < 8; ++i) { sw[(8 * i) * 33 + 0] = w[i][0] * mul; sw[(8 * i) * 33 + 1] = w[i][1] * mul; sw[(8 * i) * 33 + 2] = w[i][2] * mul; sw[(8 * i) * 33 + 3] = w[i][3] * mul; } }
    LDS_WAIT(); asm volatile("" ::: "memory");
    const int c = F.lane & 7;
#pragma unroll
    for (int j = 0; j < 4; ++j) { const int n = (F.lane >> 3) + 8 * j; const LAS float* s = scr + (8 * c) * 33 + n;
        const int drow = row_off + (mode ? gu_base(n0 + n) : (n0 + n));
        if (fp8) { v2u o; o.x = pg8::pk_fp8x4(s[0 * 33], s[1 * 33], s[2 * 33], s[3 * 33]); o.y = pg8::pk_fp8x4(s[4 * 33], s[5 * 33], s[6 * 33], s[7 * 33]);
            *(GAS v2u*)(dst + (size_t)drow * 1024 + k0 + 8 * c) = o; }
        else { v4u o; o.x = pk2(s[0 * 33], s[1 * 33]); o.y = pk2(s[2 * 33], s[3 * 33]); o.z = pk2(s[4 * 33], s[5 * 33]); o.w = pk2(s[6 * 33], s[7 * 33]);
            *(GAS v4u*)((bf16*)dst + (size_t)drow * 1024 + kcol_off + k0 + 8 * c) = o; } }
    LDS_WAIT(); asm volatile("" ::: "memory");
}
__device__ __forceinline__ void p0_run(Frame& F, int first, int end, int stride, LAS float* scr) {
    if (first >= end) return;
    f32x4 wa[8], wb[8];
    int it = first;
    p0_item_load(F, it, wa);
    for (;;) {
        const int i1 = it + stride;
        p0_item_load(F, i1 < end ? i1 : it, wb);
        p0_item_store(F, it, wa, scr);
        if (i1 >= end) break;
        const int i2 = i1 + stride;
        p0_item_load(F, i2 < end ? i2 : i1, wa);
        p0_item_store(F, i1, wb, scr);
        if (i2 >= end) break;
        it = i2;
    }
}
__device__ __forceinline__ void p0_prologue(Frame& F) {
    if (blockIdx.x < 96) {
        LAS float* sc = (LAS float*)(F.lds);
        LAS float* red = (LAS float*)(F.lds + 32768);
        const int j0 = blockIdx.x * 64, cg = F.lane & 15, kr = F.lane >> 4; const float* wa = F.in[2] + j0 + 4 * cg;
        const int kb = F.wave * 128 + kr;
        f32x4 wv[32];
#pragma unroll
        for (int i = 0; i < 32; ++i) wv[i] = __builtin_nontemporal_load((const f32x4*)(wa + (size_t)(kb + 4 * i) * 6144));
        const float* cin = F.in[1];
        { float t_[16];
#pragma unroll
          for (int i = 0; i < 16; ++i) t_[i] = cin[F.tid + 512 * i];
#pragma unroll
          for (int i = 0; i < 16; ++i) { const int idx = F.tid + 512 * i, b = idx >> 10, k = idx & 1023; sc[k * 8 + b] = silu_exact(t_[i]); } }
        __syncthreads();
        f32x4 a[8];
#pragma unroll
        for (int b = 0; b < 8; ++b) a[b] = (f32x4){0.f, 0.f, 0.f, 0.f};
#pragma unroll
        for (int i = 0; i < 32; ++i) { const int k = kb + 4 * i; const f32x4 s0 = *(const LAS f32x4*)(sc + k * 8), s1 = *(const LAS f32x4*)(sc + k * 8 + 4);
            a[0] += wv[i] * s0[0]; a[1] += wv[i] * s0[1]; a[2] += wv[i] * s0[2]; a[3] += wv[i] * s0[3]; a[4] += wv[i] * s1[0]; a[5] += wv[i] * s1[1]; a[6] += wv[i] * s1[2]; a[7] += wv[i] * s1[3]; }
#pragma unroll
        for (int b = 0; b < 8; ++b)
#pragma unroll
            for (int c = 0; c < 4; ++c) { float t = a[b][c]; t += __shfl_xor(t, 16); t += __shfl_xor(t, 32); a[b][c] = t; }
        if (F.lane < 16) {
#pragma unroll
            for (int b = 0; b < 8; ++b) *(LAS f32x4*)(red + (F.wave * 8 + b) * 64 + 4 * cg) = a[b]; }
        __syncthreads();
        { const int b = F.wave; float s = F.in[3][j0 + F.lane];
#pragma unroll
          for (int w = 0; w < 8; ++w) s += red[(w * 8 + b) * 64 + F.lane];
          ((float*)(F.ws + WS_MOD))[b * 6144 + j0 + F.lane] = s; }
        __syncthreads();
    }
    { float* cs = (float*)(F.ws + WS_CS);
      for (int idx = blockIdx.x * 512 + F.tid; idx < 2048 * 64; idx += F.G * 512) { const int pos = idx >> 6, i = idx & 63;
          double inv = 1.0, r = 0.8639884494839686; int e = i;
          for (int t = 0; t < 6; ++t) { if (e & 1) inv *= r; r *= r; e >>= 1; }
          const float ang = (float)pos * (float)inv;
          const double rev = (double)ang * 0.15915494309189535; const float fr = (float)(rev - __builtin_rint(rev));
          cs[2 * idx] = __builtin_amdgcn_cosf(fr); cs[2 * idx + 1] = __builtin_amdgcn_sinf(fr); } }
    LAS float* scr = (LAS float*)(F.lds + RING_OFF + F.wave * 16384);
    const int gw = F.vcu * NWAVES + F.wave, NGW = F.G * NWAVES;
    p0_run(F, gw, P0_MIX_ITEMS, NGW, scr);
    __syncthreads();
}
__device__ __forceinline__ void p3_items(Frame& F) {
    LAS float* scr = (LAS float*)(F.lds + RING_OFF + F.wave * 16384);
    p0_run(F, P0_MIX_ITEMS + F.vcu * NWAVES + F.wave, (F.G == 256) ? P7_LO : P0_ITEMS, F.G * NWAVES, scr);
    __syncthreads();
}
__device__ __forceinline__ void p0_tail_items(Frame& F) {
    if (F.G != 256 || blockIdx.x < 128) { if (F.G != 256) { LAS float* scr = (LAS float*)(F.lds + RING_OFF + F.wave * 16384); p0_run(F, P0_ITEMS + F.vcu * NWAVES + F.wave, P0_NITEMS, F.G * NWAVES, scr); } return; }
    LAS float* scr = (LAS float*)(F.lds + RING_OFF + F.wave * 16384);
    p0_run(F, P0_ITEMS + ((int)blockIdx.x - 128) * NWAVES + F.wave, P0_NITEMS, 128 * NWAVES, scr);
}
__device__ __forceinline__ void p1_norm(Frame& F, bf16* XN) {
    if (F.G == 256) {
        const float* mod = (const float*)(F.ws + WS_MOD);
        const int mb = F.vcu * 64 + F.wave * 8, b = mb >> 11;
        f32x4 v[8][4];
#pragma unroll
        for (int r = 0; r < 8; ++r) { const f32x4* xr = (const f32x4*)(F.in[0] + (size_t)(mb + r) * D) + F.lane;
#pragma unroll
            for (int j = 0; j < 4; ++j) v[r][j] = __builtin_nontemporal_load(xr + 64 * j); }
        f32x4 g[4], sh[4];
        { const f32x4* gp = (const f32x4*)(F.in[4]) + F.lane; const f32x4* shp = (const f32x4*)(mod + b * 6144) + F.lane; const f32x4* scp = (const f32x4*)(mod + b * 6144 + 1024) + F.lane;
#pragma unroll
          for (int j = 0; j < 4; ++j) { g[j] = gp[64 * j] * (scp[64 * j] + 1.0f); sh[j] = shp[64 * j]; } }
#pragma unroll
        for (int r = 0; r < 8; ++r) { float s = 0.f;
#pragma unroll
            for (int j = 0; j < 4; ++j) s += (v[r][j].x * v[r][j].x + v[r][j].y * v[r][j].y) + (v[r][j].z * v[r][j].z + v[r][j].w * v[r][j].w);
            const float rstd = 1.0f / sqrtf(wave_sum(s) * (1.f / D) + EPS);
            unsigned long long* o8 = (unsigned long long*)(XN + (size_t)(mb + r) * D) + F.lane;
#pragma unroll
            for (int j = 0; j < 4; ++j) { const f32x4 h = (v[r][j] * rstd) * g[j] + sh[j];
                o8[64 * j] = (unsigned long long)pk2(h.x, h.y) | ((unsigned long long)pk2(h.z, h.w) << 32); } }
        return;
    }

    const int gw = F.vcu * NWAVES + F.wave, NGW = F.G * NWAVES;
    const float* mod = (const float*)(F.ws + WS_MOD);
    for (int i = 0; i < M / NGW; ++i) { const int m = (F.G == 256) ? (F.vcu * 64 + F.wave * 8 + i) : (gw + i * NGW);
        const int b = m >> 11;
        const f32x4* xr = (const f32x4*)(F.in[0] + (size_t)m * D) + F.lane;
        const f32x4* gp = (const f32x4*)(F.in[4]) + F.lane;
        const f32x4* shp = (const f32x4*)(mod + b * 6144) + F.lane;
        const f32x4* scp = (const f32x4*)(mod + b * 6144 + 1024) + F.lane;
        f32x4 v[4]; float s = 0.f;
#pragma unroll
        for (int j = 0; j < 4; ++j) { v[j] = __builtin_nontemporal_load(xr + 64 * j); s += (v[j].x * v[j].x + v[j].y * v[j].y) + (v[j].z * v[j].z + v[j].w * v[j].w); }
        const float rstd = 1.0f / sqrtf(wave_sum(s) * (1.f / D) + EPS);
        unsigned long long* o8 = (unsigned long long*)(XN + (size_t)m * D) + F.lane;
#pragma unroll
        for (int j = 0; j < 4; ++j) { const f32x4 g = gp[64 * j], sh = shp[64 * j], sc = scp[64 * j]; const f32x4 h = (v[j] * rstd) * g * (sc + 1.0f) + sh;
            o8[64 * j] = (unsigned long long)pk2(h.x, h.y) | ((unsigned long long)pk2(h.z, h.w) << 32); }
    }
}
__device__ __forceinline__ int t5_bucket(int rel) {
    const int n = rel < 0 ? -rel : rel; int bk;
    if (n < 8) bk = n; else if (n < 12) bk = 8; else if (n < 16) bk = 9; else if (n < 23) bk = 10; else if (n < 32) bk = 11; else if (n < 46) bk = 12; else if (n < 64) bk = 13; else if (n < 91) bk = 14; else bk = 15;
    return bk + (rel > 0 ? 16 : 0);
}
__device__ __forceinline__ float ln1m(float x) { return -x * (1.f + x * (0.5f + x * (0.33333334f + x * (0.25f + x * (0.2f + x * (0.16666667f + x * 0.14285715f)))))); }
template <int MODE>
__device__ __forceinline__ void naive_unit(Frame& F, int unit, float lam, bf16* YCAT) {
    const int b = unit >> 10, h = (unit >> 8) & 3, q0 = (unit & 255) * 8;
    LAS float* S = (LAS float*)(F.lds);
    unsigned qs_off = QS_OFF; asm volatile("" : "+v"(qs_off));
    LAS float* Qs = (LAS float*)(F.lds + qs_off);
    LAS float* BT = Qs + 1024;
    const bf16* RQ = (const bf16*)(F.ws + WS_RQ); const bf16* RK = (const bf16*)(F.ws + WS_RK); const bf16* RV = (const bf16*)(F.ws + WS_RV); const bf16* RG = (const bf16*)(F.ws + WS_RG);
    const bf16* DQ1 = (const bf16*)(F.ws + WS_DQ1); const bf16* DQ2 = DQ1 + (size_t)M * 256; const bf16* DK1 = DQ2 + (size_t)M * 256; const bf16* DK2 = DK1 + (size_t)M * 256;
    const bf16* DV = (const bf16*)(F.ws + WS_DV);
    const size_t rb = (size_t)b * SEQ;
    for (int idx = F.tid; idx < 1024; idx += 512) { const int qi = idx >> 7, d = idx & 127; const size_t row = rb + q0 + qi;
        float v;
        if (MODE == 0) v = bf2f(RQ[row * 512 + h * 128 + d]);
        else v = d < 64 ? bf2f(DQ1[row * 256 + h * 64 + d]) : bf2f(DQ2[row * 256 + h * 64 + d - 64]);
        Qs[idx] = v; }
    if (MODE == 1 && F.tid < 32) BT[F.tid] = F.in[15][F.tid * 4 + h] * LOG2E;
    __syncthreads();
    float l2f, l2b;
    { const float xf = __builtin_amdgcn_exp2f(-5.0f - (float)h); l2f = ln1m(xf) * LOG2E; l2b = ln1m(xf * 0.70710678118654752f) * LOG2E; }
    for (int j = F.tid; j < SEQ; j += 512) {
        asm volatile("" ::: "memory");
        float s1[8], s2[8];
#pragma unroll
        for (int qi = 0; qi < 8; ++qi) { s1[qi] = 0.f; s2[qi] = 0.f; }
#pragma unroll 1
        for (int c = 0; c < 16; ++c) {
            const bf16* kp;
            if (MODE == 0) kp = RK + (rb + j) * 512 + h * 128 + c * 8;
            else kp = (c < 8) ? (DK1 + (rb + j) * 256 + h * 64 + c * 8) : (DK2 + (rb + j) * 256 + h * 64 + (c - 8) * 8);
            const v4u kw = *(const v4u*)kp;
            const float kf[8] = {bf2f_lo(kw.x), bf2f_hi(kw.x), bf2f_lo(kw.y), bf2f_hi(kw.y), bf2f_lo(kw.z), bf2f_hi(kw.z), bf2f_lo(kw.w), bf2f_hi(kw.w)};
            float t[8];
#pragma unroll
            for (int qi = 0; qi < 8; ++qi) { const f32x4 qa = *(const LAS f32x4*)(Qs + qi * 128 + c * 8), qb = *(const LAS f32x4*)(Qs + qi * 128 + c * 8 + 4);
                t[qi] = (qa[0] * kf[0] + qa[1] * kf[1]) + (qa[2] * kf[2] + qa[3] * kf[3]) + (qb[0] * kf[4] + qb[1] * kf[5]) + (qb[2] * kf[6] + qb[3] * kf[7]); }
            if (MODE == 1 && c >= 8) {
#pragma unroll
                for (int qi = 0; qi < 8; ++qi) s2[qi] += t[qi];
            } else {
#pragma unroll
                for (int qi = 0; qi < 8; ++qi) s1[qi] += t[qi];
            }
        }
#pragma unroll
        for (int qi = 0; qi < 8; ++qi) { const int i = q0 + qi;
            if (MODE == 0) { const float w = (j <= i) ? __builtin_amdgcn_exp2f((float)(i - j) * l2f) : __builtin_amdgcn_exp2f((float)(j - i) * l2b); S[qi * SEQ + j] = s1[qi] * w; }
            else { const float bias = BT[t5_bucket(j - i)]; S[qi * SEQ + j] = s1[qi] + bias; S[(8 + qi) * SEQ + j] = s2[qi] + bias; } }
    }
    __syncthreads();
    const int qi = F.wave; LAS float* S1 = S + qi * SEQ; LAS float* S2 = S + (8 + qi) * SEQ;
    if (MODE == 1) {
        float m1 = -3.0e38f, m2 = -3.0e38f;
        for (int j = F.lane; j < SEQ; j += 64) { m1 = fmaxf(m1, S1[j]); m2 = fmaxf(m2, S2[j]); }
        m1 = wave_max(m1); m2 = wave_max(m2);
        float l1 = 0.f, l2 = 0.f;
        for (int j = F.lane; j < SEQ; j += 64) { l1 += __builtin_amdgcn_exp2f(S1[j] - m1); l2 += __builtin_amdgcn_exp2f(S2[j] - m2); }
        l1 = wave_sum(l1); l2 = wave_sum(l2);
        const float r1 = 1.0f / l1, r2 = lam / l2;
        for (int j = F.lane; j < SEQ; j += 64) S1[j] = __builtin_amdgcn_exp2f(S1[j] - m1) * r1 - __builtin_amdgcn_exp2f(S2[j] - m2) * r2;
        LDS_WAIT(); asm volatile("" ::: "memory");
    }
    const bf16* V = (MODE == 0 ? RV : DV) + rb * 512 + h * 128 + 2 * F.lane;
    float o0 = 0.f, o1 = 0.f;
#pragma unroll 8
    for (int j = 0; j < SEQ; ++j) { const float p = S1[j]; const unsigned vv = *(const unsigned*)(V + (size_t)j * 512); o0 += p * bf2f_lo(vv); o1 += p * bf2f_hi(vv); }
    const size_t row = rb + q0 + qi;
    if (MODE == 0) {
        const float mean = wave_sum(o0 + o1) * (1.f / 128.f); const float d0 = o0 - mean, d1 = o1 - mean;
        const float var = wave_sum(d0 * d0 + d1 * d1) * (1.f / 128.f); const float rstd = 1.0f / sqrtf(var + EPS);
        const unsigned gw = *(const unsigned*)(RG + row * 512 + h * 128 + 2 * F.lane);
        const float y0 = d0 * rstd * F.in[6][h * 128 + 2 * F.lane] * bf2f_lo(gw), y1 = d1 * rstd * F.in[6][h * 128 + 2 * F.lane + 1] * bf2f_hi(gw);
        *(unsigned*)(YCAT + row * 1024 + h * 128 + 2 * F.lane) = pk2(y0, y1);
    } else {
        const float ms = wave_sum(o0 * o0 + o1 * o1) * (1.f / 128.f); const float rstd = 1.0f / sqrtf(ms + EPS);
        const float y0 = o0 * rstd * F.in[7][2 * F.lane] * 0.8f, y1 = o1 * rstd * F.in[7][2 * F.lane + 1] * 0.8f;
        *(unsigned*)(YCAT + row * 1024 + 512 + h * 128 + 2 * F.lane) = pk2(y0, y1);
    }
    __syncthreads();
}
__device__ __forceinline__ void router_finish(const float (&lg)[16], int lane, float* affrow) {
    float r8[8], r4[4], r2[2], r1;
    { const bool up = (lane & 32) != 0;
#pragma unroll
      for (int e = 0; e < 8; ++e) { const float keep = up ? lg[e + 8] : lg[e], send = up ? lg[e] : lg[e + 8]; r8[e] = keep + __shfl_xor(send, 32); } }
    { const bool up = (lane & 16) != 0;
#pragma unroll
      for (int e = 0; e < 4; ++e) { const float keep = up ? r8[e + 4] : r8[e], send = up ? r8[e] : r8[e + 4]; r4[e] = keep + __shfl_xor(send, 16); } }
    { const bool up = (lane & 8) != 0;
#pragma unroll
      for (int e = 0; e < 2; ++e) { const float keep = up ? r4[e + 2] : r4[e], send = up ? r4[e] : r4[e + 2]; r2[e] = keep + __shfl_xor(send, 8); } }
    { const bool up = (lane & 4) != 0; const float keep = up ? r2[1] : r2[0], send = up ? r2[0] : r2[1]; r1 = keep + __shfl_xor(send, 4); }
    r1 += __shfl_xor(r1, 2); r1 += __shfl_xor(r1, 1);
    float mx = r1;
#pragma unroll
    for (int o = 4; o < 64; o <<= 1) mx = fmaxf(mx, __shfl_xor(mx, o));
    const float ex = __expf(r1 - mx); float den = ex;
#pragma unroll
    for (int o = 4; o < 64; o <<= 1) den += __shfl_xor(den, o);
    if ((lane & 3) == 0) { const int e = ((lane >> 5) & 1) * 8 + ((lane >> 4) & 1) * 4 + ((lane >> 3) & 1) * 2 + ((lane >> 2) & 1); affrow[e] = ex / den; }
}
__device__ __forceinline__ void p7_router(Frame& F, const bf16* X1, unsigned char* H2, float* AFF) {
    LAS float* wr = (LAS float*)(F.lds);
    const int NIT7 = M / 4 / (F.G * NWAVES);
    v2u raw[16];
    { const int m = (F.G == 256) ? (F.vcu * 64 + F.wave * 8) : 4 * (F.vcu * NWAVES + F.wave); const v2u* x0 = (const v2u*)(X1 + (size_t)m * D) + F.lane;
#pragma unroll
      for (int q = 0; q < 16; ++q) raw[q] = x0[(q >> 2) * (D / 4) + 64 * (q & 3)]; }
    { f32x4 t_[8];
#pragma unroll
      for (int i = 0; i < 8; ++i) { const int q = F.tid + 512 * i, eq = q >> 10, k = q & 1023; t_[i] = *(const f32x4*)(F.in[17] + k * 16 + 4 * eq); }
#pragma unroll
      for (int i = 0; i < 8; ++i) { const int q = F.tid + 512 * i, eq = q >> 10, k = q & 1023;
          wr[(4 * eq + 0) * 1024 + k] = t_[i].x; wr[(4 * eq + 1) * 1024 + k] = t_[i].y; wr[(4 * eq + 2) * 1024 + k] = t_[i].z; wr[(4 * eq + 3) * 1024 + k] = t_[i].w; } }
    __syncthreads();
    const int gw = F.vcu * NWAVES + F.wave, NGW = F.G * NWAVES;
    const float* mod = (const float*)(F.ws + WS_MOD);
#pragma unroll 1
    for (int i = 0; i < NIT7; ++i) {
        const int m = (F.G == 256) ? (F.vcu * 64 + F.wave * 8 + 4 * i) : 4 * (gw + i * NGW), b = m >> 11;
        const f32x4* gp = (const f32x4*)(F.in[16]) + F.lane;
        const f32x4* shp = (const f32x4*)(mod + b * 6144 + 3072) + F.lane;
        const f32x4* scp = (const f32x4*)(mod + b * 6144 + 4096) + F.lane;
        f32x4 v[4][4]; float ss[4];
        f32x4 gs[4], sh[4];
#pragma unroll
        for (int j = 0; j < 4; ++j) { gs[j] = gp[64 * j] * (scp[64 * j] + 1.0f); sh[j] = shp[64 * j]; }
        const int cit = P7_LO + gw + i * NGW; f32x4 cw[8];
        if (F.G == 256 && P7_NMAT > 0) p0_item_load(F, cit, cw);
        {
#pragma unroll
          for (int r = 0; r < 4; ++r) { ss[r] = 0.f;
#pragma unroll
              for (int j = 0; j < 4; ++j) { const v2u w = raw[r * 4 + j]; v[r][j] = (f32x4){bf2f_lo(w.x), bf2f_hi(w.x), bf2f_lo(w.y), bf2f_hi(w.y)};
                  ss[r] += (v[r][j].x * v[r][j].x + v[r][j].y * v[r][j].y) + (v[r][j].z * v[r][j].z + v[r][j].w * v[r][j].w); } }
          if (i + 1 < NIT7) { const int mn = (F.G == 256) ? (F.vcu * 64 + F.wave * 8 + 4 * (i + 1)) : 4 * (gw + (i + 1) * NGW); const v2u* x0 = (const v2u*)(X1 + (size_t)mn * D) + F.lane;
#pragma unroll
              for (int q = 0; q < 16; ++q) raw[q] = x0[(q >> 2) * (D / 4) + 64 * (q & 3)]; } }
#pragma unroll
        for (int r = 0; r < 4; ++r) { const float rstd = 1.0f / sqrtf(wave_sum(ss[r]) * (1.f / D) + EPS);
            unsigned pk[4];
#pragma unroll
            for (int j = 0; j < 4; ++j) { v[r][j] = (v[r][j] * rstd) * gs[j] + sh[j]; pk[j] = pg8::pk_fp8x4(v[r][j].x, v[r][j].y, v[r][j].z, v[r][j].w); }
            const int qi = F.lane & 3; v4u st;
            { unsigned c0, c1, c2, c3;
              const unsigned mine0 = pk[0], mine1 = pk[1], mine2 = pk[2], mine3 = pk[3];
#define QSEL(s) ({ const unsigned a0_ = (unsigned)__builtin_amdgcn_mov_dpp((int)mine0, 0x55 * (s), 0xf, 0xf, true), a1_ = (unsigned)__builtin_amdgcn_mov_dpp((int)mine1, 0x55 * (s), 0xf, 0xf, true), \
                               a2_ = (unsigned)__builtin_amdgcn_mov_dpp((int)mine2, 0x55 * (s), 0xf, 0xf, true), a3_ = (unsigned)__builtin_amdgcn_mov_dpp((int)mine3, 0x55 * (s), 0xf, 0xf, true); \
                               qi == 0 ? a0_ : (qi == 1 ? a1_ : (qi == 2 ? a2_ : a3_)); })
              c0 = QSEL(0); c1 = QSEL(1); c2 = QSEL(2); c3 = QSEL(3);
#undef QSEL
              st = (v4u){c0, c1, c2, c3}; }
            *(v4u*)(H2 + (size_t)(m + r) * D + 256 * qi + 16 * (F.lane >> 2)) = st; }
        float l0[16], l1[16], l2[16], l3[16];
#pragma unroll
        for (int e = 0; e < 16; ++e) { f32x2 a0 = {0.f, 0.f}, a1 = {0.f, 0.f}, a2 = {0.f, 0.f}, a3 = {0.f, 0.f};
#pragma unroll
            for (int j = 0; j < 4; ++j) { const f32x4 w = *(const LAS f32x4*)(wr + e * 1024 + 4 * F.lane + 256 * j);
                const f32x2 wl = __builtin_shufflevector(w, w, 0, 1), wh = __builtin_shufflevector(w, w, 2, 3);
                a0 = __builtin_elementwise_fma(__builtin_shufflevector(v[0][j], v[0][j], 0, 1), wl, a0); a0 = __builtin_elementwise_fma(__builtin_shufflevector(v[0][j], v[0][j], 2, 3), wh, a0);
                a1 = __builtin_elementwise_fma(__builtin_shufflevector(v[1][j], v[1][j], 0, 1), wl, a1); a1 = __builtin_elementwise_fma(__builtin_shufflevector(v[1][j], v[1][j], 2, 3), wh, a1);
                a2 = __builtin_elementwise_fma(__builtin_shufflevector(v[2][j], v[2][j], 0, 1), wl, a2); a2 = __builtin_elementwise_fma(__builtin_shufflevector(v[2][j], v[2][j], 2, 3), wh, a2);
                a3 = __builtin_elementwise_fma(__builtin_shufflevector(v[3][j], v[3][j], 0, 1), wl, a3); a3 = __builtin_elementwise_fma(__builtin_shufflevector(v[3][j], v[3][j], 2, 3), wh, a3); }
            asm volatile("" : "+v"(a0), "+v"(a1), "+v"(a2), "+v"(a3));
            l0[e] = a0.x + a0.y; l1[e] = a1.x + a1.y; l2[e] = a2.x + a2.y; l3[e] = a3.x + a3.y; }
        router_finish(l0, F.lane, AFF + (size_t)m * 16); router_finish(l1, F.lane, AFF + (size_t)(m + 1) * 16);
        router_finish(l2, F.lane, AFF + (size_t)(m + 2) * 16); router_finish(l3, F.lane, AFF + (size_t)(m + 3) * 16);
        if (F.G == 256 && P7_NMAT > 0) p0_item_store(F, cit, cw, (LAS float*)(F.lds + (F.wave < 7 ? RING_OFF + 65536 + F.wave * 8448 : QS_OFF)));
    }
    __syncthreads();
}
__device__ __forceinline__ void p8_topk(Frame& F, const float* AFF, int* SELI, float* SELG, int* INV) {
    LAS int* wsum = (LAS int*)(F.lds);
    LAS int* sel = (LAS int*)(F.lds + 1024);
    for (int item = blockIdx.x; item < NB * NE; item += F.G) {
        const int pe = item, half = 0, b = pe >> 4, e = pe & 15;
        unsigned key[4];
#pragma unroll
        for (int c = 0; c < 4; ++c) key[c] = __builtin_bit_cast(unsigned, AFF[((size_t)b * SEQ + 4 * F.tid + c) * 16 + e]);
        unsigned tau = 0u;
        for (int bit = 30; bit >= 0; --bit) {
            const unsigned cand = tau | (1u << bit);
            int cnt = 0;
#pragma unroll
            for (int c = 0; c < 4; ++c) cnt += __builtin_popcountll(__ballot(key[c] >= cand));
            LAS int* ws_ = wsum + (bit & 1) * 8;
            if (F.lane == 0) ws_[F.wave] = cnt;
            __syncthreads();
            int tot = 0;
#pragma unroll
            for (int w = 0; w < 8; ++w) tot += ws_[w];
            if (tot >= CAP) tau = cand;
        }
        int gt_before = 0, eq_before = 0;
        int my_gt = 0, my_eq = 0;
#pragma unroll
        for (int c = 0; c < 4; ++c) { my_gt += key[c] > tau; my_eq += key[c] == tau; }
        int pk = my_gt | (my_eq << 16), sc = pk;
#pragma unroll
        for (int o = 1; o < 64; o <<= 1) { const int v = __shfl_up(sc, o); if (F.lane >= o) sc += v; }
        LAS int* wtot = wsum + 16;
        __syncthreads();
        if (F.lane == 63) wtot[F.wave] = sc;
        __syncthreads();
        int base = 0, total = 0;
#pragma unroll
        for (int w = 0; w < 8; ++w) { const int v = wtot[w]; if (w < F.wave) base += v; total += v; }
        const int excl = base + sc - pk; gt_before = excl & 0xffff; eq_before = excl >> 16;
        const int n_gt = total & 0xffff, need = CAP - n_gt;
        const int slot0 = (e * NB + b) * CAP;
        int g = gt_before, q = eq_before;
#pragma unroll
        for (int c = 0; c < 4; ++c) { const int s = 4 * F.tid + c; int slot = -1;
            if (key[c] > tau) { slot = g; ++g; } else if (key[c] == tau) { if (q < need) slot = n_gt + q; ++q; }
            if (half == 0) INV[((size_t)b * SEQ + s) * 16 + e] = slot;
            if (slot >= 0) { SELI[slot0 + slot] = b * SEQ + s; SELG[slot0 + slot] = __builtin_bit_cast(float, key[c]); } }
        __syncthreads();
    }
}
__device__ __forceinline__ void p11_final(Frame& F, const bf16* X1, const unsigned char* YS, const int* INV) {
    const int gw = F.vcu * NWAVES + F.wave, NGW = F.G * NWAVES;
    const float* mod = (const float*)(F.ws + WS_MOD);
    if (F.G == 256) {
        const int mb = F.vcu * 64 + F.wave * 8, b = mb >> 11;
        const int invA = INV[(size_t)(mb + (F.lane >> 4)) * 16 + (F.lane & 15)], invB = INV[(size_t)(mb + 4 + (F.lane >> 4)) * 16 + (F.lane & 15)];
        const f32x4* gap = (const f32x4*)(mod + b * 6144 + 5120) + F.lane;
        const f32x4* gp = (const f32x4*)(F.in[21]) + F.lane;
        f32x4 gav[4], gpv[4];
#pragma unroll
        for (int j = 0; j < 4; ++j) { gav[j] = gap[64 * j]; gpv[j] = gp[64 * j]; }
        v2u xw[8][4];
#pragma unroll
        for (int r = 0; r < 8; ++r) { const v2u* xr = (const v2u*)(X1 + (size_t)(mb + r) * D) + F.lane;
#pragma unroll
            for (int j = 0; j < 4; ++j) xw[r][j] = __builtin_nontemporal_load(xr + 64 * j); }
#pragma unroll
        for (int i = 0; i < 4; ++i) {
            const int m0 = mb + 2 * i;
            f32x4 v[2][4], y[2][4];
#pragma unroll
            for (int r = 0; r < 2; ++r)
#pragma unroll
                for (int j = 0; j < 4; ++j) { const v2u w = xw[2 * i + r][j]; v[r][j] = (f32x4){bf2f_lo(w.x), bf2f_hi(w.x), bf2f_lo(w.y), bf2f_hi(w.y)}; y[r][j] = (f32x4){0.f, 0.f, 0.f, 0.f}; }
            const int isrc = (i < 2) ? invA : invB;
            unsigned long long bal = __ballot(isrc >= 0);
#pragma unroll
            for (int r = 0; r < 2; ++r) {
                const int q16 = 16 * ((2 * i + r) & 3);
                unsigned mask = (unsigned)((bal >> q16) & 0xffffull);
                while (mask) {
                    int w4[4][4];
#pragma unroll
                    for (int q = 0; q < 4; ++q) { if (mask) { const int e = __builtin_ctz(mask); mask &= mask - 1; const int slot = __builtin_amdgcn_readlane(isrc, q16 + e);
                            const int* yp = (const int*)(YS + (size_t)((e * NB + b) * CAP + slot) * D) + F.lane;
#pragma unroll
                            for (int j = 0; j < 4; ++j) w4[q][j] = __builtin_nontemporal_load(yp + 64 * j); } else {
#pragma unroll
                            for (int j = 0; j < 4; ++j) w4[q][j] = 0; } }
#pragma unroll
                    for (int q = 0; q < 4; ++q)
#pragma unroll
                        for (int j = 0; j < 4; ++j) { const f32x2 lo = __builtin_amdgcn_cvt_pk_f32_fp8(w4[q][j], false), hi = __builtin_amdgcn_cvt_pk_f32_fp8(w4[q][j], true);
                            y[r][j] = y[r][j] + (f32x4){lo.x, lo.y, hi.x, hi.y}; }
                }
            }
#pragma unroll
            for (int r = 0; r < 2; ++r) { float s = 0.f;
#pragma unroll
                for (int j = 0; j < 4; ++j) { v[r][j] = v[r][j] + gav[j] * y[r][j] * (1.f / pg8::YS_SCALE); s += (v[r][j].x * v[r][j].x + v[r][j].y * v[r][j].y) + (v[r][j].z * v[r][j].z + v[r][j].w * v[r][j].w); }
                const float rstd = 1.0f / sqrtf(wave_sum(s) * (1.f / D) + EPS);
                f32x4* orow = (f32x4*)(F.out + (size_t)(m0 + r) * D) + F.lane;
#pragma unroll
                for (int j = 0; j < 4; ++j) __builtin_nontemporal_store((v[r][j] * rstd) * gpv[j], orow + 64 * j); }
        }
        return;
    }

    for (int i = 0; i < M / 2 / NGW; ++i) {
        const int m0 = (F.G == 256) ? (F.vcu * 64 + F.wave * 8 + 2 * i) : 2 * (gw + i * NGW); const int b = m0 >> 11;
        const int inv0 = INV[(size_t)m0 * 16 + (F.lane & 15)], inv1 = INV[(size_t)(m0 + 1) * 16 + (F.lane & 15)];
        f32x4 v[2][4], y[2][4];
#pragma unroll
        for (int r = 0; r < 2; ++r) { const v2u* xr = (const v2u*)(X1 + (size_t)(m0 + r) * D) + F.lane;
#pragma unroll
            for (int j = 0; j < 4; ++j) { const v2u w = xr[64 * j]; v[r][j] = (f32x4){bf2f_lo(w.x), bf2f_hi(w.x), bf2f_lo(w.y), bf2f_hi(w.y)}; y[r][j] = (f32x4){0.f, 0.f, 0.f, 0.f}; } }
#pragma unroll
        for (int r = 0; r < 2; ++r) {
            const int myinv = r ? inv1 : inv0;
            unsigned mask = (unsigned)(__ballot(myinv >= 0) & 0xffffull);
            while (mask) {
                int w4[4][4]; int cnt = 0;
#pragma unroll
                for (int q = 0; q < 4; ++q) { if (mask) { const int e = __builtin_ctz(mask); mask &= mask - 1; const int slot = __builtin_amdgcn_readlane(myinv, e);
                        const int* yp = (const int*)(YS + (size_t)((e * NB + b) * CAP + slot) * D) + F.lane;
#pragma unroll
                        for (int j = 0; j < 4; ++j) w4[q][j] = yp[64 * j];
                        cnt = q + 1; } else {
#pragma unroll
                        for (int j = 0; j < 4; ++j) w4[q][j] = 0; } }
#pragma unroll
                for (int q = 0; q < 4; ++q)
#pragma unroll
                    for (int j = 0; j < 4; ++j) { const f32x2 lo = __builtin_amdgcn_cvt_pk_f32_fp8(w4[q][j], false), hi = __builtin_amdgcn_cvt_pk_f32_fp8(w4[q][j], true);
                        y[r][j] = y[r][j] + (f32x4){lo.x, lo.y, hi.x, hi.y}; }
                (void)cnt;
            }
        }
        const f32x4* gap = (const f32x4*)(mod + b * 6144 + 5120) + F.lane;
        const f32x4* gp = (const f32x4*)(F.in[21]) + F.lane;
        f32x4 gav[4], gpv[4];
#pragma unroll
        for (int j = 0; j < 4; ++j) { gav[j] = gap[64 * j]; gpv[j] = gp[64 * j]; }
#pragma unroll
        for (int r = 0; r < 2; ++r) { float s = 0.f;
#pragma unroll
            for (int j = 0; j < 4; ++j) { v[r][j] = v[r][j] + gav[j] * y[r][j] * (1.f / pg8::YS_SCALE); s += (v[r][j].x * v[r][j].x + v[r][j].y * v[r][j].y) + (v[r][j].z * v[r][j].z + v[r][j].w * v[r][j].w); }
            const float rstd = 1.0f / sqrtf(wave_sum(s) * (1.f / D) + EPS);
            f32x4* orow = (f32x4*)(F.out + (size_t)(m0 + r) * D) + F.lane;
#pragma unroll
            for (int j = 0; j < 4; ++j) orow[64 * j] = (v[r][j] * rstd) * gpv[j]; }
    }
}

namespace mx {
typedef float f32x16 __attribute__((ext_vector_type(16)));
typedef short s16x4 __attribute__((ext_vector_type(4)));
typedef short v4i16_t __attribute__((ext_vector_type(4)));
typedef float f32x2_t __attribute__((ext_vector_type(2)));
typedef __bf16 bf16x2_t __attribute__((ext_vector_type(2)));
typedef LAS const char* lds_cptr;
constexpr int ST_K1 = 0, ST_K2 = 8192, ST_V = 16384, ST_BYTES = 32768;
constexpr int BT_OFF = QS_OFF;
__device__ __forceinline__ int crow(int r, int hi) { return (r & 3) + 8 * (r >> 2) + 4 * hi; }
__device__ __forceinline__ unsigned cvtpk(float lo, float hi) { f32x2_t v = {lo, hi}; bf16x2_t b = __builtin_convertvector(v, bf16x2_t); return __builtin_bit_cast(unsigned, b); }
__device__ __forceinline__ s16x4 vtr(lds_cptr p) { return __builtin_bit_cast(s16x4, __builtin_amdgcn_ds_read_tr16_b64_v4i16((LAS v4i16_t*)p)); }
template <int NKS>
__device__ __forceinline__ void qkt(f32x16& p0, f32x16& p1, lds_cptr kb, const bf16x8* qr) {
#pragma unroll
    for (int ks = 0; ks < NKS; ++ks) { const bf16x8 b0 = *(const LAS bf16x8*)(kb + ks * 2048), b1 = *(const LAS bf16x8*)(kb + ks * 2048 + 512);
        p0 = __builtin_amdgcn_mfma_f32_32x32x16_bf16(b0, qr[ks], p0, 0, 0, 0); p1 = __builtin_amdgcn_mfma_f32_32x32x16_bf16(b1, qr[ks], p1, 0, 0, 0); }
}
template <int NKS>
__device__ __forceinline__ void qkt1(f32x16& p, lds_cptr kb, const bf16x8* qr) {
#pragma unroll
    for (int ks = 0; ks < NKS; ++ks) { const bf16x8 b0 = *(const LAS bf16x8*)(kb + ks * 2048); p = __builtin_amdgcn_mfma_f32_32x32x16_bf16(b0, qr[ks], p, 0, 0, 0); }
}
template <int NKS>
__device__ __forceinline__ void kload(bf16x8 (&kf)[NKS], lds_cptr kb) {
#pragma unroll
    for (int ks = 0; ks < NKS; ++ks) kf[ks] = *(const LAS bf16x8*)(kb + ks * 2048);
}
template <int NKS>
__device__ __forceinline__ void kmma(f32x16& p, const f32x16& init, const bf16x8 (&kf)[NKS], const bf16x8* qr) {
    p = __builtin_amdgcn_mfma_f32_32x32x16_bf16(kf[0], qr[0], init, 0, 0, 0);
#pragma unroll
    for (int ks = 1; ks < NKS; ++ks) p = __builtin_amdgcn_mfma_f32_32x32x16_bf16(kf[ks], qr[ks], p, 0, 0, 0);
}
__device__ __forceinline__ bf16x8 packp(const f32x16& p, int s) {
    v4u w; w.x = cvtpk(p[8 * s + 0], p[8 * s + 1]); w.y = cvtpk(p[8 * s + 2], p[8 * s + 3]); w.z = cvtpk(p[8 * s + 4], p[8 * s + 5]); w.w = cvtpk(p[8 * s + 6], p[8 * s + 7]);
    return __builtin_bit_cast(bf16x8, w);
}
#define MX_SB() __builtin_amdgcn_sched_barrier(0)
__device__ __forceinline__ void vload(s16x4 (&lo)[4], s16x4 (&hh)[4], lds_cptr vp, int d0) {
#pragma unroll
    for (int kk = 0; kk < 4; ++kk) { lo[kk] = vtr(vp + d0 * 4096 + kk * 1024); hh[kk] = vtr(vp + d0 * 4096 + kk * 1024 + 512); }
}
__device__ __forceinline__ void vmma(f32x16& o, const s16x4 (&lo)[4], const s16x4 (&hh)[4], const bf16x8 (&pw)[4]) {
#pragma unroll
    for (int kk = 0; kk < 4; ++kk) { const bf16x8 vf = (bf16x8){lo[kk][0], lo[kk][1], lo[kk][2], lo[kk][3], hh[kk][0], hh[kk][1], hh[kk][2], hh[kk][3]};
        o = __builtin_amdgcn_mfma_f32_32x32x16_bf16(vf, pw[kk], o, 0, 0, 0); }
}
__device__ __forceinline__ void pv(f32x16 (&o)[4], lds_cptr vp, const bf16x8 (&pw)[4]) {
    s16x4 la[4], ha[4], lb[4], hb[4];
    vload(la, ha, vp, 0); vload(lb, hb, vp, 1); MX_SB();
    vmma(o[0], la, ha, pw); MX_SB(); vload(la, ha, vp, 2); MX_SB();
    vmma(o[1], lb, hb, pw); MX_SB(); vload(lb, hb, vp, 3); MX_SB();
    vmma(o[2], la, ha, pw); MX_SB();
    vmma(o[3], lb, hb, pw); MX_SB();
}
__device__ __forceinline__ float max32(const f32x16& a, const f32x16& b) {
    float m = fmaxf(a[0], b[0]);
#pragma unroll
    for (int r = 1; r < 16; ++r) m = fmaxf(m, fmaxf(a[r], b[r]));
    return m;
}

#define MX_WAITBAR(N) asm volatile("s_waitcnt vmcnt(" #N ") lgkmcnt(0)\n\ts_barrier" ::: "memory")
__device__ __forceinline__ void glds(const void* g, LAS unsigned char* l) { unsigned keep; const unsigned dst = (unsigned)__builtin_amdgcn_readfirstlane((int)(unsigned)(size_t)l);
    asm volatile("s_mov_b32 %0, m0\n\ts_mov_b32 m0, %2\n\ts_nop 0\n\tglobal_load_lds_dwordx4 %1, off\n\ts_mov_b32 m0, %0" : "=&s"(keep) : "v"(g), "s"(dst) : "memory"); }
__device__ __forceinline__ f32x16 splat16(float v) { f32x16 r;
#pragma unroll
    for (int i = 0; i < 16; ++i) r[i] = v;
    return r; }
template <int NKS>
__device__ __forceinline__ void qkt1i(f32x16& p, const f32x16& init, lds_cptr kb, const bf16x8* qr) {
    p = __builtin_amdgcn_mfma_f32_32x32x16_bf16(*(const LAS bf16x8*)(kb), qr[0], init, 0, 0, 0);
#pragma unroll
    for (int ks = 1; ks < NKS; ++ks) p = __builtin_amdgcn_mfma_f32_32x32x16_bf16(*(const LAS bf16x8*)(kb + ks * 2048), qr[ks], p, 0, 0, 0);
}

template <int VAR>
__device__ __forceinline__ void diff_unit(Frame& F, int b, int h, int qb, float lam, bf16* YCAT) {
    const int lane = F.lane, r32 = lane & 31, hi = lane >> 5, wave = F.wave, half = wave >> 2;
    const size_t rb = (size_t)b * SEQ; const int qw = qb * 256 + wave * 32;
    const bf16* DQ1 = (const bf16*)(F.ws + WS_DQ1); const bf16* DQ2 = DQ1 + (size_t)M * 256; const bf16* DK1 = DQ2 + (size_t)M * 256; const bf16* DK2 = DK1 + (size_t)M * 256;
    const bf16* DV = (const bf16*)(F.ws + WS_DV);
    LAS float* bt = (LAS float*)(F.lds + BT_OFF);
    __syncthreads();
    const float cneg = F.in[15][15 * 4 + h] * LOG2E, cpos = F.in[15][31 * 4 + h] * LOG2E;
    bf16x8 qr1[4], qr2[4];
#pragma unroll
    for (int ks = 0; ks < 4; ++ks) { qr1[ks] = *(const bf16x8*)(DQ1 + (rb + qw + r32) * 256 + h * 64 + ks * 16 + hi * 8); qr2[ks] = *(const bf16x8*)(DQ2 + (rb + qw + r32) * 256 + h * 64 + ks * 16 + hi * 8); }
    const bf16* k1src = DK1 + (rb + lane) * 256 + h * 64 + wave * 8; const bf16* k2src = DK2 + (rb + lane) * 256 + h * 64 + wave * 8;
    const bf16* vsrc0 = DV + (rb + ((2 * wave) & 3) * 16 + (lane >> 2)) * 512 + h * 128 + ((2 * wave) >> 2) * 32 + (lane & 3) * 8;
    const bf16* vsrc1 = DV + (rb + ((2 * wave + 1) & 3) * 16 + (lane >> 2)) * 512 + h * 128 + ((2 * wave + 1) >> 2) * 32 + (lane & 3) * 8;
    const lds_cptr L = (lds_cptr)F.lds;
    const int kfo = hi * 1024 + r32 * 16;
    const int vfo = ST_V + ((lane >> 4) & 1) * 32 + (lane & 3) * 8 + (4 * hi + ((lane & 15) >> 2)) * 64;
    const int btb = (256 - qw - r32 + 4 * hi) * 4;
#define DIFF_DMA(u, WITHV) do { const int so_ = ((u) % 3) * ST_BYTES; const size_t ko_ = (size_t)(u) * 64 * 256; \
        glds(k1src + ko_, F.lds + so_ + ST_K1 + wave * 1024); glds(k2src + ko_, F.lds + so_ + ST_K2 + wave * 1024); \
        if (WITHV) { const size_t vo_ = (size_t)(u) * 64 * 512; glds(vsrc0 + vo_, F.lds + so_ + ST_V + wave * 2048); glds(vsrc1 + vo_, F.lds + so_ + ST_V + wave * 2048 + 1024); } } while (0)
    constexpr int T = 32;
#define P1_DMA(u) do { const int so_ = ((u) % 6) * 16384; const size_t ko_ = (size_t)(u) * 64 * 256; \
        glds(k1src + ko_, F.lds + so_ + wave * 1024); glds(k2src + ko_, F.lds + so_ + 8192 + wave * 1024); } while (0)
#define P1_WAIT(t) do { const int rem_ = T - 2 - (t); if (rem_ >= 3) MX_WAITBAR(6); else if (rem_ == 2) MX_WAITBAR(4); else if (rem_ == 1) MX_WAITBAR(2); else MX_WAITBAR(0); } while (0)
    P1_DMA(0); P1_DMA(1); P1_DMA(2); P1_DMA(3);
    for (int i = F.tid; i < 512; i += 512) bt[i] = F.in[15][t5_bucket(i - 256) * 4 + h] * LOG2E;
    MX_WAITBAR(0);
#pragma unroll
    for (int ks = 0; ks < 4; ++ks) { asm volatile("" : "+v"(qr1[ks])); asm volatile("" : "+v"(qr2[ks])); }
    float mref1 = 0.f, mref2 = 0.f, l1 = 0.f, l2 = 0.f;
    f32x16 ni1 = splat16(0.f), ni2 = splat16(0.f);
    f32x16 a0, a1, c0, c1;
    const float ecneg = __builtin_amdgcn_exp2f(cneg), ecpos = __builtin_amdgcn_exp2f(cpos);
    for (int t = 0; t < ((VAR & 1) ? 0 : T); ++t) {
        const lds_cptr stg = L + (t % 6) * 16384;
        if (t + 4 < T) P1_DMA(t + 4);
        { bf16x8 ka[4], kb_[4], kc[4], kd[4];
          kload<4>(ka, stg + ST_K1 + kfo); kload<4>(kb_, stg + ST_K1 + kfo + 512); kload<4>(kc, stg + ST_K2 + kfo); kload<4>(kd, stg + ST_K2 + kfo + 512); MX_SB();
          kmma<4>(a0, ni1, ka, qr1); kmma<4>(a1, ni1, kb_, qr1); kmma<4>(c0, ni2, kc, qr2); kmma<4>(c1, ni2, kd, qr2); MX_SB(); }
        if (!(VAR & 16)) {
            const int kt = t * 64; float cc = 0.f, ecc = 1.f;
            if (kt <= qw - 191) { cc = cneg; ecc = ecneg; } else if (kt >= qw + 159) { cc = cpos; ecc = ecpos; }
            else { const LAS float* bp = (const LAS float*)((lds_cptr)bt + btb + kt * 4);
#pragma unroll
                for (int r = 0; r < 16; ++r) { const float b0 = bp[(r & 3) + 8 * (r >> 2)], b1 = bp[32 + (r & 3) + 8 * (r >> 2)]; a0[r] += b0; c0[r] += b0; a1[r] += b1; c1[r] += b1; } }
            float s1 = 0.f, s2 = 0.f;
#pragma unroll
            for (int r = 0; r < 16; ++r) { s1 += __builtin_amdgcn_exp2f(a0[r]) + __builtin_amdgcn_exp2f(a1[r]); s2 += __builtin_amdgcn_exp2f(c0[r]) + __builtin_amdgcn_exp2f(c1[r]); }
            s1 *= ecc; s2 *= ecc;
            if (__any(t == 0 || !(s1 < 1e15f) || !(s2 < 1e15f))) {
                { float d = max32(a0, a1) + cc; if (t != 0) d = fmaxf(d, 0.f); mref1 += d; l1 *= __builtin_amdgcn_exp2f(-d); const float sh = d - cc; s1 = 0.f;
#pragma unroll
                  for (int r = 0; r < 16; ++r) s1 += __builtin_amdgcn_exp2f(a0[r] - sh) + __builtin_amdgcn_exp2f(a1[r] - sh);
                  ni1 = splat16(-mref1); }
                { float d = max32(c0, c1) + cc; if (t != 0) d = fmaxf(d, 0.f); mref2 += d; l2 *= __builtin_amdgcn_exp2f(-d); const float sh = d - cc; s2 = 0.f;
#pragma unroll
                  for (int r = 0; r < 16; ++r) s2 += __builtin_amdgcn_exp2f(c0[r] - sh) + __builtin_amdgcn_exp2f(c1[r] - sh);
                  ni2 = splat16(-mref2); }
            }
            l1 += s1; l2 += s2;
        }
        P1_WAIT(t);
    }
    float ml1, ml2;
    { const float mo = __shfl_xor(mref1, 32), lo = __shfl_xor(l1, 32), mm = fmaxf(mref1, mo); const float ll = l1 * __builtin_amdgcn_exp2f(mref1 - mm) + lo * __builtin_amdgcn_exp2f(mo - mm); ml1 = mm + __builtin_amdgcn_logf(ll); }
    { const float mo = __shfl_xor(mref2, 32), lo = __shfl_xor(l2, 32), mm = fmaxf(mref2, mo); const float ll = l2 * __builtin_amdgcn_exp2f(mref2 - mm) + lo * __builtin_amdgcn_exp2f(mo - mm); ml2 = mm + __builtin_amdgcn_logf(ll); }
#define P2_DMA(u) do { const int so_ = ((u) & 3) * ST_BYTES; const size_t ko_ = (size_t)(u) * 64 * 256, vo_ = (size_t)(u) * 64 * 512; \
        glds(k1src + ko_, F.lds + so_ + ST_K1 + wave * 1024); glds(k2src + ko_, F.lds + so_ + ST_K2 + wave * 1024); \
        glds(vsrc0 + vo_, F.lds + so_ + ST_V + wave * 2048); glds(vsrc1 + vo_, F.lds + so_ + ST_V + wave * 2048 + 1024); } while (0)
    P2_DMA(0); P2_DMA(1);
    MX_WAITBAR(0);
    f32x16 o[4]; o[0] = f32x16{}; o[1] = f32x16{}; o[2] = f32x16{}; o[3] = f32x16{};
    bf16x8 pw[4];
    int cls = -1;
    for (int t = 0; t < T; ++t) {
        const lds_cptr stg = L + (t & 3) * ST_BYTES;
        if (t + 2 < T) P2_DMA(t + 2);
        if (t > 0) pv(o, L + ((t - 1) & 3) * ST_BYTES + vfo, pw);
        const int kt = t * 64; const int c3 = (kt <= qw - 191) ? 0 : ((kt >= qw + 159) ? 2 : 1);
        if (c3 != cls) { cls = c3; const float cc = (c3 == 0) ? cneg : ((c3 == 2) ? cpos : 0.f); ni1 = splat16(cc - ml1); ni2 = splat16(cc - ml2); }
        { bf16x8 ka[4], kc[4], kb_[4], kd[4];
          kload<4>(ka, stg + ST_K1 + kfo); kload<4>(kc, stg + ST_K2 + kfo); kload<4>(kb_, stg + ST_K1 + kfo + 512); kload<4>(kd, stg + ST_K2 + kfo + 512); MX_SB();
          kmma<4>(a0, ni1, ka, qr1); kmma<4>(c0, ni2, kc, qr2); kmma<4>(a1, ni1, kb_, qr1); kmma<4>(c1, ni2, kd, qr2); MX_SB(); }
        {
            if (c3 == 1) { const LAS float* bp = (const LAS float*)((lds_cptr)bt + btb + kt * 4);
#pragma unroll
                for (int r = 0; r < 16; ++r) { const float b0 = bp[(r & 3) + 8 * (r >> 2)], b1 = bp[32 + (r & 3) + 8 * (r >> 2)]; a0[r] += b0; c0[r] += b0; a1[r] += b1; c1[r] += b1; } }
#pragma unroll
            for (int r = 0; r < 16; ++r) a0[r] = __builtin_amdgcn_exp2f(a0[r]) - lam * __builtin_amdgcn_exp2f(c0[r]);
            pw[0] = packp(a0, 0); pw[1] = packp(a0, 1);
#pragma unroll
            for (int r = 0; r < 16; ++r) a1[r] = __builtin_amdgcn_exp2f(a1[r]) - lam * __builtin_amdgcn_exp2f(c1[r]);
            pw[2] = packp(a1, 0); pw[3] = packp(a1, 1);
        }
        if (t + 2 < T) MX_WAITBAR(4); else MX_WAITBAR(0);
    }
    f32x4 gg[4][4];
#pragma unroll
    for (int d0 = 0; d0 < 4; ++d0)
#pragma unroll
        for (int g = 0; g < 4; ++g) gg[d0][g] = *(const f32x4*)(F.in[7] + 32 * d0 + 8 * g + 4 * hi);
    pv(o, L + ((T - 1) & 3) * ST_BYTES + vfo, pw);
#undef P2_DMA
#undef DIFF_DMA
#undef P1_DMA
#undef P1_WAIT
    float ss = 0.f;
#pragma unroll
    for (int d0 = 0; d0 < 4; ++d0)
#pragma unroll
        for (int r = 0; r < 16; ++r) ss += o[d0][r] * o[d0][r];
    ss += __shfl_xor(ss, 32);
    const float rstd = 0.8f / sqrtf(ss * (1.f / 128.f) + EPS);
    bf16* yrow = YCAT + (rb + qw + r32) * 1024 + 512 + h * 128;
#pragma unroll
    for (int d0 = 0; d0 < 4; ++d0)
#pragma unroll
        for (int g = 0; g < 4; ++g) { const int dv = 32 * d0 + 8 * g + 4 * hi;
            v2u w; w.x = cvtpk(o[d0][4 * g] * rstd * gg[d0][g][0], o[d0][4 * g + 1] * rstd * gg[d0][g][1]); w.y = cvtpk(o[d0][4 * g + 2] * rstd * gg[d0][g][2], o[d0][4 * g + 3] * rstd * gg[d0][g][3]);
            *(v2u*)(yrow + dv) = w; }
}

template <int VAR>
__device__ __forceinline__ void ret_unit(Frame& F, int b, int h, int qb, bf16* YCAT) {
    const int lane = F.lane, r32 = lane & 31, hi = lane >> 5, wave = F.wave, half = wave >> 2;
    const size_t rb = (size_t)b * SEQ; const int qw = qb * 256 + wave * 32;
    const bf16* RQ = (const bf16*)(F.ws + WS_RQ); const bf16* RK = (const bf16*)(F.ws + WS_RK); const bf16* RV = (const bf16*)(F.ws + WS_RV); const bf16* RG = (const bf16*)(F.ws + WS_RG);
    float l2f, l2b;
    { const float xf = __builtin_amdgcn_exp2f(-5.0f - (float)h); l2f = ln1m(xf) * LOG2E; l2b = ln1m(xf * 0.70710678118654752f) * LOG2E; }
    bf16x8 qr[8];
#pragma unroll
    for (int ks = 0; ks < 8; ++ks) qr[ks] = *(const bf16x8*)(RQ + (rb + qw + r32) * 512 + h * 128 + ks * 16 + hi * 8);
    const bf16* ksrc = RK + (rb + lane) * 512 + h * 128 + wave * 8;
    const bf16* vsrc0 = RV + (rb + ((2 * wave) & 3) * 16 + (lane >> 2)) * 512 + h * 128 + ((2 * wave) >> 2) * 32 + (lane & 3) * 8;
    const bf16* vsrc1 = RV + (rb + ((2 * wave + 1) & 3) * 16 + (lane >> 2)) * 512 + h * 128 + ((2 * wave + 1) >> 2) * 32 + (lane & 3) * 8;
    const lds_cptr L = (lds_cptr)F.lds;
    const int kfo = hi * 1024 + r32 * 16;
    const int vfo = ST_V + ((lane >> 4) & 1) * 32 + (lane & 3) * 8 + (4 * hi + ((lane & 15) >> 2)) * 64;
#define RET_DMA(u) do { const int so_ = ((u) % 3) * ST_BYTES; const size_t o_ = (size_t)(u) * 64 * 512; \
        glds(ksrc + o_, F.lds + so_ + wave * 1024); glds(ksrc + o_ + 64, F.lds + so_ + 8192 + wave * 1024); \
        glds(vsrc0 + o_, F.lds + so_ + ST_V + wave * 2048); glds(vsrc1 + o_, F.lds + so_ + ST_V + wave * 2048 + 1024); } while (0)
    constexpr int T = 32;
#pragma unroll
    for (int ks = 0; ks < 8; ++ks) asm volatile("" : "+v"(qr[ks]));
    __syncthreads();
    RET_DMA(0); RET_DMA(1);
    MX_WAITBAR(0);
    f32x16 o[4]; o[0] = f32x16{}; o[1] = f32x16{}; o[2] = f32x16{}; o[3] = f32x16{};
    bf16x8 pw[4];
    const float nl2f = -l2f, nl2b = -l2b;
    if (half) MX_WAITBAR(0);
    for (int t = 0; t < T; ++t) {
        const lds_cptr stg = L + (t % 3) * ST_BYTES;
        if (!(VAR & 8) && half && t + 2 < T) RET_DMA(t + 2);
        {
            f32x16 a0, a1; const f32x16 zero16 = {};
            if (VAR & 4) { a0 = splat16((float)t); a1 = splat16((float)(t + 1)); } else
            { bf16x8 ka[8], kb_[8]; kload<8>(ka, stg + kfo); kload<8>(kb_, stg + kfo + 512); MX_SB(); kmma<8>(a0, zero16, ka, qr); kmma<8>(a1, zero16, kb_, qr); MX_SB(); }
            const int kt = t * 64;
            const float e0 = (float)(qw + r32 - kt - 4 * hi);
            if (VAR & 1) { } else if (kt + 63 <= qw) {
                const float bl = e0 * l2f;
#pragma unroll
                for (int r = 0; r < 16; ++r) { const float cr = (float)((r & 3) + 8 * (r >> 2)); a0[r] *= __builtin_amdgcn_exp2f(__builtin_fmaf(cr, nl2f, bl)); a1[r] *= __builtin_amdgcn_exp2f(__builtin_fmaf(cr + 32.f, nl2f, bl)); }
            } else if (kt > qw + 31) {
                const float bl = -e0 * l2b;
#pragma unroll
                for (int r = 0; r < 16; ++r) { const float cr = (float)((r & 3) + 8 * (r >> 2)); a0[r] *= __builtin_amdgcn_exp2f(__builtin_fmaf(cr, l2b, bl)); a1[r] *= __builtin_amdgcn_exp2f(__builtin_fmaf(cr + 32.f, l2b, bl)); }
            } else {
#pragma unroll
                for (int r = 0; r < 16; ++r) { const float cr = (float)((r & 3) + 8 * (r >> 2)); const float d0 = e0 - cr, d1 = e0 - cr - 32.f;
                    a0[r] *= __builtin_amdgcn_exp2f(fminf(d0 * l2f, d0 * nl2b)); a1[r] *= __builtin_amdgcn_exp2f(fminf(d1 * l2f, d1 * nl2b)); }
            }
            pw[0] = packp(a0, 0); pw[1] = packp(a0, 1); pw[2] = packp(a1, 0); pw[3] = packp(a1, 1);
        }
        if (t + 2 < T) MX_WAITBAR(4); else MX_WAITBAR(0);
        if (!(VAR & 8) && !half && t + 2 < T) RET_DMA(t + 2);
        if (!(VAR & 2)) pv(o, stg + vfo, pw);
        if (t + 2 < T) MX_WAITBAR(4); else MX_WAITBAR(0);
    }
    if (!half) MX_WAITBAR(0);
#undef RET_DMA
    float sm = 0.f;
#pragma unroll
    for (int d0 = 0; d0 < 4; ++d0)
#pragma unroll
        for (int r = 0; r < 16; ++r) sm += o[d0][r];
    sm += __shfl_xor(sm, 32);
    const float mean = sm * (1.f / 128.f); float q = 0.f;
#pragma unroll
    for (int d0 = 0; d0 < 4; ++d0)
#pragma unroll
        for (int r = 0; r < 16; ++r) { o[d0][r] -= mean; q += o[d0][r] * o[d0][r]; }
    q += __shfl_xor(q, 32);
    const float rstd = 1.0f / sqrtf(q * (1.f / 128.f) + EPS);
    const size_t row = rb + qw + r32;
#pragma unroll
    for (int d0 = 0; d0 < 4; ++d0)
#pragma unroll
        for (int g = 0; g < 4; ++g) { const int dv = 32 * d0 + 8 * g + 4 * hi; const f32x4 gg = *(const f32x4*)(F.in[6] + h * 128 + dv); const v2u gw = *(const v2u*)(RG + row * 512 + h * 128 + dv);
            v2u w; w.x = cvtpk(o[d0][4 * g] * rstd * gg[0] * bf2f_lo(gw.x), o[d0][4 * g + 1] * rstd * gg[1] * bf2f_hi(gw.x));
            w.y = cvtpk(o[d0][4 * g + 2] * rstd * gg[2] * bf2f_lo(gw.y), o[d0][4 * g + 3] * rstd * gg[3] * bf2f_hi(gw.y));
            *(v2u*)(YCAT + row * 1024 + h * 128 + dv) = w; }
    __syncthreads();
}

constexpr int CH = 128;
__device__ __forceinline__ void ret_state_job(Frame& F, int job, bf16* ST) {
    const int lane = F.lane, hi = lane >> 5, wave = F.wave, tid = F.tid;
    const int bh = job >> 3, dir = (job >> 2) & 1, dvq = job & 3, b = bh >> 2, h = bh & 3;
    const size_t rb = (size_t)b * SEQ;
    const bf16* RK = (const bf16*)(F.ws + WS_RK); const bf16* RV = (const bf16*)(F.ws + WS_RV);
    float l2g; { const float xf = __builtin_amdgcn_exp2f(-5.0f - (float)h); l2g = dir ? ln1m(xf * 0.70710678118654752f) * LOG2E : ln1m(xf) * LOG2E; }
    const float cdec = __builtin_amdgcn_exp2f(128.f * l2g);
    constexpr int SB_ = 40960, DEC_OFF = 3 * SB_;
    __syncthreads();
    if (tid < 128) ((LAS float*)(F.lds + DEC_OFF))[tid] = __builtin_amdgcn_exp2f((dir ? (float)tid : (float)(127 - tid)) * l2g);
    auto chunk_of = [&](int i) { return dir ? (15 - i) : i; };
#define ST_DMA(i) do { const int so_ = ((i) % 3) * SB_; const size_t o_ = (size_t)chunk_of(i) * CH * 512; \
        _Pragma("unroll") for (int j_ = 0; j_ < 4; ++j_) { const int blk_ = wave * 4 + j_, d0_ = blk_ >> 3, rg_ = blk_ & 7; \
            glds(RK + o_ + (rb + rg_ * 16 + (lane >> 2)) * 512 + h * 128 + d0_ * 32 + (lane & 3) * 8, F.lds + so_ + blk_ * 1024); } \
        glds(RV + o_ + (rb + wave * 16 + (lane >> 2)) * 512 + h * 128 + dvq * 32 + (lane & 3) * 8, F.lds + so_ + 32768 + wave * 1024); } while (0)
    ST_DMA(0); ST_DMA(1);
    MX_WAITBAR(0);
    const lds_cptr L = (lds_cptr)F.lds;
    const int trp = ((lane >> 4) & 1) * 32 + (lane & 3) * 8 + (4 * hi + ((lane & 15) >> 2)) * 64;
    const LAS float* dec = (const LAS float*)(F.lds + DEC_OFF) + 4 * hi;
    f32x16 acc = {};
    for (int i = 0; i < 16; ++i) {
        const int st = (i % 3) * SB_;
        if (i + 2 < 16) ST_DMA(i + 2);
        if (wave < 4) {
            const int n = chunk_of(i);
            bf16* sp = ST + ((size_t)((dir * 32 + bh) * 16 + n) * 128 + dvq * 32 + (lane & 31)) * 128 + wave * 32 + 4 * hi;
#pragma unroll
            for (int g = 0; g < 4; ++g) { v2u w; w.x = cvtpk(acc[4 * g], acc[4 * g + 1]); w.y = cvtpk(acc[4 * g + 2], acc[4 * g + 3]); *(v2u*)(sp + 8 * g) = w; }
#pragma unroll
            for (int r = 0; r < 16; ++r) acc[r] *= cdec;
            s16x4 kl[8], kh[8], vl[8], vh[8]; f32x4 dl[8], dh_[8];
#pragma unroll
            for (int ks = 0; ks < 8; ++ks) { const lds_cptr kp = L + st + (wave * 8 + ks) * 1024 + trp, vp = L + st + 32768 + ks * 1024 + trp;
                kl[ks] = vtr(kp); kh[ks] = vtr(kp + 512); vl[ks] = vtr(vp); vh[ks] = vtr(vp + 512);
                dl[ks] = *(const LAS f32x4*)(dec + 16 * ks); dh_[ks] = *(const LAS f32x4*)(dec + 16 * ks + 8); }
            MX_SB();
#pragma unroll
            for (int ks = 0; ks < 8; ++ks) {
                const bf16x8 kf = (bf16x8){kl[ks][0], kl[ks][1], kl[ks][2], kl[ks][3], kh[ks][0], kh[ks][1], kh[ks][2], kh[ks][3]};
                const v2u ul = __builtin_bit_cast(v2u, vl[ks]), uh = __builtin_bit_cast(v2u, vh[ks]); v4u w;
                w.x = cvtpk(bf2f_lo(ul.x) * dl[ks][0], bf2f_hi(ul.x) * dl[ks][1]); w.y = cvtpk(bf2f_lo(ul.y) * dl[ks][2], bf2f_hi(ul.y) * dl[ks][3]);
                w.z = cvtpk(bf2f_lo(uh.x) * dh_[ks][0], bf2f_hi(uh.x) * dh_[ks][1]); w.w = cvtpk(bf2f_lo(uh.y) * dh_[ks][2], bf2f_hi(uh.y) * dh_[ks][3]);
                acc = __builtin_amdgcn_mfma_f32_32x32x16_bf16(kf, __builtin_bit_cast(bf16x8, w), acc, 0, 0, 0);
            }
        }
        if (i + 2 < 16) { if (wave < 4) MX_WAITBAR(13); else MX_WAITBAR(5); }
        else if (i == 14) { if (wave < 4) MX_WAITBAR(8); else MX_WAITBAR(0); }
        else MX_WAITBAR(0);
    }
#undef ST_DMA
    __syncthreads();
}
__device__ __forceinline__ bf16x8 scale8(const bf16x8& q, float s) {
    const v4u u = __builtin_bit_cast(v4u, q); v4u w;
    w.x = cvtpk(bf2f_lo(u.x) * s, bf2f_hi(u.x) * s); w.y = cvtpk(bf2f_lo(u.y) * s, bf2f_hi(u.y) * s); w.z = cvtpk(bf2f_lo(u.z) * s, bf2f_hi(u.z) * s); w.w = cvtpk(bf2f_lo(u.w) * s, bf2f_hi(u.w) * s);
    return __builtin_bit_cast(bf16x8, w);
}
__device__ __forceinline__ void ret_out_unit(Frame& F, int b, int h, int m, const bf16* ST, bf16* YCAT) {
    const int lane = F.lane, r32 = lane & 31, hi = lane >> 5, wave = F.wave, rbk = wave & 3, dh = wave >> 2;
    const size_t rb = (size_t)b * SEQ; const int bh = b * 4 + h; const int row0 = m * CH;
    const bf16* RQ = (const bf16*)(F.ws + WS_RQ); const bf16* RK = (const bf16*)(F.ws + WS_RK); const bf16* RV = (const bf16*)(F.ws + WS_RV); const bf16* RG = (const bf16*)(F.ws + WS_RG);
    float l2f, l2b;
    { const float xf = __builtin_amdgcn_exp2f(-5.0f - (float)h); l2f = ln1m(xf) * LOG2E; l2b = ln1m(xf * 0.70710678118654752f) * LOG2E; }
    const int il = rbk * 32 + r32;
    bf16x8 qr[8];
    const bf16* sfp = ST + (size_t)((0 * 32 + bh) * 16 + m) * 128 * 128; const bf16* sbp = ST + (size_t)((1 * 32 + bh) * 16 + m) * 128 * 128;
    __syncthreads();
#pragma unroll
    for (int i = 0; i < 4; ++i) { const int pc = wave * 4 + i, c = pc >> 1, hf = pc & 1;
        glds(RK + (rb + row0 + hf * 64 + lane) * 512 + h * 128 + c * 8, F.lds + c * 2048 + hf * 1024);
        const int blk = wave * 4 + i, d0 = blk >> 3, rg = blk & 7;
        glds(RV + (rb + row0 + rg * 16 + (lane >> 2)) * 512 + h * 128 + d0 * 32 + (lane & 3) * 8, F.lds + 32768 + blk * 1024); }
#pragma unroll
    for (int ks = 0; ks < 8; ++ks) qr[ks] = *(const bf16x8*)(RQ + (rb + row0 + il) * 512 + h * 128 + ks * 16 + hi * 8);
    const size_t row = rb + row0 + il;
    f32x4 gga[2][4]; v2u gwa[2][4];
#pragma unroll
    for (int dd = 0; dd < 2; ++dd)
#pragma unroll
        for (int g = 0; g < 4; ++g) { const int dv = 32 * (2 * dh + dd) + 8 * g + 4 * hi; gga[dd][g] = *(const f32x4*)(F.in[6] + h * 128 + dv); gwa[dd][g] = *(const v2u*)(RG + row * 512 + h * 128 + dv); }
    MX_WAITBAR(0);
#pragma unroll
    for (int i = 0; i < 4; ++i) { const int pc = wave * 4 + i, c = pc >> 1, hf = pc & 1;
        glds(sfp + (size_t)(hf * 64 + lane) * 128 + c * 8, F.lds + 65536 + c * 2048 + hf * 1024);
        glds(sbp + (size_t)(hf * 64 + lane) * 128 + c * 8, F.lds + 98304 + c * 2048 + hf * 1024); }
#pragma unroll
    for (int ks = 0; ks < 8; ++ks) asm volatile("" : "+v"(qr[ks]));
    const lds_cptr L = (lds_cptr)F.lds;
    const int kfo = hi * 2048 + r32 * 16;
    const int trp = ((lane >> 4) & 1) * 32 + (lane & 3) * 8 + (4 * hi + ((lane & 15) >> 2)) * 64;
    f32x16 o[2]; o[0] = f32x16{}; o[1] = f32x16{};
    const f32x16 zero16 = {};
    const float nl2b = -l2b;
#pragma unroll
    for (int t = 0; t < 2; ++t) {
        f32x16 a0, a1;
        { bf16x8 ka[8], kb_[8];
#pragma unroll
          for (int ks = 0; ks < 8; ++ks) { ka[ks] = *(const LAS bf16x8*)(L + kfo + ks * 4096 + (2 * t) * 512); kb_[ks] = *(const LAS bf16x8*)(L + kfo + ks * 4096 + (2 * t + 1) * 512); }
          kmma<8>(a0, zero16, ka, qr); kmma<8>(a1, zero16, kb_, qr); }
        const float e0 = (float)(il - 64 * t - 4 * hi);
#pragma unroll
        for (int r = 0; r < 16; ++r) { const float cr = (float)((r & 3) + 8 * (r >> 2)); const float d0 = e0 - cr, d1 = e0 - cr - 32.f;
            a0[r] *= __builtin_amdgcn_exp2f(fminf(d0 * l2f, d0 * nl2b)); a1[r] *= __builtin_amdgcn_exp2f(fminf(d1 * l2f, d1 * nl2b)); }
        bf16x8 pw[4]; pw[0] = packp(a0, 0); pw[1] = packp(a0, 1); pw[2] = packp(a1, 0); pw[3] = packp(a1, 1);
#pragma unroll
        for (int dd = 0; dd < 2; ++dd)
#pragma unroll
            for (int kk = 0; kk < 4; ++kk) { const lds_cptr vp = L + 32768 + ((2 * dh + dd) * 8 + 4 * t + kk) * 1024 + trp; const s16x4 lo = vtr(vp), hh = vtr(vp + 512);
                const bf16x8 vf = (bf16x8){lo[0], lo[1], lo[2], lo[3], hh[0], hh[1], hh[2], hh[3]};
                o[dd] = __builtin_amdgcn_mfma_f32_32x32x16_bf16(vf, pw[kk], o[dd], 0, 0, 0); }
    }
    MX_WAITBAR(0);
    { const float sf = __builtin_amdgcn_exp2f((float)(il + 1) * l2f), sb = __builtin_amdgcn_exp2f((float)(CH - il) * l2b);
#pragma unroll
      for (int ks = 0; ks < 8; ++ks) { const bf16x8 qf = scale8(qr[ks], sf), qb = scale8(qr[ks], sb);
#pragma unroll
          for (int dd = 0; dd < 2; ++dd) { const int off = kfo + ks * 4096 + (2 * dh + dd) * 512;
              o[dd] = __builtin_amdgcn_mfma_f32_32x32x16_bf16(*(const LAS bf16x8*)(L + 65536 + off), qf, o[dd], 0, 0, 0);
              o[dd] = __builtin_amdgcn_mfma_f32_32x32x16_bf16(*(const LAS bf16x8*)(L + 98304 + off), qb, o[dd], 0, 0, 0); } } }
    float s = 0.f, ss = 0.f;
#pragma unroll
    for (int dd = 0; dd < 2; ++dd)
#pragma unroll
        for (int r = 0; r < 16; ++r) { s += o[dd][r]; ss += o[dd][r] * o[dd][r]; }
    s += __shfl_xor(s, 32); ss += __shfl_xor(ss, 32);
    LAS float* ex = (LAS float*)(F.lds + QS_OFF);
    if (hi == 0) { ex[(wave * 32 + r32) * 2] = s; ex[(wave * 32 + r32) * 2 + 1] = ss; }
    __syncthreads();
    { const int pw_ = wave ^ 4; s += ex[(pw_ * 32 + r32) * 2]; ss += ex[(pw_ * 32 + r32) * 2 + 1]; }
    const float mean = s * (1.f / 128.f); const float var = fmaxf(ss * (1.f / 128.f) - mean * mean, 0.f); const float rstd = 1.0f / sqrtf(var + EPS);
#pragma unroll
    for (int dd = 0; dd < 2; ++dd)
#pragma unroll
        for (int g = 0; g < 4; ++g) { const int dv = 32 * (2 * dh + dd) + 8 * g + 4 * hi; const f32x4 gg = gga[dd][g]; const v2u gw = gwa[dd][g];
            v2u w; w.x = cvtpk((o[dd][4 * g] - mean) * rstd * gg[0] * bf2f_lo(gw.x), (o[dd][4 * g + 1] - mean) * rstd * gg[1] * bf2f_hi(gw.x));
            w.y = cvtpk((o[dd][4 * g + 2] - mean) * rstd * gg[2] * bf2f_lo(gw.y), (o[dd][4 * g + 3] - mean) * rstd * gg[3] * bf2f_hi(gw.y));
            *(v2u*)(YCAT + row * 1024 + h * 128 + dv) = w; }
    __syncthreads();
}
#undef MX_WAITBAR
#undef MX_SB
}

#ifndef RET_CHUNKED
#define RET_CHUNKED 1
#endif
#ifndef MIX_FAST
#define MIX_FAST 3
#endif
#ifndef MK_PER_PHASE
#define MK_PER_PHASE 0
#endif
constexpr int N_PHASES = 12;
__device__ __forceinline__ void touch_b_share(Frame& F, const unsigned char* Bt, int Mrows, int Ncols, int rowbytes, int gdiv, size_t gstride) {
    pg8::StaticOrder S; S.init(Mrows, Ncols, F.G, (int)blockIdx.x); pg8::Unit u; if (!S.next(0, u)) return;
    const unsigned char* panel = Bt + (size_t)(u.pm / gdiv) * gstride + (size_t)u.pn * 256 * rowbytes + (size_t)(32 * (u.pm & 7)) * rowbytes;
    const int lpr = rowbytes >> 7, nlines = 32 * lpr;
    for (int l = (F.wave - 1) * 64 + F.lane; l < nlines; l += 448) { const unsigned v = *(const unsigned*)(panel + (size_t)(l / lpr) * rowbytes + (l % lpr) * 128); asm volatile("" :: "v"(v)); }
}
#define GRID_BAR_HOOK(k, body) do { if (IN(k) && IN((k) + 1)) xcd_barrier_hook(bar, [&]() __attribute__((always_inline)) { body; }); } while (0)
struct Args { const float* in[22]; float* out; unsigned char* ws; int ph_lo, ph_hi; };
__global__ void __launch_bounds__(NWAVES * 64, 2) fwd_kernel(Args args) {
    extern __shared__ __attribute__((aligned(16))) unsigned char lds[];
    Frame F;
    F.lds = (LAS unsigned char*)lds;
    F.MISC = (volatile LAS unsigned*)(F.lds + MISC_OFF);
    F.tid = threadIdx.x; F.lane = F.tid & 63; F.wave = __builtin_amdgcn_readfirstlane(F.tid >> 6);
    F.G = gridDim.x; { const int bx = blockIdx.x; F.vcu = (F.G % 8 == 0) ? (bx % 8) * (F.G / 8) + bx / 8 : bx; }
    F.ws = args.ws; F.out = args.out; F.ctl = (gu32*)(args.ws + WS_CTL);
#pragma unroll
    for (int i = 0; i < 22; ++i) F.in[i] = args.in[i];
    for (int u = F.tid; u < (LDS_BYTES - LDSCTL_OFF) / 4; u += NWAVES * 64) ((LAS unsigned*)(F.lds + LDSCTL_OFF))[u] = 0u;
    __syncthreads();
    XcdBarrier bar; bar.bar = (unsigned*)(F.ctl + CW_BAR); bar.x = 0; bar.st = nullptr;
    if (!MK_PER_PHASE) bar = xcd_barrier_post((unsigned*)(F.ctl + CW_BAR), F.MISC + 8);
    const int lo = args.ph_lo, hi = args.ph_hi;
#ifndef PHASE_MASK
#define PHASE_MASK 0xfff
#endif
#define IN(k) (((PHASE_MASK >> (k)) & 1) && lo <= (k) && (k) < hi)
#define GRID_BAR(k) do { if (IN(k) && IN((k) + 1)) xcd_barrier(bar); } while (0)
#ifndef DUP_MASK
#define DUP_MASK 0
#endif
#define REP(k) _Pragma("unroll") for (int rep_ = 0; rep_ < 1 + ((DUP_MASK >> (k)) & 1); ++rep_)
    unsigned char* ws = args.ws;
    bf16* XN = (bf16*)args.out;
    bf16* YCAT = (bf16*)args.out;
    float* X1 = args.out;
    const float* MOD = (const float*)(ws + WS_MOD);

    if (IN(0)) REP(0) { p0_prologue(F); }
    GRID_BAR(0);
    if (IN(1)) REP(1) { p1_norm(F, XN); }
    GRID_BAR(1);
    if (IN(2)) REP(2) {
        pg8::Gemm g{XN, (const bf16*)(ws + WS_WIN), M, NIN, D, D, D, 1 << 30, 0};
        pg8::StaticOrder S; S.init(M, NIN, F.G, (int)blockIdx.x);
        pg8::EpiProj E{(bf16*)ws, (const float*)(ws + WS_CS), WS_RQ / 2, WS_RK / 2, WS_RV / 2, WS_RG / 2, WS_DQ1 / 2, WS_DV / 2, WS_GR / 2, WS_GD / 2};
        pg8::gemm_phase<pg8::EpiProj, pg8::StaticOrder, true, true>(F.lds + RING_OFF, g, S, E);
        p0_tail_items(F);
    }
    GRID_BAR(2);
    if (IN(3)) REP(3) {
        float lam;
        const float lq1 = F.in[8][F.lane], lk1 = F.in[9][F.lane], lq2 = F.in[10][F.lane], lk2 = F.in[11][F.lane];
        lam = __expf(wave_sum(lq1 * lk1)) - __expf(wave_sum(lq2 * lk2)) + 0.2f;
#if RET_CHUNKED
        { bf16* ST = (bf16*)args.out + (size_t)M * 1024; for (int j = F.vcu; j < 256; j += F.G) mx::ret_state_job(F, j, ST); }
        VM_WAIT(); __syncthreads();
        if (F.tid == 0) { __builtin_amdgcn_fence(__ATOMIC_RELEASE, "agent"); VM_WAIT(); __hip_atomic_fetch_add((unsigned*)(F.ctl + CW_RET), 1u, RLX_AGENT); }
#endif
#if (MIX_FAST & 1)
        { const int u = F.vcu; if (u < 256) mx::diff_unit<0>(F, u >> 5, (u >> 3) & 3, u & 7, lam, YCAT); }
        __syncthreads(); p3_items(F);
#ifdef DIFF_VAR
        { const int u = F.vcu; if (u < 256) mx::diff_unit<DIFF_VAR>(F, u >> 5, (u >> 3) & 3, u & 7, lam, YCAT + (size_t)M * 1024); }
#endif
#else
        for (int u = F.vcu; u < 8192; u += F.G) naive_unit<1>(F, u, lam, YCAT);
#endif
#if (MIX_FAST & 2)
#if RET_CHUNKED
        { bf16* ST = (bf16*)args.out + (size_t)M * 1024;
          if (F.tid == 0) { unsigned sp_ = 0; const unsigned want = (unsigned)(F.G < 256 ? F.G : 256);
              while (__hip_atomic_load((unsigned*)(F.ctl + CW_RET), RLX_AGENT) < want) { __builtin_amdgcn_s_sleep(2); if (++sp_ > (1u << 22)) { __hip_atomic_store((unsigned*)(F.ctl + CW_TMO), 1u, RLX_AGENT); break; } }
              __builtin_amdgcn_fence(__ATOMIC_ACQUIRE, "agent"); VM_WAIT(); }
          __syncthreads();
          for (int u = F.vcu; u < 512; u += F.G) mx::ret_out_unit(F, u >> 6, (u >> 4) & 3, u & 15, ST, YCAT); }
#else
        { const int u = F.vcu; if (u < 256) mx::ret_unit<0>(F, u >> 5, (u >> 3) & 3, u & 7, YCAT); }
#endif
#else
        for (int u = F.vcu; u < 8192; u += F.G) naive_unit<0>(F, u, lam, YCAT);
#endif
    }
    GRID_BAR_HOOK(3, touch_b_share(F, ws + WS_WCAT, M, D, 2048, 1 << 30, 0));
    if (IN(4)) REP(4) {
        pg8::Gemm g{YCAT, (const bf16*)(ws + WS_WCAT), M, D, D, D, D, 1 << 30, 0};
        pg8::StaticOrder S; S.init(M, D, F.G, (int)blockIdx.x);
        pg8::EpiGate2 E{(bf16*)(ws + WS_MERGED), (const bf16*)(ws + WS_GR), (const bf16*)(ws + WS_GD), D};
        pg8::gemm_phase<pg8::EpiGate2, pg8::StaticOrder, true, true>(F.lds + RING_OFF, g, S, E);
    }
    GRID_BAR_HOOK(5, touch_b_share(F, ws + WS_WO, M, D, 2048, 1 << 30, 0));
    if (IN(6)) REP(6) {
        pg8::Gemm g{(const bf16*)(ws + WS_MERGED), (const bf16*)(ws + WS_WO), M, D, D, D, D, 1 << 30, 0};
        pg8::StaticOrder S; S.init(M, D, F.G, (int)blockIdx.x);
        pg8::EpiResidB E{(bf16*)(ws + WS_X1), F.in[0], MOD + 2048, D, 6144};
        pg8::gemm_phase<pg8::EpiResidB, pg8::StaticOrder, true, true>(F.lds + RING_OFF, g, S, E);
    }
    GRID_BAR(6);
    if (IN(7)) REP(7) { p7_router(F, (const bf16*)(ws + WS_X1), ws + WS_H2, (float*)(ws + WS_AFF)); }
    GRID_BAR(7);
    if (IN(8)) REP(8) { p8_topk(F, (const float*)(ws + WS_AFF), (int*)(ws + WS_SELG + 131072), (float*)(ws + WS_SELG), (int*)(ws + WS_INV)); }
    GRID_BAR(8);
    if (IN(9)) REP(9) {
        pg8::Gemm g{(const bf16*)(ws + WS_H2), (const bf16*)(ws + WS_WGU), MS, 2048, 512, 512, 512, 8, (size_t)2048 * 1024, (const int*)(ws + WS_SELG + 131072)};
        pg8::StaticOrder S; S.init(MS, 2048, F.G, (int)blockIdx.x);
        pg8::EpiSwiGLU8 E{ws + WS_ACT, D};
        pg8::gemm_phase<pg8::EpiSwiGLU8, pg8::StaticOrder, true, true>(F.lds + RING_OFF, g, S, E);
    }
    GRID_BAR_HOOK(9, touch_b_share(F, ws + WS_WD, MS, D, 1024, 8, (size_t)1024 * 1024));
    if (IN(10)) REP(10) {
        pg8::Gemm g{(const bf16*)(ws + WS_ACT), (const bf16*)(ws + WS_WD), MS, D, 512, 512, 512, 8, (size_t)1024 * 1024};
        pg8::StaticOrder S; S.init(MS, D, F.G, (int)blockIdx.x);
        pg8::EpiRowScale8 E{ws + WS_YS, (const float*)(ws + WS_SELG), D};
        pg8::gemm_phase<pg8::EpiRowScale8, pg8::StaticOrder, true, true>(F.lds + RING_OFF, g, S, E);
    }
    GRID_BAR(10);
#ifdef EXTRA_BARS
#pragma unroll 1
    for (int xb = 0; xb < EXTRA_BARS; ++xb) xcd_barrier(bar);
#endif
    if (IN(11)) { p11_final(F, (const bf16*)(ws + WS_X1), ws + WS_YS, (const int*)(ws + WS_INV)); }
#undef IN
#undef GRID_BAR
}

extern "C" void kernel_launch(void* const* d_in, const int* in_sizes, int n_in, void* d_out, int out_size, void* d_ws, size_t ws_size, hipStream_t stream) {
    static int grid = 0;
    if (grid == 0) {
        if (n_in != 22 || in_sizes[0] != M * D || out_size != M * D || ws_size < WS_END) { fprintf(stderr, "kernel_launch: unexpected problem (n_in %d, out %d, ws %zu); nothing launched\n", n_in, out_size, ws_size); grid = -1; return; }
        int dev = 0, cus = 0, per_cu = 0;
        if (hipGetDevice(&dev) != hipSuccess || hipDeviceGetAttribute(&cus, hipDeviceAttributeMultiprocessorCount, dev) != hipSuccess) { grid = -1; return; }
        if (hipFuncSetAttribute((const void*)fwd_kernel, hipFuncAttributeMaxDynamicSharedMemorySize, LDS_BYTES) != hipSuccess) { fprintf(stderr, "kernel_launch: hipFuncSetAttribute failed\n"); grid = -1; return; }
        if (hipOccupancyMaxActiveBlocksPerMultiprocessor(&per_cu, (const void*)fwd_kernel, NWAVES * 64, LDS_BYTES) != hipSuccess || per_cu < 1) { fprintf(stderr, "kernel_launch: occupancy query reports %d\n", per_cu); }
        (void)hipGetLastError();
        grid = cus;
        if (cus != 256) { fprintf(stderr, "kernel_launch: this kernel's unit deal is built for the 256 CUs of an MI355X (device reports %d); nothing launched\n", cus); grid = -1; return; }
    }
    if (grid < 0) return;
    if (hipMemsetAsync((char*)d_ws + WS_CTL, 0, CTL_ZERO_BYTES, stream) != hipSuccess) return;
    Args a{};
    for (int i = 0; i < 22; ++i) a.in[i] = (const float*)d_in[i];
    a.out = (float*)d_out; a.ws = (unsigned char*)d_ws;
#if MK_PER_PHASE
    for (int p = 0; p < N_PHASES; ++p) { a.ph_lo = p; a.ph_hi = p + 1; hipLaunchKernelGGL(fwd_kernel, dim3(grid), dim3(NWAVES * 64), LDS_BYTES, stream, a); }
#else
    a.ph_lo = 0; a.ph_hi = N_PHASES;
    hipLaunchKernelGGL(fwd_kernel, dim3(grid), dim3(NWAVES * 64), LDS_BYTES, stream, a);
#endif
}
```
